# Optimizing an MI355X kernel written in HIP

```python
import jax, jax.numpy as jnp
from jax import lax
import numpy as np

D_MODEL = 1024
BATCH = 16
SEQ = 2048
DEPTH = 1

N_META = 16
D_CONV_GRP = D_MODEL
CONV_WIDTH = 3
CONV_HEADS = 8
SSD_HEADS = 16
SSD_HEAD_DIM = 64
D_SSD = SSD_HEADS * SSD_HEAD_DIM
SSD_GROUPS = 4
D_STATE = 128
SSD_CONV = 4
CHUNK = 128
D_MIX = D_CONV_GRP + D_SSD
SSD_XBC = D_SSD + 2 * SSD_GROUPS * D_STATE
D_IN_PROJ = 3 * D_CONV_GRP + D_SSD + SSD_XBC + SSD_HEADS
N_EXPERTS = 32
TOP_K = 4
D_FF = D_MODEL
SWIGLU_ALPHA = 1.702
SWIGLU_LIMIT = 7.0
MOE_BLOCK = 128
EPS = 1e-5

kernel_name = "hymba_conv_ssd_moe_layer"


def rms_norm(x, w):
    xf = x.astype(jnp.float32)
    y = xf * lax.rsqrt(jnp.mean(xf * xf, axis=-1, keepdims=True) + EPS)
    return (y * w.astype(jnp.float32)).astype(x.dtype)


def grouped_rms_norm(x, w, groups):
    shp = x.shape
    xf = x.astype(jnp.float32).reshape(shp[:-1] + (groups, shp[-1] // groups))
    y = xf * lax.rsqrt(jnp.mean(xf * xf, axis=-1, keepdims=True) + EPS)
    return (y.reshape(shp) * w.astype(jnp.float32)).astype(x.dtype)


def causal_dwconv(u, w, b=None):
    k_w = w.shape[0]
    length = u.shape[1]
    up = jnp.pad(u, ((0, 0), (k_w - 1, 0), (0, 0)))
    y = up[:, 0:length] * w[0]
    for k in range(1, k_w):
        y = y + up[:, k:k + length] * w[k]
    if b is not None:
        y = y + b
    return y


def ssd_chunked(xdt, da, bm, cm):
    bsz, length = xdt.shape[0], xdt.shape[1]
    pad_front = (-length) % CHUNK

    def front_pad(t):
        return jnp.pad(t, [(0, 0), (pad_front, 0)] + [(0, 0)] * (t.ndim - 2))

    xdt, da, bm, cm = front_pad(xdt), front_pad(da), front_pad(bm), front_pad(cm)
    nc = (length + pad_front) // CHUNK
    r = SSD_HEADS // SSD_GROUPS
    xc = xdt.reshape(bsz, nc, CHUNK, SSD_GROUPS, r, SSD_HEAD_DIM)
    ac = da.reshape(bsz, nc, CHUNK, SSD_GROUPS, r)
    bc = bm.reshape(bsz, nc, CHUNK, SSD_GROUPS, D_STATE)
    cc = cm.reshape(bsz, nc, CHUNK, SSD_GROUPS, D_STATE)

    a_cs = jnp.cumsum(ac, axis=2)
    seg = a_cs[:, :, :, None] - a_cs[:, :, None, :]
    causal = jnp.tril(jnp.ones((CHUNK, CHUNK), dtype=bool))[:, :, None, None]
    decay = jnp.where(causal, jnp.exp(jnp.where(causal, seg, 0.0)), 0.0)

    cb = jnp.einsum('bclgn,bcsgn->bclsg', cc, bc)
    y_diag = jnp.einsum('bclsgr,bcsgrp->bclgrp', cb[..., None] * decay, xc)

    decay_to_end = jnp.exp(a_cs[:, :, -1:] - a_cs)
    states = jnp.einsum('bclgn,bclgrp->bcgrpn', bc, xc * decay_to_end[..., None])
    chunk_decay = jnp.exp(a_cs[:, :, -1])

    def step(h, inp):
        st, dec = inp
        return dec[..., None, None] * h + st, h

    h0 = jnp.zeros_like(states[:, 0])
    _, prev = lax.scan(step, h0, (jnp.moveaxis(states, 1, 0), jnp.moveaxis(chunk_decay, 1, 0)))
    prev = jnp.moveaxis(prev, 0, 1)
    y_off = jnp.einsum('bclgn,bcgrpn->bclgrp', cc, prev) * jnp.exp(a_cs)[..., None]

    y = (y_diag + y_off).reshape(bsz, nc * CHUNK, SSD_HEADS, SSD_HEAD_DIM)
    return y[:, pad_front:]


def hybrid_mixer(n, w_in, conv_short_w, conv_norm_w, ssd_conv_w, ssd_conv_b,
                 ssd_dt_bias, ssd_a_log, ssd_d, ssd_norm_w, w_out):
    bsz, length, _ = n.shape
    proj = jnp.einsum('bld,de->ble', n, w_in)
    cuts = list(np.cumsum([D_CONV_GRP, D_CONV_GRP, D_CONV_GRP, D_SSD, SSD_XBC]))
    c_b, c_c, c_x, z, xbc, dt_raw = jnp.split(proj, cuts, axis=-1)

    y_conv = c_b * causal_dwconv(c_c * c_x, conv_short_w)
    y_conv = grouped_rms_norm(y_conv, conv_norm_w, CONV_HEADS)

    xbc = jax.nn.silu(causal_dwconv(xbc, ssd_conv_w, ssd_conv_b))
    xs, bs, cs = jnp.split(xbc, [D_SSD, D_SSD + SSD_GROUPS * D_STATE], axis=-1)
    xs = xs.reshape(bsz, length, SSD_HEADS, SSD_HEAD_DIM).astype(jnp.float32)
    dt = jax.nn.softplus(dt_raw.astype(jnp.float32) + ssd_dt_bias.astype(jnp.float32))
    a = -jnp.exp(ssd_a_log.astype(jnp.float32))
    y_ssd = ssd_chunked(xs * dt[..., None], dt * a,
                        bs.astype(jnp.float32).reshape(bsz, length, SSD_GROUPS, D_STATE),
                        cs.astype(jnp.float32).reshape(bsz, length, SSD_GROUPS, D_STATE))
    y_ssd = y_ssd + ssd_d.astype(jnp.float32)[:, None] * xs
    y_ssd = y_ssd.reshape(bsz, length, D_SSD).astype(n.dtype) * jax.nn.silu(z)
    y_ssd = grouped_rms_norm(y_ssd, ssd_norm_w, SSD_GROUPS)

    y = jnp.concatenate([y_conv, y_ssd], axis=-1)
    return jnp.einsum('ble,ed->bld', y, w_out)


def moe_ffn(n, router_w, router_b, w_gate_up, b_gate_up, w_down, b_down):
    bsz, length, d = n.shape
    n_tok = bsz * length
    xt = n.reshape(n_tok, d)
    logits = (xt @ router_w + router_b).astype(jnp.float32)
    top_vals, top_idx = lax.top_k(logits, TOP_K)
    gates = jax.nn.softmax(top_vals, axis=-1).astype(n.dtype)

    n_assign = n_tok * TOP_K
    flat_e = top_idx.reshape(-1)
    flat_tok = jnp.arange(n_assign, dtype=jnp.int32) // TOP_K
    flat_g = gates.reshape(-1)
    order = jnp.argsort(flat_e)
    sorted_e = flat_e[order]
    counts = jnp.bincount(flat_e, length=N_EXPERTS)
    padded = ((counts + MOE_BLOCK - 1) // MOE_BLOCK) * MOE_BLOCK
    pad_end = jnp.cumsum(padded)
    pad_start = pad_end - padded
    grp_start = jnp.cumsum(counts) - counts
    dest = pad_start[sorted_e] + (jnp.arange(n_assign, dtype=jnp.int32) - grp_start[sorted_e])

    n_blocks = -(-(n_assign + N_EXPERTS * (MOE_BLOCK - 1)) // MOE_BLOCK)
    rows = n_blocks * MOE_BLOCK
    slot_tok = jnp.zeros((rows,), jnp.int32).at[dest].set(flat_tok[order])
    slot_gate = jnp.zeros((rows,), n.dtype).at[dest].set(flat_g[order])
    blk_expert = jnp.minimum(
        jnp.searchsorted(pad_end, jnp.arange(n_blocks, dtype=jnp.int32) * MOE_BLOCK, side='right'),
        N_EXPERTS - 1)

    def run_block(args):
        tok, g, e = args
        xb = xt[tok]
        gu = xb @ w_gate_up[e] + b_gate_up[e]
        glu = jnp.minimum(gu[:, :D_FF], SWIGLU_LIMIT)
        lin = jnp.clip(gu[:, D_FF:], -SWIGLU_LIMIT, SWIGLU_LIMIT)
        act = glu * jax.nn.sigmoid(SWIGLU_ALPHA * glu) * (lin + 1.0)
        return (act @ w_down[e] + b_down[e]) * g[:, None]

    yb = lax.map(run_block, (slot_tok.reshape(n_blocks, MOE_BLOCK),
                             slot_gate.reshape(n_blocks, MOE_BLOCK), blk_expert))
    out = jnp.zeros((n_tok, d), n.dtype).at[slot_tok].add(yb.reshape(rows, d))
    return out.reshape(bsz, length, d)


def setup_inputs(seed: int = 0) -> dict:
    key = jax.random.key(seed)
    ks = jax.random.split(key, 24)
    f32 = jnp.float32
    nrm = lambda k, shp, s: jax.random.normal(k, shp, f32) * s
    dt = jnp.exp(jax.random.uniform(ks[9], (DEPTH, SSD_HEADS), f32)
                 * (jnp.log(0.1) - jnp.log(0.001)) + jnp.log(0.001))
    return {
        "x": nrm(ks[0], (BATCH, SEQ, D_MODEL), 1.0),
        "meta_tokens": nrm(ks[1], (N_META, D_MODEL), 1.0),
        "norm_mix_w": 1.0 + nrm(ks[2], (DEPTH, D_MODEL), 0.02),
        "w_in": nrm(ks[3], (DEPTH, D_MODEL, D_IN_PROJ), D_MODEL ** -0.5),
        "conv_short_w": nrm(ks[4], (DEPTH, CONV_WIDTH, D_CONV_GRP), CONV_WIDTH ** -0.5),
        "conv_norm_w": 1.0 + nrm(ks[5], (DEPTH, D_CONV_GRP), 0.02),
        "ssd_conv_w": nrm(ks[6], (DEPTH, SSD_CONV, SSD_XBC), SSD_CONV ** -0.5),
        "ssd_conv_b": nrm(ks[7], (DEPTH, SSD_XBC), 0.01),
        "ssd_dt_bias": dt + jnp.log(-jnp.expm1(-dt)),
        "ssd_a_log": jnp.log(jax.random.uniform(ks[8], (DEPTH, SSD_HEADS), f32, 1.0, 16.0)),
        "ssd_d": 1.0 + nrm(ks[10], (DEPTH, SSD_HEADS), 0.1),
        "ssd_norm_w": 1.0 + nrm(ks[11], (DEPTH, D_SSD), 0.02),
        "w_out": nrm(ks[12], (DEPTH, D_MIX, D_MODEL), D_MIX ** -0.5),
        "norm_ffn_w": 1.0 + nrm(ks[13], (DEPTH, D_MODEL), 0.02),
        "router_w": nrm(ks[14], (DEPTH, D_MODEL, N_EXPERTS), D_MODEL ** -0.5),
        "router_b": nrm(ks[15], (DEPTH, N_EXPERTS), 0.01),
        "w_gate_up": nrm(ks[16], (DEPTH, N_EXPERTS, D_MODEL, 2 * D_FF), D_MODEL ** -0.5),
        "b_gate_up": nrm(ks[17], (DEPTH, N_EXPERTS, 2 * D_FF), 0.01),
        "w_down": nrm(ks[18], (DEPTH, N_EXPERTS, D_FF, D_MODEL), D_FF ** -0.5),
        "b_down": nrm(ks[19], (DEPTH, N_EXPERTS, D_MODEL), 0.01),
        "norm_final_w": 1.0 + nrm(ks[20], (D_MODEL,), 0.02),
    }


def reference(x, meta_tokens, norm_mix_w, w_in, conv_short_w, conv_norm_w, ssd_conv_w,
              ssd_conv_b, ssd_dt_bias, ssd_a_log, ssd_d, ssd_norm_w, w_out, norm_ffn_w,
              router_w, router_b, w_gate_up, b_gate_up, w_down, b_down, norm_final_w):
    bsz = x.shape[0]
    meta = jnp.broadcast_to(meta_tokens.astype(x.dtype)[None], (bsz, N_META, D_MODEL))
    h = jnp.concatenate([meta, x], axis=1)
    for l in range(DEPTH):
        h = h + hybrid_mixer(rms_norm(h, norm_mix_w[l]), w_in[l], conv_short_w[l], conv_norm_w[l],
                             ssd_conv_w[l], ssd_conv_b[l], ssd_dt_bias[l], ssd_a_log[l], ssd_d[l],
                             ssd_norm_w[l], w_out[l])
        h = h + moe_ffn(rms_norm(h, norm_ffn_w[l]), router_w[l], router_b[l], w_gate_up[l],
                        b_gate_up[l], w_down[l], b_down[l])
    h = rms_norm(h, norm_final_w)
    return h[:, N_META:]
```

```cpp
#include <hip/hip_runtime.h>
#include <cstdio>
#include <cstdint>

#define LAS __attribute__((address_space(3)))
#define GAS __attribute__((address_space(1)))
typedef unsigned short bf16;
typedef short bf16x8 __attribute__((ext_vector_type(8)));
typedef float f32x4 __attribute__((ext_vector_type(4)));
typedef float f32x2 __attribute__((ext_vector_type(2)));
typedef unsigned u32x4 __attribute__((ext_vector_type(4)));
typedef unsigned u32x2 __attribute__((ext_vector_type(2)));
typedef GAS unsigned gu32;

constexpr int BATCH = 16, SEQ = 2048, D = 1024, NMETA = 16, LSEQ = SEQ + NMETA;
constexpr int TR = BATCH * SEQ;
constexpr int TA = 33024;
constexpr int MROW = TR;
constexpr int WIN_LD = 6160, NPROJ = 6144;
constexpr int C_CB = 0, C_CC = 1024, C_CX = 2048, C_Z = 3072, C_XS = 4096, C_BS = 5120, C_CS = 5632;
constexpr int NH = 16, HD = 64, NE = 32, DMIX = 2048;
constexpr float EPS = 1e-5f;
constexpr float SW_ALPHA = 1.702f, SW_LIMIT = 7.0f;

constexpr size_t MiB = 1u << 20;
constexpr size_t WS_CTL = 0, CTL_ZERO_BYTES = 1 * MiB;
constexpr size_t WS_LIST = 1 * MiB;
constexpr size_t WS_GATE = 5 * MiB;
constexpr size_t WS_DT = 6 * MiB;
constexpr size_t WS_WIN = 12 * MiB;
constexpr size_t WS_WOUT = 24 * MiB;
constexpr size_t WS_WGU = 28 * MiB;
constexpr size_t WS_WDN = 156 * MiB;
constexpr size_t WS_XN = 220 * MiB;
constexpr size_t WS_PROJ = 285 * MiB;
constexpr size_t WS_ACT = 285 * MiB;
constexpr size_t WS_YE = 557 * MiB;
constexpr size_t WS_Y = 672 * MiB;
constexpr size_t WS_H1 = 816 * MiB;
constexpr size_t WS_XBCA = 880 * MiB;
constexpr size_t WS_END = 1024 * MiB;
constexpr int CW_CNT = 64;
constexpr int CW_BAR = 4096;

__device__ __forceinline__ unsigned f2bf(float f) { unsigned u = __float_as_uint(f); return (u + 0x7fffu + ((u >> 16) & 1u)) >> 16; }
__device__ __forceinline__ unsigned pk2(float lo, float hi) { return f2bf(lo) | (f2bf(hi) << 16); }
__device__ __forceinline__ float bf2f(unsigned short b) { return __uint_as_float(((unsigned)b) << 16); }
__device__ __forceinline__ float bflo(unsigned w) { return __uint_as_float(w << 16); }
__device__ __forceinline__ float bfhi(unsigned w) { return __uint_as_float(w & 0xffff0000u); }
__device__ __forceinline__ unsigned cvt_pk_bf16(float lo, float hi) { unsigned r; asm volatile("v_cvt_pk_bf16_f32 %0, %1, %2" : "=v"(r) : "v"(lo), "v"(hi)); return r; }
__device__ __forceinline__ float wave_sum(float v) {
#pragma unroll
    for (int o = 1; o < 64; o <<= 1) v += __shfl_xor(v, o);
    return v;
}
__device__ __forceinline__ int row_of(int b, int l) { return l >= NMETA ? b * SEQ + (l - NMETA) : MROW + l; }
__device__ __forceinline__ float silu_f(float z) { return z / (1.0f + __expf(-z)); }
#define LDS_WAIT() asm volatile("s_waitcnt lgkmcnt(0)" ::: "memory")
#define VM_WAIT() asm volatile("s_waitcnt vmcnt(0)" ::: "memory")

namespace pg8 {
constexpr int BM = 256, BK = 64, HALF = 128, HTB = HALF * BK * 2, STAGE_BYTES = 8 * HTB, NXCD = 8, WGM = 8;
constexpr int NOFF_REL = STAGE_BYTES + 8192;
__host__ __device__ __forceinline__ int lds_byte(int r, int c) { const int st = (r >> 4) * 2 + (c >> 5), rr = r & 15, cc = c & 31, ob = rr * 64 + cc * 2; return st * 1024 + (ob ^ (((ob >> 9) & 1) << 5)); }
__host__ __device__ __forceinline__ void stage_rc(int b, int& R, int& C) { const int st = b / 1024, sb = b % 1024, swz = sb ^ (((sb >> 9) & 1) << 5); R = (st >> 1) * 16 + swz / 64; C = (st & 1) * 32 + (swz % 64) / 2; }
__host__ __device__ __forceinline__ int perm32(int rho) { const int n = rho >> 4, i = rho & 15; return 8 * (i >> 2) + 4 * n + (i & 3); }

template <class Epi, class Sched, bool ALIGN_EPI, bool SP2>
__device__ __forceinline__ void gemm_phase(LAS unsigned char* lds, const char* Abase, const int K, const Sched& S, const Epi& E) {
    const int tid = threadIdx.x, wid = __builtin_amdgcn_readfirstlane(tid >> 6), lane = tid & 63, wr = wid >> 2, wc = wid & 3, fr = lane & 15, fq = lane >> 4;
    const int nt = K / BK;
    int Rr[2]; unsigned cbA[2], voffB[2];
#pragma unroll
    for (int i = 0; i < 2; ++i) { int R, C; stage_rc(tid * 16 + i * 8192, R, C); const int Rb = Epi::PERM ? ((R & ~31) + perm32(R & 31)) : R;
        Rr[i] = R; cbA[i] = (unsigned)C * 2u; voffB[i] = (unsigned)(Rb * K + C) * 2u; }
    const size_t kstep = (size_t)(BK * 2);
    const size_t hstep = (size_t)HALF * K * 2;
    const unsigned ldsw = (unsigned)wid * 1024u;
    const int aoff = lds_byte(wr * 64 + fr, fq * 8), boff = lds_byte(wc * 32 + fr, fq * 8);
#define PG8_SA(b, h) (((b) * 2 + (h)) * HTB)
#define PG8_SB(b, h) ((4 + (b) * 2 + (h)) * HTB)
#define PG8_STAGEB(bufoff, gbase) do { _Pragma("unroll") for (int _i = 0; _i < 2; ++_i) \
        __builtin_amdgcn_global_load_lds((const unsigned*)((const char*)(gbase) + voffB[_i]), (LAS unsigned*)(lds + (bufoff) + ldsw + _i * 8192), 16, 0, 0); } while (0)
#define PG8_STAGEA(bufoff, offs, kt) do { const char* _gb = Abase + (size_t)(kt) * kstep; _Pragma("unroll") for (int _i = 0; _i < 2; ++_i) \
        __builtin_amdgcn_global_load_lds((const unsigned*)(_gb + (offs)[_i]), (LAS unsigned*)(lds + (bufoff) + ldsw + _i * 8192), 16, 0, 0); } while (0)
#define PG8_LDA(dst, b, h) do { _Pragma("unroll") for (int m = 0; m < 4; ++m) _Pragma("unroll") for (int k = 0; k < 2; ++k) dst[m][k] = *(const LAS bf16x8*)(lds + PG8_SA(b, h) + aoff + m * 2048 + k * 1024); } while (0)
#define PG8_LDB(dst, b, h) do { _Pragma("unroll") for (int n = 0; n < 2; ++n) _Pragma("unroll") for (int k = 0; k < 2; ++k) dst[n][k] = *(const LAS bf16x8*)(lds + PG8_SB(b, h) + boff + n * 2048 + k * 1024); } while (0)
#define PG8_MMA(ai, bj, At, Bt) do { __builtin_amdgcn_s_setprio(1); _Pragma("unroll") for (int m = 0; m < 4; ++m) _Pragma("unroll") for (int n = 0; n < 2; ++n) _Pragma("unroll") for (int k = 0; k < 2; ++k) \
        acc[ai][bj][m][n] = __builtin_amdgcn_mfma_f32_16x16x32_bf16(Bt[n][k], At[m][k], acc[ai][bj][m][n], 0, 0, 0); __builtin_amdgcn_s_setprio(0); } while (0)
#define PG8_WAIT_V(n) asm volatile("s_waitcnt vmcnt(" #n ")" ::: "memory")
#define PG8_WAIT_L(n) asm volatile("s_waitcnt lgkmcnt(" #n ")" ::: "memory")
#define PG8_BAR __builtin_amdgcn_s_barrier()
#define PG8_SCHED __builtin_amdgcn_sched_barrier(0)
    typename Sched::Unit cur, nxt; int ui = 0;
    if (!S.next(0, cur)) return;
    f32x4 acc[2][2][4][2];
#pragma unroll
    for (int a = 0; a < 2; ++a)
#pragma unroll
        for (int b = 0; b < 2; ++b)
#pragma unroll
            for (int m = 0; m < 4; ++m)
#pragma unroll
                for (int n = 0; n < 2; ++n) acc[a][b][m][n] = (f32x4){0.f, 0.f, 0.f, 0.f};
    bf16x8 At[4][2], B0[2][2], B1[2][2];
    unsigned coff[2][2];
    LAS u32x4* stash = (LAS u32x4*)(lds + NOFF_REL) + tid;
#pragma unroll
    for (int h = 0; h < 2; ++h)
#pragma unroll
        for (int i = 0; i < 2; ++i) coff[h][i] = S.aoff(cur, h * HALF + Rr[i]) + cbA[i];
    const char* cB = S.bptr(cur);
    if constexpr (SP2) {
        PG8_STAGEB(PG8_SB(0, 0), cB); PG8_STAGEB(PG8_SB(0, 1), cB + hstep); PG8_STAGEA(PG8_SA(0, 0), coff[0], 0); PG8_STAGEA(PG8_SA(0, 1), coff[1], 0);
        if (wr == 1) PG8_BAR;
        PG8_WAIT_V(2); PG8_BAR;
        PG8_STAGEB(PG8_SB(1, 0), cB + kstep); PG8_STAGEA(PG8_SA(1, 0), coff[0], 1); PG8_STAGEB(PG8_SB(1, 1), cB + hstep + kstep);
        PG8_WAIT_V(6); PG8_BAR;
    } else {
        PG8_STAGEB(PG8_SB(0, 0), cB); PG8_STAGEA(PG8_SA(0, 0), coff[0], 0); PG8_STAGEB(PG8_SB(0, 1), cB + hstep); PG8_STAGEA(PG8_SA(0, 1), coff[1], 0);
        if (wr == 1) PG8_BAR;
        PG8_WAIT_V(4); PG8_BAR;
        PG8_STAGEB(PG8_SB(1, 0), cB + kstep); PG8_STAGEA(PG8_SA(1, 0), coff[0], 1); PG8_STAGEB(PG8_SB(1, 1), cB + hstep + kstep);
        PG8_WAIT_V(6); PG8_BAR;
    }
    for (;;) {
        const bool has_next = S.next(ui + 1, nxt);
        const char* nB = has_next ? S.bptr(nxt) : cB;
        if (has_next) { u32x4 w; w.x = S.aoff(nxt, Rr[0]) + cbA[0]; w.y = S.aoff(nxt, Rr[1]) + cbA[1]; w.z = S.aoff(nxt, HALF + Rr[0]) + cbA[0]; w.w = S.aoff(nxt, HALF + Rr[1]) + cbA[1]; *stash = w; }
        for (int t = 0; t < nt; t += 2) {
            const bool last = (t == nt - 2);
            const char* b2 = last ? nB : cB + (size_t)(t + 2) * kstep;
            const char* b3 = b2 + kstep;
            const int ka = last ? 0 : t + 2;
            if constexpr (SP2) {
            PG8_LDB(B0, 0, 0); PG8_LDB(B1, 0, 1); PG8_SCHED; PG8_LDA(At, 0, 0); PG8_STAGEA(PG8_SA(1, 1), coff[1], t + 1);
            PG8_WAIT_V(8); PG8_WAIT_L(0); PG8_BAR; PG8_MMA(0, 0, At, B0); PG8_MMA(0, 1, At, B1); PG8_BAR; PG8_SCHED;
            if (last && has_next) { const u32x4 w = *stash; coff[0][0] = w.x; coff[0][1] = w.y; coff[1][0] = w.z; coff[1][1] = w.w; }
            PG8_LDA(At, 0, 1); PG8_STAGEB(PG8_SB(0, 0), b2); PG8_STAGEB(PG8_SB(0, 1), b2 + hstep); PG8_STAGEA(PG8_SA(0, 0), coff[0], ka);
            PG8_WAIT_V(8); PG8_WAIT_L(0); PG8_BAR; PG8_MMA(1, 0, At, B0); PG8_MMA(1, 1, At, B1); PG8_BAR; PG8_SCHED;
            PG8_LDB(B0, 1, 0); PG8_LDB(B1, 1, 1); PG8_SCHED; PG8_LDA(At, 1, 0); PG8_STAGEA(PG8_SA(0, 1), coff[1], ka);
            PG8_WAIT_V(8); PG8_WAIT_L(0); PG8_BAR; PG8_MMA(0, 0, At, B0); PG8_MMA(0, 1, At, B1); PG8_BAR; PG8_SCHED;
            PG8_LDA(At, 1, 1); PG8_STAGEB(PG8_SB(1, 0), b3); PG8_STAGEB(PG8_SB(1, 1), b3 + hstep); PG8_STAGEA(PG8_SA(1, 0), coff[0], ka + 1);
            PG8_WAIT_V(8); PG8_WAIT_L(0); PG8_BAR; PG8_MMA(1, 0, At, B0); PG8_MMA(1, 1, At, B1); PG8_BAR; PG8_SCHED;
            } else {
            PG8_LDB(B0, 0, 0); PG8_SCHED; PG8_LDA(At, 0, 0); PG8_STAGEA(PG8_SA(1, 1), coff[1], t + 1);
            PG8_WAIT_L(8); PG8_BAR; PG8_WAIT_L(0); PG8_MMA(0, 0, At, B0); PG8_BAR; PG8_SCHED;
            if (last && has_next) { const u32x4 w = *stash; coff[0][0] = w.x; coff[0][1] = w.y; coff[1][0] = w.z; coff[1][1] = w.w; }
            PG8_LDB(B1, 0, 1); PG8_STAGEB(PG8_SB(0, 0), b2);
            PG8_BAR; PG8_WAIT_L(0); PG8_MMA(0, 1, At, B1); PG8_BAR;
            PG8_LDA(At, 0, 1); PG8_STAGEA(PG8_SA(0, 0), coff[0], ka);
            PG8_BAR; PG8_WAIT_L(0); PG8_MMA(1, 0, At, B0); PG8_BAR; PG8_SCHED;
            PG8_STAGEB(PG8_SB(0, 1), b2 + hstep);
            PG8_WAIT_V(6); PG8_BAR; PG8_MMA(1, 1, At, B1); PG8_BAR;
            PG8_LDB(B0, 1, 0); PG8_SCHED; PG8_LDA(At, 1, 0); PG8_STAGEA(PG8_SA(0, 1), coff[1], ka);
            PG8_WAIT_L(8); PG8_BAR; PG8_WAIT_L(0); PG8_MMA(0, 0, At, B0); PG8_BAR; PG8_SCHED;
            PG8_LDB(B1, 1, 1); PG8_STAGEB(PG8_SB(1, 0), b3);
            PG8_BAR; PG8_WAIT_L(0); PG8_MMA(0, 1, At, B1); PG8_BAR;
            PG8_LDA(At, 1, 1); PG8_STAGEA(PG8_SA(1, 0), coff[0], ka + 1);
            PG8_BAR; PG8_WAIT_L(0); PG8_MMA(1, 0, At, B0); PG8_BAR; PG8_SCHED;
            PG8_STAGEB(PG8_SB(1, 1), b3 + hstep);
            PG8_WAIT_V(6); PG8_BAR; PG8_MMA(1, 1, At, B1); PG8_BAR;
            }
        }
        if constexpr (ALIGN_EPI) { if (wr == 0) PG8_BAR; }
        asm volatile("" ::: "memory");
        E(acc, cur, wr, wc, fr, fq);
        if (!has_next) break;
#pragma unroll
        for (int a = 0; a < 2; ++a)
#pragma unroll
            for (int b = 0; b < 2; ++b)
#pragma unroll
                for (int m = 0; m < 4; ++m)
#pragma unroll
                    for (int n = 0; n < 2; ++n) acc[a][b][m][n] = (f32x4){0.f, 0.f, 0.f, 0.f};
        cur = nxt; cB = nB; ++ui;
        if constexpr (ALIGN_EPI) { if (wr == 1) PG8_BAR; }
    }
    PG8_WAIT_V(0);
    if constexpr (!ALIGN_EPI) { if (wr == 0) PG8_BAR; }
    PG8_BAR;
#undef PG8_SA
#undef PG8_SB
#undef PG8_STAGEA
#undef PG8_STAGEB
#undef PG8_LDA
#undef PG8_LDB
#undef PG8_MMA
#undef PG8_WAIT_V
#undef PG8_WAIT_L
#undef PG8_BAR
#undef PG8_SCHED
}

struct DenseUnit { int pm, pn; };
struct DenseSched {
    typedef DenseUnit Unit;
    int nM, nN, nwg, G, c, K; const char* Bt;
    __device__ void init(int M, int N, int K_, const void* Bt_, int G_, int c_) { nM = M / BM; nN = N / BM; nwg = nM * nN; G = G_; c = c_; K = K_; Bt = (const char*)Bt_; }
    __device__ __forceinline__ bool next(int i, Unit& u) const {
        const long L = (long)i * G + c; if (L >= nwg) return false;
        int wgid = (int)L; { const int q = nwg / NXCD, r = nwg % NXCD, xcd = wgid % NXCD, off = wgid / NXCD; wgid = (xcd < r ? xcd * (q + 1) : r * (q + 1) + (xcd - r) * q) + off; }
        const int nig = WGM * nN, gid = wgid / nig, fm = gid * WGM, gsz = (nM - fm) < WGM ? (nM - fm) : WGM;
        u.pm = fm + ((wgid % nig) % gsz); u.pn = (wgid % nig) / gsz; return true;
    }
    __device__ __forceinline__ unsigned aoff(const Unit& u, int r) const { return (unsigned)(u.pm * BM + r) * (unsigned)(K * 2); }
    __device__ __forceinline__ const char* bptr(const Unit& u) const { return Bt + (size_t)u.pn * BM * K * 2; }
};

struct MoeUnit { int e, rt, l0, nv, pn; };
template <bool GATHER>
struct MoeSched {
    typedef MoeUnit Unit;
    const LAS int* tst;
    const LAS int* cnt;
    int G, c, NP, K; const int* list; const char* Bt; size_t estride;
    __device__ __forceinline__ bool next(int i, Unit& u) const {
        const int L = i * G + c; const int R = __builtin_amdgcn_readfirstlane(tst[NE]); if (L >= R * NP) return false;
        const int rt = L / NP; u.pn = L % NP;
        int e = 0;
#pragma unroll 1
        for (int j = 1; j < NE; ++j) e = (rt >= __builtin_amdgcn_readfirstlane(tst[j])) ? j : e;
        u.e = e; u.rt = rt; u.l0 = (rt - __builtin_amdgcn_readfirstlane(tst[e])) * BM; const int rem = __builtin_amdgcn_readfirstlane(cnt[e]) - u.l0; u.nv = rem < BM ? rem : BM; return true;
    }
    __device__ __forceinline__ unsigned aoff(const Unit& u, int r) const {
        if (GATHER) { const int j = (r < u.nv) ? (u.l0 + r) : u.l0; const int a = list[(size_t)u.e * TR + j]; return (unsigned)(a >> 2) * (unsigned)(K * 2); }
        else return (unsigned)(u.rt * BM + r) * (unsigned)(K * 2);
    }
    __device__ __forceinline__ const char* bptr(const Unit& u) const { return Bt + (size_t)u.e * estride + (size_t)u.pn * BM * K * 2; }
};

struct EpiProj {
    static constexpr bool PERM = true;
    bf16* O; int ldc;
    __device__ __forceinline__ void operator()(const f32x4 (&acc)[2][2][4][2], const DenseUnit& u, int wr, int wc, int fr, int fq) const {
        const int row0 = u.pm * BM + wr * 64 + fr; const int col0 = u.pn * BM + wc * 32 + 8 * fq;
#pragma unroll
        for (int ai = 0; ai < 2; ++ai)
#pragma unroll
            for (int m = 0; m < 4; ++m) { bf16* rowp = O + (size_t)(row0 + ai * HALF + m * 16) * ldc + col0;
#pragma unroll
                for (int bj = 0; bj < 2; ++bj) { const f32x4 v0 = acc[ai][bj][m][0], v1 = acc[ai][bj][m][1];
                    u32x4 w; w.x = cvt_pk_bf16(v0[0], v0[1]); w.y = cvt_pk_bf16(v0[2], v0[3]); w.z = cvt_pk_bf16(v1[0], v1[1]); w.w = cvt_pk_bf16(v1[2], v1[3]);
                    *(u32x4*)(rowp + bj * HALF) = w; } }
    }
};
struct EpiH1 {
    static constexpr bool PERM = false;
    const float* X; float* H; int ldc;
    __device__ __forceinline__ void operator()(const f32x4 (&acc)[2][2][4][2], const DenseUnit& u, int wr, int wc, int fr, int fq) const {
        const int row0 = u.pm * BM + wr * 64 + fr, col0 = u.pn * BM + wc * 32 + 4 * fq;
#pragma unroll
        for (int ai = 0; ai < 2; ++ai)
#pragma unroll
            for (int m = 0; m < 4; ++m) { const size_t off = (size_t)(row0 + ai * HALF + m * 16) * ldc + col0;
#pragma unroll
                for (int bj = 0; bj < 2; ++bj)
#pragma unroll
                    for (int n = 0; n < 2; ++n) { const f32x4 xv = *(const f32x4*)(X + off + bj * HALF + n * 16); *(f32x4*)(H + off + bj * HALF + n * 16) = xv + acc[ai][bj][m][n]; }
                asm volatile("" ::: "memory"); }
    }
};
__device__ __forceinline__ float swiglu1(float g, float l) {
    g = fminf(g, SW_LIMIT); l = fminf(fmaxf(l, -SW_LIMIT), SW_LIMIT);
    return g * (l + 1.0f) / (1.0f + __expf(-SW_ALPHA * g));
}
struct EpiSwiGLU {
    static constexpr bool PERM = true;
    bf16* ACT; const float* bgu;
    __device__ __forceinline__ void operator()(const f32x4 (&acc)[2][2][4][2], const MoeUnit& u, int wr, int wc, int fr, int fq) const {
        const int row0 = u.rt * BM + wr * 64 + fr; const int j0 = u.pn * HALF + wc * 32 + 8 * fq;
        const float* bg = bgu + (size_t)u.e * 2048 + j0;
        const f32x4 g0 = *(const f32x4*)(bg), g1 = *(const f32x4*)(bg + 4), l0 = *(const f32x4*)(bg + 1024), l1 = *(const f32x4*)(bg + 1028);
#pragma unroll
        for (int ai = 0; ai < 2; ++ai)
#pragma unroll
            for (int m = 0; m < 4; ++m) { bf16* rowp = ACT + (size_t)(row0 + ai * HALF + m * 16) * 1024 + j0;
                const f32x4 a0 = acc[ai][0][m][0] + g0, a1 = acc[ai][0][m][1] + g1, b0 = acc[ai][1][m][0] + l0, b1 = acc[ai][1][m][1] + l1;
                u32x4 w; w.x = cvt_pk_bf16(swiglu1(a0[0], b0[0]), swiglu1(a0[1], b0[1])); w.y = cvt_pk_bf16(swiglu1(a0[2], b0[2]), swiglu1(a0[3], b0[3]));
                w.z = cvt_pk_bf16(swiglu1(a1[0], b1[0]), swiglu1(a1[1], b1[1])); w.w = cvt_pk_bf16(swiglu1(a1[2], b1[2]), swiglu1(a1[3], b1[3]));
                *(u32x4*)rowp = w; }
    }
};
struct EpiDown {
    static constexpr bool PERM = true;
    bf16* YE; const float* bdn; const int* list; const float* gate;
    __device__ __forceinline__ void operator()(const f32x4 (&acc)[2][2][4][2], const MoeUnit& u, int wr, int wc, int fr, int fq) const {
        const int col0 = u.pn * BM + wc * 32 + 8 * fq;
        const float* bb = bdn + (size_t)u.e * 1024 + col0;
        f32x4 bv[2][2];
#pragma unroll
        for (int bj = 0; bj < 2; ++bj)
#pragma unroll
            for (int n = 0; n < 2; ++n) bv[bj][n] = *(const f32x4*)(bb + bj * HALF + 4 * n);
#pragma unroll
        for (int ai = 0; ai < 2; ++ai)
#pragma unroll
            for (int m = 0; m < 4; ++m) { const int r = ai * HALF + wr * 64 + m * 16 + fr;
                if (r < u.nv) { const int a = list[(size_t)u.e * TR + u.l0 + r]; const float g = gate[a]; bf16* rowp = YE + (size_t)a * 1024 + col0;
#pragma unroll
                    for (int bj = 0; bj < 2; ++bj) { const f32x4 v0 = (acc[ai][bj][m][0] + bv[bj][0]) * g, v1 = (acc[ai][bj][m][1] + bv[bj][1]) * g;
                        u32x4 w; w.x = cvt_pk_bf16(v0[0], v0[1]); w.y = cvt_pk_bf16(v0[2], v0[3]); w.z = cvt_pk_bf16(v1[0], v1[1]); w.w = cvt_pk_bf16(v1[2], v1[3]);
                        *(u32x4*)(rowp + bj * HALF) = w; } } }
    }
};
}

constexpr int NWAVES = 8;
constexpr int RING_OFF = 0, RING_BYTES = 131072;
constexpr int LDSCTL_OFF = RING_BYTES;
constexpr int MISC_OFF = LDSCTL_OFF + 320;
constexpr int MOE_OFF = LDSCTL_OFF + 512;
constexpr int RT_OFF = LDSCTL_OFF + 1024;
constexpr int LDS_BYTES = 147456;

#define XB_TMO      128
#define XB_XCNT(j)  (256  + 64 * (j))
#define XB_XSUB(j)  (1280 + 64 * (j))
#define XB_XGEN(j)  (2304 + 64 * (j))
#define XB_TOP      3328
#define XB_TOPGEN   3392
#define XCD_BAR_WORDS 3456
#define XB_SPIN_CAP (1u << 18)
__device__ __forceinline__ unsigned xb_ld(unsigned* p)              { return __hip_atomic_load(p, __ATOMIC_RELAXED, __HIP_MEMORY_SCOPE_AGENT); }
__device__ __forceinline__ unsigned xb_add(unsigned* p, unsigned v) { return __hip_atomic_fetch_add(p, v, __ATOMIC_RELAXED, __HIP_MEMORY_SCOPE_AGENT); }
__device__ __forceinline__ unsigned xb_xcc_id() { return (unsigned)__builtin_amdgcn_s_getreg((3 << 11) | 20) & 0xFu; }
#define XB_SPIN(cond, bar) do { unsigned _sp = 0; while (cond) { __builtin_amdgcn_s_sleep(1); \
    if ((++_sp & 255u) == 0u) { if (xb_ld(&(bar)[XB_TMO])) break; if (_sp > XB_SPIN_CAP) { atomicAdd(&(bar)[XB_TMO], 1u); break; } } } } while (0)
struct XcdBarrier { unsigned* bar; unsigned x; volatile LAS unsigned* st; };
__device__ __forceinline__ XcdBarrier xcd_barrier_post(unsigned* bar, volatile LAS unsigned* st) {
    XcdBarrier b; b.bar = bar; b.x = xb_xcc_id(); b.st = st;
    if (threadIdx.x == 0) (void)xb_add(&bar[XB_XCNT(b.x)], 1u);
    return b;
}
__device__ __forceinline__ void xcd_barrier_complete(unsigned* bar, unsigned x, unsigned& nloc, unsigned& nx) {
    const unsigned G = gridDim.x * gridDim.y * gridDim.z;
    unsigned sum, cnt, mine, sp = 0u;
    for (;;) {
        sum = 0u; cnt = 0u; mine = 0u;
#pragma unroll
        for (unsigned j = 0; j < 16; ++j) { const unsigned c = xb_ld(&bar[XB_XCNT(j)]); sum += c; cnt += (c > 0u) ? 1u : 0u; mine = (j == x) ? c : mine; }
        if (sum == G) break;
        __builtin_amdgcn_s_sleep(1);
        if ((++sp & 255u) == 0u) { if (xb_ld(&bar[XB_TMO])) break; if (sp > XB_SPIN_CAP) { atomicAdd(&bar[XB_TMO], 1u); break; } }
    }
    nloc = mine > 0u ? mine : 1u; nx = cnt > 0u ? cnt : 1u;
}
__device__ __forceinline__ void xcd_barrier(const XcdBarrier& b) {
    asm volatile("s_waitcnt vmcnt(0)" ::: "memory");
    __syncthreads();
    if (threadIdx.x == 0) {
        unsigned* bar = b.bar;
        __builtin_amdgcn_s_waitcnt(0);
        unsigned nloc = b.st[0], nx = b.st[1];
        if (nloc == 0u) { xcd_barrier_complete(bar, b.x, nloc, nx); b.st[0] = nloc; b.st[1] = nx; }
        const unsigned old = xb_add(&bar[XB_XSUB(b.x)], 1u);
        const unsigned gen = old / nloc;
        if (old + 1u == (gen + 1u) * nloc) {
            __builtin_amdgcn_fence(__ATOMIC_RELEASE, "agent");
            asm volatile("s_waitcnt vmcnt(0)" ::: "memory");
            const unsigned og = xb_add(&bar[XB_TOP], 1u);
            const unsigned tg = og / nx;
            if (og + 1u == (tg + 1u) * nx) xb_add(&bar[XB_TOPGEN], 1u);
            else XB_SPIN(xb_ld(&bar[XB_TOPGEN]) == tg, bar);
            __builtin_amdgcn_fence(__ATOMIC_ACQUIRE, "agent");
            xb_add(&bar[XB_XGEN(b.x)], 1u);
            asm volatile("s_waitcnt vmcnt(0)" ::: "memory");
        } else {
            XB_SPIN(xb_ld(&bar[XB_XGEN(b.x)]) == gen, bar);
            __builtin_amdgcn_fence(__ATOMIC_ACQUIRE, "agent");
            asm volatile("s_waitcnt vmcnt(0)" ::: "memory");
        }
    }
    __syncthreads();
}

struct Args { const float* in[21]; float* out; unsigned char* ws; int ph_lo, ph_hi; };
enum { I_X = 0, I_META, I_NMIX, I_WIN, I_CSW, I_CNW, I_SCW, I_SCB, I_DTB, I_ALOG, I_SD, I_SNW, I_WOUT, I_NFFN, I_RW, I_RB, I_WGU, I_BGU, I_WDN, I_BDN, I_NFIN };

__device__ __forceinline__ void p0_transpose_item(const float* W, int ldw, int K, const float* kscale, bf16* WT, int row_off, int k0, int n0, LAS float* scr, int lane) {
#pragma unroll 8
    for (int i = 0; i < 32; ++i) { const int kk = 2 * i + (lane >> 5); float v = W[(size_t)(k0 + kk) * ldw + n0 + (lane & 31)]; if (kscale) v *= kscale[k0 + kk]; scr[kk * 33 + (lane & 31)] = v; }
    LDS_WAIT(); asm volatile("" ::: "memory");
    const int c = lane & 7;
#pragma unroll
    for (int j = 0; j < 4; ++j) { const int n = (lane >> 3) + 8 * j; const LAS float* s = scr + (8 * c) * 33 + n;
        u32x4 o; o.x = pk2(s[0 * 33], s[1 * 33]); o.y = pk2(s[2 * 33], s[3 * 33]); o.z = pk2(s[4 * 33], s[5 * 33]); o.w = pk2(s[6 * 33], s[7 * 33]);
        *(u32x4*)(WT + (size_t)(row_off + n) * K + k0 + 8 * c) = o; }
    LDS_WAIT(); asm volatile("" ::: "memory");
}

__device__ __forceinline__ void p0_prologue(const Args& A, LAS unsigned char* lds, int vcu, int G, int tid, int lane, int wave) {
    unsigned char* ws = A.ws;
    LAS float* scr = (LAS float*)(lds + RING_OFF + wave * 16384);
    const int gw = vcu * NWAVES + wave, NGW = G * NWAVES;
    constexpr int I_IN = 16 * 192, I_OUT = 32 * 32, I_GU = 32 * 16 * 64, I_DN = 32 * 16 * 32;
    constexpr int NITEMS = I_IN + I_OUT + I_GU + I_DN;
    for (int it = gw; it < NITEMS; it += NGW) {
        int r = it;
        if (r < I_IN) { const int kb = r / 192, nb = r % 192; p0_transpose_item(A.in[I_WIN], WIN_LD, 1024, A.in[I_NMIX], (bf16*)(ws + WS_WIN), 32 * nb, 64 * kb, 32 * nb, scr, lane); continue; } r -= I_IN;
        if (r < I_OUT) { const int kb = r / 32, nb = r % 32; const float* ks = (kb < 16) ? A.in[I_CNW] : (A.in[I_SNW] - 1024);
            p0_transpose_item(A.in[I_WOUT], 1024, 2048, ks, (bf16*)(ws + WS_WOUT), 32 * nb, 64 * kb, 32 * nb, scr, lane); continue; } r -= I_OUT;
        if (r < I_GU) { const int e = r >> 10, q = r & 1023, kb = q >> 6, nb = q & 63; const int n0 = 32 * nb;
            const int bj = n0 >> 10, j = n0 & 1023, pn = j >> 7, jj = j & 127; const int rho = 256 * pn + 128 * bj + jj;
            p0_transpose_item(A.in[I_WGU] + (size_t)e * 1024 * 2048, 2048, 1024, A.in[I_NFFN], (bf16*)(ws + WS_WGU) + (size_t)e * 2048 * 1024, rho, 64 * kb, n0, scr, lane); continue; } r -= I_GU;
        { const int e = r >> 9, q = r & 511, kb = q >> 5, nb = q & 31;
            p0_transpose_item(A.in[I_WDN] + (size_t)e * 1024 * 1024, 1024, 1024, nullptr, (bf16*)(ws + WS_WDN) + (size_t)e * 1024 * 1024, 32 * nb, 64 * kb, 32 * nb, scr, lane); }
    }
    __syncthreads();
    LAS float* wdt = (LAS float*)(lds + RING_OFF);
    for (int idx = tid; idx < 16 * 1024; idx += NWAVES * 64) { const int d = idx >> 4, j = idx & 15; wdt[j * 1024 + d] = A.in[I_WIN][(size_t)d * WIN_LD + NPROJ + j] * A.in[I_NMIX][d]; }
    LDS_WAIT(); __syncthreads();
    bf16* XN = (bf16*)(ws + WS_XN); float* DT = (float*)(ws + WS_DT);
    for (int m = gw; m < TA; m += NGW) {
        const float* src = (m < TR) ? A.in[I_X] + (size_t)m * D : ((m < MROW + NMETA) ? A.in[I_META] + (size_t)(m - MROW) * D : nullptr);
        f32x4 v[4]; float s = 0.f;
#pragma unroll
        for (int j = 0; j < 4; ++j) { v[j] = src ? *((const f32x4*)src + 64 * j + lane) : (f32x4){0.f, 0.f, 0.f, 0.f}; s += (v[j].x * v[j].x + v[j].y * v[j].y) + (v[j].z * v[j].z + v[j].w * v[j].w); }
        const float rstd = 1.0f / sqrtf(wave_sum(s) * (1.0f / D) + EPS);
        u32x2* o8 = (u32x2*)(XN + (size_t)m * D) + lane;
#pragma unroll
        for (int j = 0; j < 4; ++j) { u32x2 w; w.x = pk2(v[j].x * rstd, v[j].y * rstd); w.y = pk2(v[j].z * rstd, v[j].w * rstd); o8[64 * j] = w; }
        float mine = 0.f;
#pragma unroll 2
        for (int jj = 0; jj < 16; ++jj) { float a = 0.f;
#pragma unroll
            for (int j = 0; j < 4; ++j) { const f32x4 w = *(const LAS f32x4*)(wdt + jj * 1024 + 256 * j + 4 * lane); a += (v[j].x * w.x + v[j].y * w.y) + (v[j].z * w.z + v[j].w * w.w); }
            a = wave_sum(a); mine = (lane == jj) ? a : mine; }
        if (lane < 16) DT[(size_t)m * 16 + lane] = mine * rstd;
    }
}

__device__ __forceinline__ void p4_router(const Args& A, LAS unsigned char* lds, int vcu, int G, int tid, int lane, int wave) {
    unsigned char* ws = A.ws;
    const float* H1 = (const float*)(ws + WS_H1); bf16* XN2 = (bf16*)(ws + WS_XN);
    int* LIST = (int*)(ws + WS_LIST); float* GATE = (float*)(ws + WS_GATE); unsigned* CNT = (unsigned*)(ws + WS_CTL) + CW_CNT;
    LAS float* rwt = (LAS float*)(lds + RING_OFF);
    LAS int* sel_e = (LAS int*)(lds + RT_OFF); LAS float* sel_g = (LAS float*)(lds + RT_OFF + 2048); LAS int* rnk = (LAS int*)(lds + RT_OFF + 4096);
    LAS int* cnt_loc = (LAS int*)(lds + RT_OFF + 6144); LAS int* base_loc = (LAS int*)(lds + RT_OFF + 6144 + 128);
    for (int idx = tid; idx < 32 * 1024; idx += NWAVES * 64) { const int d = idx >> 5, e = idx & 31; rwt[e * 1024 + d] = A.in[I_RW][(size_t)d * 32 + e] * A.in[I_NFFN][d]; }
    LDS_WAIT(); __syncthreads();
    float rb[32];
#pragma unroll
    for (int e = 0; e < 32; ++e) rb[e] = A.in[I_RB][e];
    for (int ch = vcu; ch < TR / 128; ch += G) {
        if (tid < 32) cnt_loc[tid] = 0;
        LDS_WAIT(); __syncthreads();
        for (int q = 0; q < 16; ++q) {
            const int tl = wave * 16 + q, t = ch * 128 + tl;
            f32x4 v[4]; float s = 0.f;
#pragma unroll
            for (int j = 0; j < 4; ++j) { v[j] = *((const f32x4*)(H1 + (size_t)t * D) + 64 * j + lane); s += (v[j].x * v[j].x + v[j].y * v[j].y) + (v[j].z * v[j].z + v[j].w * v[j].w); }
            const float rstd = 1.0f / sqrtf(wave_sum(s) * (1.0f / D) + EPS);
            u32x2* o8 = (u32x2*)(XN2 + (size_t)t * D) + lane;
#pragma unroll
            for (int j = 0; j < 4; ++j) { u32x2 w; w.x = pk2(v[j].x * rstd, v[j].y * rstd); w.y = pk2(v[j].z * rstd, v[j].w * rstd); o8[64 * j] = w; }
            float lg[32];
#pragma unroll
            for (int e = 0; e < 32; ++e) { float a = 0.f;
#pragma unroll
                for (int j = 0; j < 4; ++j) { const f32x4 w = *(const LAS f32x4*)(rwt + e * 1024 + 256 * j + 4 * lane); a += (v[j].x * w.x + v[j].y * w.y) + (v[j].z * w.z + v[j].w * w.w); }
                lg[e] = wave_sum(a) * rstd + rb[e]; }
            float tv[4]; int ti[4];
#pragma unroll
            for (int k = 0; k < 4; ++k) { float best = lg[0]; int bi = 0;
#pragma unroll
                for (int e = 1; e < 32; ++e) { const bool gt = lg[e] > best; best = gt ? lg[e] : best; bi = gt ? e : bi; }
                tv[k] = best; ti[k] = bi;
#pragma unroll
                for (int e = 0; e < 32; ++e) lg[e] = (e == bi) ? -3.0e38f : lg[e]; }
            const float e1 = __expf(tv[1] - tv[0]), e2 = __expf(tv[2] - tv[0]), e3 = __expf(tv[3] - tv[0]); const float inv = 1.0f / (1.0f + e1 + e2 + e3);
            if (lane < 4) { const int e = lane == 0 ? ti[0] : (lane == 1 ? ti[1] : (lane == 2 ? ti[2] : ti[3]));
                const float g = (lane == 0 ? 1.0f : (lane == 1 ? e1 : (lane == 2 ? e2 : e3))) * inv;
                const int r = __hip_atomic_fetch_add(cnt_loc + e, 1, __ATOMIC_RELAXED, __HIP_MEMORY_SCOPE_WORKGROUP);
                sel_e[tl * 4 + lane] = e; sel_g[tl * 4 + lane] = g; rnk[tl * 4 + lane] = r; }
        }
        LDS_WAIT(); __syncthreads();
        if (tid < 32) base_loc[tid] = (int)__hip_atomic_fetch_add(CNT + tid, (unsigned)cnt_loc[tid], __ATOMIC_RELAXED, __HIP_MEMORY_SCOPE_AGENT);
        LDS_WAIT(); __syncthreads();
        { const int e = sel_e[tid]; const int pos = base_loc[e] + rnk[tid]; const int a = (ch * 128) * 4 + tid; LIST[(size_t)e * TR + pos] = a; GATE[a] = sel_g[tid]; }
        __syncthreads();
    }
}

__device__ __forceinline__ void p7_final(const Args& A, int vcu, int G, int lane, int wave) {
    unsigned char* ws = A.ws;
    const float* H1 = (const float*)(ws + WS_H1); const bf16* YE = (const bf16*)(ws + WS_YE);
    const int gw = vcu * NWAVES + wave, NGW = G * NWAVES;
    f32x4 wf[4];
#pragma unroll
    for (int j = 0; j < 4; ++j) wf[j] = *((const f32x4*)A.in[I_NFIN] + 64 * j + lane);
    for (int t = gw; t < TR; t += NGW) {
        f32x4 v[4]; float s = 0.f;
#pragma unroll
        for (int j = 0; j < 4; ++j) v[j] = *((const f32x4*)(H1 + (size_t)t * D) + 64 * j + lane);
#pragma unroll
        for (int k = 0; k < 4; ++k) { const u32x2* yr = (const u32x2*)(YE + ((size_t)t * 4 + k) * D) + lane;
#pragma unroll
            for (int j = 0; j < 4; ++j) { const u32x2 w = yr[64 * j]; v[j].x += bflo(w.x); v[j].y += bfhi(w.x); v[j].z += bflo(w.y); v[j].w += bfhi(w.y); } }
#pragma unroll
        for (int j = 0; j < 4; ++j) s += (v[j].x * v[j].x + v[j].y * v[j].y) + (v[j].z * v[j].z + v[j].w * v[j].w);
        const float rstd = 1.0f / sqrtf(wave_sum(s) * (1.0f / D) + EPS);
        f32x4* o = (f32x4*)(A.out + (size_t)t * D) + lane;
#pragma unroll
        for (int j = 0; j < 4; ++j) o[64 * j] = v[j] * rstd * wf[j];
    }
}

__device__ __forceinline__ void moe_tables(const Args& A, LAS unsigned char* lds, int tid) {
    LAS int* tst = (LAS int*)(lds + MOE_OFF); LAS int* cnt = tst + 40;
    const unsigned* CNT = (const unsigned*)(A.ws + WS_CTL) + CW_CNT;
    if (tid < 32) cnt[tid] = (int)__hip_atomic_load(CNT + tid, __ATOMIC_RELAXED, __HIP_MEMORY_SCOPE_AGENT);
    LDS_WAIT(); __syncthreads();
    if (tid == 0) { int s = 0; for (int e = 0; e < NE; ++e) { tst[e] = s; s += (cnt[e] + 255) >> 8; } tst[NE] = s; }
    LDS_WAIT(); __syncthreads();
}

enum { PH_PREP = 0, PH_INPROJ, PH_MIX, PH_OUTPROJ, PH_ROUTER, PH_GU, PH_DOWN, PH_FINAL, PH_N };
__global__ void __launch_bounds__(NWAVES * 64, 2) mk_fwd(Args args) {
    extern __shared__ __attribute__((aligned(16))) unsigned char lds_raw[];
    LAS unsigned char* lds = (LAS unsigned char*)lds_raw;
    const int tid = threadIdx.x, lane = tid & 63, wave = __builtin_amdgcn_readfirstlane(tid >> 6);
    const int G = gridDim.x; const int bx = blockIdx.x; const int vcu = (G % 8 == 0) ? (bx % 8) * (G / 8) + bx / 8 : bx;
    unsigned char* ws = args.ws;
    for (int u = tid; u < (LDS_BYTES - LDSCTL_OFF) / 4; u += NWAVES * 64) ((LAS unsigned*)(lds + LDSCTL_OFF))[u] = 0u;
    __syncthreads();
    const int lo = args.ph_lo, hi = args.ph_hi;
    const bool multi = (hi - lo) > 1;
    XcdBarrier bar; bar.bar = (unsigned*)(ws + WS_CTL) + CW_BAR; bar.x = 0; bar.st = nullptr;
    if (multi) bar = xcd_barrier_post((unsigned*)(ws + WS_CTL) + CW_BAR, (volatile LAS unsigned*)(lds + MISC_OFF) + 8);
#ifndef PHASE_MASK
#define PHASE_MASK 0xffff
#endif
#define IN(k) (((PHASE_MASK >> (k)) & 1) && lo <= (k) && (k) < hi)
#define SEAM(k) do { if (IN(k) && IN((k) + 1)) xcd_barrier(bar); } while (0)

    if (IN(PH_PREP)) { p0_prologue(args, lds, vcu, G, tid, lane, wave); __syncthreads(); SEAM(PH_PREP); }

    if (IN(PH_INPROJ)) {
        pg8::DenseSched S; S.init(TA, NPROJ, 1024, ws + WS_WIN, G, bx);
        pg8::EpiProj E{(bf16*)(ws + WS_PROJ), NPROJ};
        pg8::gemm_phase<pg8::EpiProj, pg8::DenseSched, true, true>(lds + RING_OFF, (const char*)(ws + WS_XN), 1024, S, E);
        SEAM(PH_INPROJ);
    }
    if (IN(PH_MIX)) { SEAM(PH_MIX); }
    if (IN(PH_OUTPROJ)) {
        pg8::DenseSched S; S.init(TR, 1024, 2048, ws + WS_WOUT, G, bx);
        pg8::EpiH1 E{args.in[I_X], (float*)(ws + WS_H1), 1024};
        pg8::gemm_phase<pg8::EpiH1, pg8::DenseSched, true, true>(lds + RING_OFF, (const char*)(ws + WS_Y), 2048, S, E);
        SEAM(PH_OUTPROJ);
    }
    if (IN(PH_ROUTER)) { p4_router(args, lds, vcu, G, tid, lane, wave); SEAM(PH_ROUTER); }
    if (IN(PH_GU)) {
        moe_tables(args, lds, tid);
        pg8::MoeSched<true> S; S.tst = (const LAS int*)(lds + MOE_OFF); S.cnt = S.tst + 40; S.G = G; S.c = bx; S.NP = 8; S.K = 1024; S.list = (const int*)(ws + WS_LIST);
        S.Bt = (const char*)(ws + WS_WGU); S.estride = (size_t)2048 * 1024 * 2;
        pg8::EpiSwiGLU E{(bf16*)(ws + WS_ACT), args.in[I_BGU]};
        pg8::gemm_phase<pg8::EpiSwiGLU, pg8::MoeSched<true>, true, true>(lds + RING_OFF, (const char*)(ws + WS_XN), 1024, S, E);
        SEAM(PH_GU);
    }
    if (IN(PH_DOWN)) {
        moe_tables(args, lds, tid);
        pg8::MoeSched<false> S; S.tst = (const LAS int*)(lds + MOE_OFF); S.cnt = S.tst + 40; S.G = G; S.c = bx; S.NP = 4; S.K = 1024; S.list = (const int*)(ws + WS_LIST);
        S.Bt = (const char*)(ws + WS_WDN); S.estride = (size_t)1024 * 1024 * 2;
        pg8::EpiDown E{(bf16*)(ws + WS_YE), args.in[I_BDN], (const int*)(ws + WS_LIST), (const float*)(ws + WS_GATE)};
        pg8::gemm_phase<pg8::EpiDown, pg8::MoeSched<false>, true, true>(lds + RING_OFF, (const char*)(ws + WS_ACT), 1024, S, E);
        SEAM(PH_DOWN);
    }
    if (IN(PH_FINAL)) { p7_final(args, vcu, G, lane, wave); }
#undef IN
#undef SEAM
}

__global__ void __launch_bounds__(256) k_conv_branch(const bf16* __restrict__ PROJ, const float* __restrict__ cw, bf16* __restrict__ Y) {
    const int m = blockIdx.x * 4 + (threadIdx.x >> 6), lane = threadIdx.x & 63;
    const int b = m / SEQ, s = m % SEQ, l = s + NMETA;
    const int r0 = row_of(b, l), r1 = row_of(b, l - 1), r2 = row_of(b, l - 2);
#pragma unroll
    for (int j = 0; j < 4; ++j) {
        const int c = 256 * j + 4 * lane;
        const u32x2 cb = *(const u32x2*)(PROJ + (size_t)r0 * NPROJ + C_CB + c);
        const u32x2 c0 = *(const u32x2*)(PROJ + (size_t)r0 * NPROJ + C_CC + c), x0 = *(const u32x2*)(PROJ + (size_t)r0 * NPROJ + C_CX + c);
        const u32x2 c1 = *(const u32x2*)(PROJ + (size_t)r1 * NPROJ + C_CC + c), x1 = *(const u32x2*)(PROJ + (size_t)r1 * NPROJ + C_CX + c);
        const u32x2 c2 = *(const u32x2*)(PROJ + (size_t)r2 * NPROJ + C_CC + c), x2 = *(const u32x2*)(PROJ + (size_t)r2 * NPROJ + C_CX + c);
        const f32x4 w0 = *(const f32x4*)(cw + c), w1 = *(const f32x4*)(cw + 1024 + c), w2 = *(const f32x4*)(cw + 2048 + c);
        float y[4];
        y[0] = bflo(cb.x) * (w0.x * bflo(c2.x) * bflo(x2.x) + w1.x * bflo(c1.x) * bflo(x1.x) + w2.x * bflo(c0.x) * bflo(x0.x));
        y[1] = bfhi(cb.x) * (w0.y * bfhi(c2.x) * bfhi(x2.x) + w1.y * bfhi(c1.x) * bfhi(x1.x) + w2.y * bfhi(c0.x) * bfhi(x0.x));
        y[2] = bflo(cb.y) * (w0.z * bflo(c2.y) * bflo(x2.y) + w1.z * bflo(c1.y) * bflo(x1.y) + w2.z * bflo(c0.y) * bflo(x0.y));
        y[3] = bfhi(cb.y) * (w0.w * bfhi(c2.y) * bfhi(x2.y) + w1.w * bfhi(c1.y) * bfhi(x1.y) + w2.w * bfhi(c0.y) * bfhi(x0.y));
        float ss = (y[0] * y[0] + y[1] * y[1]) + (y[2] * y[2] + y[3] * y[3]);
#pragma unroll
        for (int o = 1; o < 32; o <<= 1) ss += __shfl_xor(ss, o);
        const float rstd = 1.0f / sqrtf(ss * (1.0f / 128.0f) + EPS);
        u32x2 w; w.x = pk2(y[0] * rstd, y[1] * rstd); w.y = pk2(y[2] * rstd, y[3] * rstd);
        *(u32x2*)(Y + (size_t)m * DMIX + c) = w;
    }
}
__global__ void __launch_bounds__(256) k_xbc_act(const bf16* __restrict__ PROJ, const float* __restrict__ cw, const float* __restrict__ cb, bf16* __restrict__ XBCA) {
    const int m = blockIdx.x * 4 + (threadIdx.x >> 6), lane = threadIdx.x & 63;
    if (m >= MROW + NMETA) return;
    int b, l; if (m < TR) { b = m / SEQ; l = (m % SEQ) + NMETA; } else { b = 0; l = m - MROW; }
    int rk[4];
#pragma unroll
    for (int k = 0; k < 4; ++k) { const int lk = l - 3 + k; rk[k] = lk >= 0 ? row_of(b, lk) : -1; }
#pragma unroll
    for (int j = 0; j < 8; ++j) {
        const int c = 256 * j + 4 * lane;
        f32x4 a = *(const f32x4*)(cb + c);
#pragma unroll
        for (int k = 0; k < 4; ++k) if (rk[k] >= 0) { const u32x2 u = *(const u32x2*)(PROJ + (size_t)rk[k] * NPROJ + C_XS + c); const f32x4 w = *(const f32x4*)(cw + k * 2048 + c);
            a.x += w.x * bflo(u.x); a.y += w.y * bfhi(u.x); a.z += w.z * bflo(u.y); a.w += w.w * bfhi(u.y); }
        u32x2 o; o.x = pk2(silu_f(a.x), silu_f(a.y)); o.y = pk2(silu_f(a.z), silu_f(a.w));
        *(u32x2*)(XBCA + (size_t)m * 2048 + c) = o;
    }
}
__global__ void __launch_bounds__(64) k_ssd_naive(const bf16* __restrict__ XBCA, const bf16* __restrict__ PROJ, const float* __restrict__ DT, const float* __restrict__ dt_bias,
                                                   const float* __restrict__ a_log, const float* __restrict__ dpar, bf16* __restrict__ YPRE) {
    const int b = blockIdx.x >> 4, h = blockIdx.x & 15, g = h >> 2, p = threadIdx.x;
    const float Aneg = -__expf(a_log[h]), dtb = dt_bias[h], Dh = dpar[h];
    float S[128];
#pragma unroll
    for (int n = 0; n < 128; ++n) S[n] = 0.f;
    int row = row_of(b, 0);
    float n_draw = DT[(size_t)row * 16 + h]; unsigned short n_x = XBCA[(size_t)row * 2048 + h * 64 + p];
    unsigned n_bw = *(const unsigned*)(XBCA + (size_t)row * 2048 + 1024 + g * 128 + 2 * p), n_cw = *(const unsigned*)(XBCA + (size_t)row * 2048 + 1536 + g * 128 + 2 * p);
    unsigned short n_z = PROJ[(size_t)row * NPROJ + C_Z + h * 64 + p];
    for (int l = 0; l < LSEQ; ++l) {
        const int crow = row; const float draw = n_draw + dtb; const float xv = bf2f(n_x); const unsigned bw = n_bw, cw = n_cw; const float z = bf2f(n_z);
        if (l + 1 < LSEQ) { row = row_of(b, l + 1);
            n_draw = DT[(size_t)row * 16 + h]; n_x = XBCA[(size_t)row * 2048 + h * 64 + p];
            n_bw = *(const unsigned*)(XBCA + (size_t)row * 2048 + 1024 + g * 128 + 2 * p); n_cw = *(const unsigned*)(XBCA + (size_t)row * 2048 + 1536 + g * 128 + 2 * p);
            n_z = PROJ[(size_t)row * NPROJ + C_Z + h * 64 + p]; }
        const float dtv = draw > 20.f ? draw : log1pf(__expf(draw));
        const float dec = __expf(dtv * Aneg), xdt = xv * dtv;
        float y = 0.f;
#pragma unroll
        for (int n = 0; n < 128; n += 2) {
            const unsigned bb = (unsigned)__builtin_amdgcn_readlane((int)bw, n >> 1), cc = (unsigned)__builtin_amdgcn_readlane((int)cw, n >> 1);
            S[n] = S[n] * dec + xdt * bflo(bb); y += S[n] * bflo(cc);
            S[n + 1] = S[n + 1] * dec + xdt * bfhi(bb); y += S[n + 1] * bfhi(cc);
        }
        if (l >= NMETA) { const float yg = (y + Dh * xv) * silu_f(z); YPRE[(size_t)crow * 1024 + h * 64 + p] = (bf16)f2bf(yg); }
    }
}
__global__ void __launch_bounds__(256) k_ssd_norm(const bf16* __restrict__ YPRE, bf16* __restrict__ Y) {
    const int m = blockIdx.x * 4 + (threadIdx.x >> 6), lane = threadIdx.x & 63;
#pragma unroll
    for (int j = 0; j < 4; ++j) {
        const int c = 256 * j + 4 * lane;
        const u32x2 u = *(const u32x2*)(YPRE + (size_t)m * 1024 + c);
        const float y0 = bflo(u.x), y1 = bfhi(u.x), y2 = bflo(u.y), y3 = bfhi(u.y);
        const float ss = wave_sum((y0 * y0 + y1 * y1) + (y2 * y2 + y3 * y3));
        const float rstd = 1.0f / sqrtf(ss * (1.0f / 256.0f) + EPS);
        u32x2 w; w.x = pk2(y0 * rstd, y1 * rstd); w.y = pk2(y2 * rstd, y3 * rstd);
        *(u32x2*)(Y + (size_t)m * DMIX + 1024 + c) = w;
    }
}

extern "C" void kernel_launch(void* const* d_in, const int* in_sizes, int n_in, void* d_out, int out_size, void* d_ws, size_t ws_size, hipStream_t stream) {
    static int grid = 0;
    if (grid == 0) {
        if (n_in != 21 || in_sizes[0] != TR * D || out_size != TR * D || ws_size < WS_END) { fprintf(stderr, "kernel_launch: unexpected problem shape (n_in %d, in0 %d, out %d, ws %zu)\n", n_in, n_in > 0 ? in_sizes[0] : -1, out_size, ws_size); grid = -1; return; }
        int dev = 0, cus = 0, per_cu = 0;
        if (hipGetDevice(&dev) != hipSuccess || hipDeviceGetAttribute(&cus, hipDeviceAttributeMultiprocessorCount, dev) != hipSuccess) { grid = -1; return; }
        if (hipFuncSetAttribute((const void*)mk_fwd, hipFuncAttributeMaxDynamicSharedMemorySize, LDS_BYTES) != hipSuccess) { fprintf(stderr, "kernel_launch: hipFuncSetAttribute failed\n"); grid = -1; return; }
        if (hipOccupancyMaxActiveBlocksPerMultiprocessor(&per_cu, (const void*)mk_fwd, NWAVES * 64, LDS_BYTES) != hipSuccess || per_cu < 1) { fprintf(stderr, "kernel_launch: occupancy query says %d\n", per_cu); per_cu = 1; }
        (void)hipGetLastError();
        grid = cus;
    }
    if (grid < 0) return;
    (void)hipMemsetAsync((char*)d_ws + WS_CTL, 0, CTL_ZERO_BYTES, stream);
    Args a{};
    for (int i = 0; i < 21; ++i) a.in[i] = (const float*)d_in[i];
    a.out = (float*)d_out; a.ws = (unsigned char*)d_ws;
    unsigned char* ws = (unsigned char*)d_ws;
    auto launch = [&](int lo, int hi) { a.ph_lo = lo; a.ph_hi = hi; hipLaunchKernelGGL(mk_fwd, dim3(grid), dim3(NWAVES * 64), LDS_BYTES, stream, a); };
    launch(PH_PREP, PH_PREP + 1);
    launch(PH_INPROJ, PH_INPROJ + 1);
    hipLaunchKernelGGL(k_conv_branch, dim3(TR / 4), dim3(256), 0, stream, (const bf16*)(ws + WS_PROJ), a.in[I_CSW], (bf16*)(ws + WS_Y));
    hipLaunchKernelGGL(k_xbc_act, dim3(TA / 4), dim3(256), 0, stream, (const bf16*)(ws + WS_PROJ), a.in[I_SCW], a.in[I_SCB], (bf16*)(ws + WS_XBCA));
    hipLaunchKernelGGL(k_ssd_naive, dim3(256), dim3(64), 0, stream, (const bf16*)(ws + WS_XBCA), (const bf16*)(ws + WS_PROJ), (const float*)(ws + WS_DT), a.in[I_DTB], a.in[I_ALOG], a.in[I_SD], (bf16*)(ws + WS_XN));
    hipLaunchKernelGGL(k_ssd_norm, dim3(TR / 4), dim3(256), 0, stream, (const bf16*)(ws + WS_XN), (bf16*)(ws + WS_Y));
    launch(PH_OUTPROJ, PH_OUTPROJ + 1);
    launch(PH_ROUTER, PH_ROUTER + 1);
    launch(PH_GU, PH_GU + 1);
    launch(PH_DOWN, PH_DOWN + 1);
    launch(PH_FINAL, PH_FINAL + 1);
}
```

```cpp
#include <hip/hip_runtime.h>
#include <cstdio>
#include <cstdint>

#define LAS __attribute__((address_space(3)))
#define GAS __attribute__((address_space(1)))
typedef unsigned short bf16;
typedef short bf16x8 __attribute__((ext_vector_type(8)));
typedef float f32x4 __attribute__((ext_vector_type(4)));
typedef float f32x2 __attribute__((ext_vector_type(2)));
typedef unsigned u32x4 __attribute__((ext_vector_type(4)));
typedef unsigned u32x2 __attribute__((ext_vector_type(2)));
typedef GAS unsigned gu32;

constexpr int BATCH = 16, SEQ = 2048, D = 1024, NMETA = 16, LSEQ = SEQ + NMETA;
constexpr int TR = BATCH * SEQ;
constexpr int TA = 33024;
constexpr int MROW = TR;
constexpr int WIN_LD = 6160, NPROJ = 6144;
constexpr int C_CB = 0, C_CC = 1024, C_CX = 2048, C_Z = 3072, C_XS = 4096, C_BS = 5120, C_CS = 5632;
constexpr int NH = 16, HD = 64, NE = 32, DMIX = 2048;
constexpr float EPS = 1e-5f;
constexpr float SW_ALPHA = 1.702f, SW_LIMIT = 7.0f;

constexpr size_t MiB = 1u << 20;
constexpr size_t WS_CTL = 0, CTL_ZERO_BYTES = 1 * MiB;
constexpr size_t WS_LIST = 1 * MiB;
constexpr size_t WS_GATE = 5 * MiB;
constexpr size_t WS_DT = 6 * MiB;
constexpr size_t WS_WIN = 12 * MiB;
constexpr size_t WS_WOUT = 24 * MiB;
constexpr size_t WS_WGU = 28 * MiB;
constexpr size_t WS_WDN = 156 * MiB;
constexpr size_t WS_XN = 220 * MiB;
constexpr size_t WS_PROJ = 285 * MiB;
constexpr size_t WS_ACT = 285 * MiB;
constexpr size_t WS_YE = 557 * MiB;
constexpr size_t WS_Y = 672 * MiB;
constexpr size_t WS_H1 = 816 * MiB;
constexpr size_t WS_XBCA = 880 * MiB;
constexpr size_t WS_END = 1024 * MiB;
constexpr int CW_CNT = 64;
constexpr int CW_BAR = 4096;

__device__ __forceinline__ unsigned f2bf(float f) { unsigned u = __float_as_uint(f); return (u + 0x7fffu + ((u >> 16) & 1u)) >> 16; }
__device__ __forceinline__ unsigned pk2(float lo, float hi) { return f2bf(lo) | (f2bf(hi) << 16); }
__device__ __forceinline__ float bf2f(unsigned short b) { return __uint_as_float(((unsigned)b) << 16); }
__device__ __forceinline__ float bflo(unsigned w) { return __uint_as_float(w << 16); }
__device__ __forceinline__ float bfhi(unsigned w) { return __uint_as_float(w & 0xffff0000u); }
__device__ __forceinline__ unsigned cvt_pk_bf16(float lo, float hi) { unsigned r; asm volatile("v_cvt_pk_bf16_f32 %0, %1, %2" : "=v"(r) : "v"(lo), "v"(hi)); return r; }
__device__ __forceinline__ float wave_sum(float v) {
#pragma unroll
    for (int o = 1; o < 64; o <<= 1) v += __shfl_xor(v, o);
    return v;
}
__device__ __forceinline__ int row_of(int b, int l) { return l >= NMETA ? b * SEQ + (l - NMETA) : MROW + l; }
__device__ __forceinline__ float silu_f(float z) { return z / (1.0f + __expf(-z)); }
#define LDS_WAIT() asm volatile("s_waitcnt lgkmcnt(0)" ::: "memory")
#define VM_WAIT() asm volatile("s_waitcnt vmcnt(0)" ::: "memory")

namespace pg8 {
constexpr int BM = 256, BK = 64, HALF = 128, HTB = HALF * BK * 2, STAGE_BYTES = 8 * HTB, NXCD = 8, WGM = 8;
constexpr int NOFF_REL = STAGE_BYTES + 8192;
__host__ __device__ __forceinline__ int lds_byte(int r, int c) { const int st = (r >> 4) * 2 + (c >> 5), rr = r & 15, cc = c & 31, ob = rr * 64 + cc * 2; return st * 1024 + (ob ^ (((ob >> 9) & 1) << 5)); }
__host__ __device__ __forceinline__ void stage_rc(int b, int& R, int& C) { const int st = b / 1024, sb = b % 1024, swz = sb ^ (((sb >> 9) & 1) << 5); R = (st >> 1) * 16 + swz / 64; C = (st & 1) * 32 + (swz % 64) / 2; }
__host__ __device__ __forceinline__ int perm32(int rho) { const int n = rho >> 4, i = rho & 15; return 8 * (i >> 2) + 4 * n + (i & 3); }

template <class Epi, class Sched, bool ALIGN_EPI, bool SP2>
__device__ __forceinline__ void gemm_phase(LAS unsigned char* lds, const char* Abase, const int K, const Sched& S, const Epi& E) {
    const int tid = threadIdx.x, wid = __builtin_amdgcn_readfirstlane(tid >> 6), lane = tid & 63, wr = wid >> 2, wc = wid & 3, fr = lane & 15, fq = lane >> 4;
    const int nt = K / BK;
    int Rr[2]; unsigned cbA[2], voffB[2];
#pragma unroll
    for (int i = 0; i < 2; ++i) { int R, C; stage_rc(tid * 16 + i * 8192, R, C); const int Rb = Epi::PERM ? ((R & ~31) + perm32(R & 31)) : R;
        Rr[i] = R; cbA[i] = (unsigned)C * 2u; voffB[i] = (unsigned)(Rb * K + C) * 2u; }
    const size_t kstep = (size_t)(BK * 2);
    const size_t hstep = (size_t)HALF * K * 2;
    const unsigned ldsw = (unsigned)wid * 1024u;
    const int aoff = lds_byte(wr * 64 + fr, fq * 8), boff = lds_byte(wc * 32 + fr, fq * 8);
#define PG8_SA(b, h) (((b) * 2 + (h)) * HTB)
#define PG8_SB(b, h) ((4 + (b) * 2 + (h)) * HTB)
#define PG8_STAGEB(bufoff, gbase) do { _Pragma("unroll") for (int _i = 0; _i < 2; ++_i) \
        __builtin_amdgcn_global_load_lds((const unsigned*)((const char*)(gbase) + voffB[_i]), (LAS unsigned*)(lds + (bufoff) + ldsw + _i * 8192), 16, 0, 0); } while (0)
#define PG8_STAGEA(bufoff, offs, kt) do { const char* _gb = Abase + (size_t)(kt) * kstep; _Pragma("unroll") for (int _i = 0; _i < 2; ++_i) \
        __builtin_amdgcn_global_load_lds((const unsigned*)(_gb + (offs)[_i]), (LAS unsigned*)(lds + (bufoff) + ldsw + _i * 8192), 16, 0, 0); } while (0)
#define PG8_LDA(dst, b, h) do { _Pragma("unroll") for (int m = 0; m < 4; ++m) _Pragma("unroll") for (int k = 0; k < 2; ++k) dst[m][k] = *(const LAS bf16x8*)(lds + PG8_SA(b, h) + aoff + m * 2048 + k * 1024); } while (0)
#define PG8_LDB(dst, b, h) do { _Pragma("unroll") for (int n = 0; n < 2; ++n) _Pragma("unroll") for (int k = 0; k < 2; ++k) dst[n][k] = *(const LAS bf16x8*)(lds + PG8_SB(b, h) + boff + n * 2048 + k * 1024); } while (0)
#define PG8_MMA(ai, bj, At, Bt) do { __builtin_amdgcn_s_setprio(1); _Pragma("unroll") for (int m = 0; m < 4; ++m) _Pragma("unroll") for (int n = 0; n < 2; ++n) _Pragma("unroll") for (int k = 0; k < 2; ++k) \
        acc[ai][bj][m][n] = __builtin_amdgcn_mfma_f32_16x16x32_bf16(Bt[n][k], At[m][k], acc[ai][bj][m][n], 0, 0, 0); __builtin_amdgcn_s_setprio(0); } while (0)
#define PG8_WAIT_V(n) asm volatile("s_waitcnt vmcnt(" #n ")" ::: "memory")
#define PG8_WAIT_L(n) asm volatile("s_waitcnt lgkmcnt(" #n ")" ::: "memory")
#define PG8_BAR __builtin_amdgcn_s_barrier()
#define PG8_SCHED __builtin_amdgcn_sched_barrier(0)
    typename Sched::Unit cur, nxt; int ui = 0;
    if (!S.next(0, cur)) return;
    f32x4 acc[2][2][4][2];
#pragma unroll
    for (int a = 0; a < 2; ++a)
#pragma unroll
        for (int b = 0; b < 2; ++b)
#pragma unroll
            for (int m = 0; m < 4; ++m)
#pragma unroll
                for (int n = 0; n < 2; ++n) acc[a][b][m][n] = (f32x4){0.f, 0.f, 0.f, 0.f};
    bf16x8 At[4][2], B0[2][2], B1[2][2];
    unsigned coff[2][2];
    LAS u32x4* stash = (LAS u32x4*)(lds + NOFF_REL) + tid;
#pragma unroll
    for (int h = 0; h < 2; ++h)
#pragma unroll
        for (int i = 0; i < 2; ++i) coff[h][i] = S.aoff(cur, h * HALF + Rr[i]) + cbA[i];
    const char* cB = S.bptr(cur);
    if constexpr (SP2) {
        PG8_STAGEB(PG8_SB(0, 0), cB); PG8_STAGEB(PG8_SB(0, 1), cB + hstep); PG8_STAGEA(PG8_SA(0, 0), coff[0], 0); PG8_STAGEA(PG8_SA(0, 1), coff[1], 0);
        if (wr == 1) PG8_BAR;
        PG8_WAIT_V(2); PG8_BAR;
        PG8_STAGEB(PG8_SB(1, 0), cB + kstep); PG8_STAGEA(PG8_SA(1, 0), coff[0], 1); PG8_STAGEB(PG8_SB(1, 1), cB + hstep + kstep);
        PG8_WAIT_V(6); PG8_BAR;
    } else {
        PG8_STAGEB(PG8_SB(0, 0), cB); PG8_STAGEA(PG8_SA(0, 0), coff[0], 0); PG8_STAGEB(PG8_SB(0, 1), cB + hstep); PG8_STAGEA(PG8_SA(0, 1), coff[1], 0);
        if (wr == 1) PG8_BAR;
        PG8_WAIT_V(4); PG8_BAR;
        PG8_STAGEB(PG8_SB(1, 0), cB + kstep); PG8_STAGEA(PG8_SA(1, 0), coff[0], 1); PG8_STAGEB(PG8_SB(1, 1), cB + hstep + kstep);
        PG8_WAIT_V(6); PG8_BAR;
    }
    for (;;) {
        const bool has_next = S.next(ui + 1, nxt);
        const char* nB = has_next ? S.bptr(nxt) : cB;
        if (has_next) { u32x4 w; w.x = S.aoff(nxt, Rr[0]) + cbA[0]; w.y = S.aoff(nxt, Rr[1]) + cbA[1]; w.z = S.aoff(nxt, HALF + Rr[0]) + cbA[0]; w.w = S.aoff(nxt, HALF + Rr[1]) + cbA[1]; *stash = w; }
        for (int t = 0; t < nt; t += 2) {
            const bool last = (t == nt - 2);
            const char* b2 = last ? nB : cB + (size_t)(t + 2) * kstep;
            const char* b3 = b2 + kstep;
            const int ka = last ? 0 : t + 2;
            if constexpr (SP2) {
            PG8_LDB(B0, 0, 0); PG8_LDB(B1, 0, 1); PG8_SCHED; PG8_LDA(At, 0, 0); PG8_STAGEA(PG8_SA(1, 1), coff[1], t + 1);
            PG8_WAIT_V(8); PG8_WAIT_L(0); PG8_BAR; PG8_MMA(0, 0, At, B0); PG8_MMA(0, 1, At, B1); PG8_BAR; PG8_SCHED;
            if (last && has_next) { const u32x4 w = *stash; coff[0][0] = w.x; coff[0][1] = w.y; coff[1][0] = w.z; coff[1][1] = w.w; }
            PG8_LDA(At, 0, 1); PG8_STAGEB(PG8_SB(0, 0), b2); PG8_STAGEB(PG8_SB(0, 1), b2 + hstep); PG8_STAGEA(PG8_SA(0, 0), coff[0], ka);
            PG8_WAIT_V(8); PG8_WAIT_L(0); PG8_BAR; PG8_MMA(1, 0, At, B0); PG8_MMA(1, 1, At, B1); PG8_BAR; PG8_SCHED;
            PG8_LDB(B0, 1, 0); PG8_LDB(B1, 1, 1); PG8_SCHED; PG8_LDA(At, 1, 0); PG8_STAGEA(PG8_SA(0, 1), coff[1], ka);
            PG8_WAIT_V(8); PG8_WAIT_L(0); PG8_BAR; PG8_MMA(0, 0, At, B0); PG8_MMA(0, 1, At, B1); PG8_BAR; PG8_SCHED;
            PG8_LDA(At, 1, 1); PG8_STAGEB(PG8_SB(1, 0), b3); PG8_STAGEB(PG8_SB(1, 1), b3 + hstep); PG8_STAGEA(PG8_SA(1, 0), coff[0], ka + 1);
            PG8_WAIT_V(8); PG8_WAIT_L(0); PG8_BAR; PG8_MMA(1, 0, At, B0); PG8_MMA(1, 1, At, B1); PG8_BAR; PG8_SCHED;
            } else {
            PG8_LDB(B0, 0, 0); PG8_SCHED; PG8_LDA(At, 0, 0); PG8_STAGEA(PG8_SA(1, 1), coff[1], t + 1);
            PG8_WAIT_L(8); PG8_BAR; PG8_WAIT_L(0); PG8_MMA(0, 0, At, B0); PG8_BAR; PG8_SCHED;
            if (last && has_next) { const u32x4 w = *stash; coff[0][0] = w.x; coff[0][1] = w.y; coff[1][0] = w.z; coff[1][1] = w.w; }
            PG8_LDB(B1, 0, 1); PG8_STAGEB(PG8_SB(0, 0), b2);
            PG8_BAR; PG8_WAIT_L(0); PG8_MMA(0, 1, At, B1); PG8_BAR;
            PG8_LDA(At, 0, 1); PG8_STAGEA(PG8_SA(0, 0), coff[0], ka);
            PG8_BAR; PG8_WAIT_L(0); PG8_MMA(1, 0, At, B0); PG8_BAR; PG8_SCHED;
            PG8_STAGEB(PG8_SB(0, 1), b2 + hstep);
            PG8_WAIT_V(6); PG8_BAR; PG8_MMA(1, 1, At, B1); PG8_BAR;
            PG8_LDB(B0, 1, 0); PG8_SCHED; PG8_LDA(At, 1, 0); PG8_STAGEA(PG8_SA(0, 1), coff[1], ka);
            PG8_WAIT_L(8); PG8_BAR; PG8_WAIT_L(0); PG8_MMA(0, 0, At, B0); PG8_BAR; PG8_SCHED;
            PG8_LDB(B1, 1, 1); PG8_STAGEB(PG8_SB(1, 0), b3);
            PG8_BAR; PG8_WAIT_L(0); PG8_MMA(0, 1, At, B1); PG8_BAR;
            PG8_LDA(At, 1, 1); PG8_STAGEA(PG8_SA(1, 0), coff[0], ka + 1);
            PG8_BAR; PG8_WAIT_L(0); PG8_MMA(1, 0, At, B0); PG8_BAR; PG8_SCHED;
            PG8_STAGEB(PG8_SB(1, 1), b3 + hstep);
            PG8_WAIT_V(6); PG8_BAR; PG8_MMA(1, 1, At, B1); PG8_BAR;
            }
        }
        if constexpr (ALIGN_EPI) { if (wr == 0) PG8_BAR; }
        asm volatile("" ::: "memory");
        E(acc, cur, wr, wc, fr, fq);
        if (!has_next) break;
#pragma unroll
        for (int a = 0; a < 2; ++a)
#pragma unroll
            for (int b = 0; b < 2; ++b)
#pragma unroll
                for (int m = 0; m < 4; ++m)
#pragma unroll
                    for (int n = 0; n < 2; ++n) acc[a][b][m][n] = (f32x4){0.f, 0.f, 0.f, 0.f};
        cur = nxt; cB = nB; ++ui;
        if constexpr (ALIGN_EPI) { if (wr == 1) PG8_BAR; }
    }
    PG8_WAIT_V(0);
    if constexpr (!ALIGN_EPI) { if (wr == 0) PG8_BAR; }
    PG8_BAR;
#undef PG8_SA
#undef PG8_SB
#undef PG8_STAGEA
#undef PG8_STAGEB
#undef PG8_LDA
#undef PG8_LDB
#undef PG8_MMA
#undef PG8_WAIT_V
#undef PG8_WAIT_L
#undef PG8_BAR
#undef PG8_SCHED
}

struct DenseUnit { int pm, pn; };
struct DenseSched {
    typedef DenseUnit Unit;
    int nM, nN, nwg, G, c, K; const char* Bt;
    __device__ void init(int M, int N, int K_, const void* Bt_, int G_, int c_) { nM = M / BM; nN = N / BM; nwg = nM * nN; G = G_; c = c_; K = K_; Bt = (const char*)Bt_; }
    __device__ __forceinline__ bool next(int i, Unit& u) const {
        const long L = (long)i * G + c; if (L >= nwg) return false;
        int wgid = (int)L; { const int q = nwg / NXCD, r = nwg % NXCD, xcd = wgid % NXCD, off = wgid / NXCD; wgid = (xcd < r ? xcd * (q + 1) : r * (q + 1) + (xcd - r) * q) + off; }
        const int nig = WGM * nN, gid = wgid / nig, fm = gid * WGM, gsz = (nM - fm) < WGM ? (nM - fm) : WGM;
        u.pm = fm + ((wgid % nig) % gsz); u.pn = (wgid % nig) / gsz; return true;
    }
    __device__ __forceinline__ unsigned aoff(const Unit& u, int r) const { return (unsigned)(u.pm * BM + r) * (unsigned)(K * 2); }
    __device__ __forceinline__ const char* bptr(const Unit& u) const { return Bt + (size_t)u.pn * BM * K * 2; }
};

struct MoeUnit { int e, rt, l0, nv, pn; };
template <bool GATHER>
struct MoeSched {
    typedef MoeUnit Unit;
    const LAS int* tst;
    const LAS int* cnt;
    int G, c, NP, K; const int* list; const char* Bt; size_t estride;
    __device__ __forceinline__ bool next(int i, Unit& u) const {
        const int L = i * G + c; const int R = __builtin_amdgcn_readfirstlane(tst[NE]); if (L >= R * NP) return false;
        const int rt = L / NP; u.pn = L % NP;
        int e = 0;
#pragma unroll 1
        for (int j = 1; j < NE; ++j) e = (rt >= __builtin_amdgcn_readfirstlane(tst[j])) ? j : e;
        u.e = e; u.rt = rt; u.l0 = (rt - __builtin_amdgcn_readfirstlane(tst[e])) * BM; const int rem = __builtin_amdgcn_readfirstlane(cnt[e]) - u.l0; u.nv = rem < BM ? rem : BM; return true;
    }
    __device__ __forceinline__ unsigned aoff(const Unit& u, int r) const {
        if (GATHER) { const int j = (r < u.nv) ? (u.l0 + r) : u.l0; const int a = list[(size_t)u.e * TR + j]; return (unsigned)(a >> 2) * (unsigned)(K * 2); }
        else return (unsigned)(u.rt * BM + r) * (unsigned)(K * 2);
    }
    __device__ __forceinline__ const char* bptr(const Unit& u) const { return Bt + (size_t)u.e * estride + (size_t)u.pn * BM * K * 2; }
};

struct EpiProj {
    static constexpr bool PERM = true;
    bf16* O; int ldc;
    __device__ __forceinline__ void operator()(const f32x4 (&acc)[2][2][4][2], const DenseUnit& u, int wr, int wc, int fr, int fq) const {
        const int row0 = u.pm * BM + wr * 64 + fr; const int col0 = u.pn * BM + wc * 32 + 8 * fq;
#pragma unroll
        for (int ai = 0; ai < 2; ++ai)
#pragma unroll
            for (int m = 0; m < 4; ++m) { bf16* rowp = O + (size_t)(row0 + ai * HALF + m * 16) * ldc + col0;
#pragma unroll
                for (int bj = 0; bj < 2; ++bj) { const f32x4 v0 = acc[ai][bj][m][0], v1 = acc[ai][bj][m][1];
                    u32x4 w; w.x = cvt_pk_bf16(v0[0], v0[1]); w.y = cvt_pk_bf16(v0[2], v0[3]); w.z = cvt_pk_bf16(v1[0], v1[1]); w.w = cvt_pk_bf16(v1[2], v1[3]);
                    *(u32x4*)(rowp + bj * HALF) = w; } }
    }
};
struct EpiH1 {
    static constexpr bool PERM = false;
    const float* X; float* H; int ldc;
    __device__ __forceinline__ void operator()(const f32x4 (&acc)[2][2][4][2], const DenseUnit& u, int wr, int wc, int fr, int fq) const {
        const int row0 = u.pm * BM + wr * 64 + fr, col0 = u.pn * BM + wc * 32 + 4 * fq;
#pragma unroll
        for (int ai = 0; ai < 2; ++ai)
#pragma unroll
            for (int m = 0; m < 4; ++m) { const size_t off = (size_t)(row0 + ai * HALF + m * 16) * ldc + col0;
#pragma unroll
                for (int bj = 0; bj < 2; ++bj)
#pragma unroll
                    for (int n = 0; n < 2; ++n) { const f32x4 xv = *(const f32x4*)(X + off + bj * HALF + n * 16); *(f32x4*)(H + off + bj * HALF + n * 16) = xv + acc[ai][bj][m][n]; }
                asm volatile("" ::: "memory"); }
    }
};
__device__ __forceinline__ float swiglu1(float g, float l) {
    g = fminf(g, SW_LIMIT); l = fminf(fmaxf(l, -SW_LIMIT), SW_LIMIT);
    return g * (l + 1.0f) / (1.0f + __expf(-SW_ALPHA * g));
}
struct EpiSwiGLU {
    static constexpr bool PERM = true;
    bf16* ACT; const float* bgu;
    __device__ __forceinline__ void operator()(const f32x4 (&acc)[2][2][4][2], const MoeUnit& u, int wr, int wc, int fr, int fq) const {
        const int row0 = u.rt * BM + wr * 64 + fr; const int j0 = u.pn * HALF + wc * 32 + 8 * fq;
        const float* bg = bgu + (size_t)u.e * 2048 + j0;
        const f32x4 g0 = *(const f32x4*)(bg), g1 = *(const f32x4*)(bg + 4), l0 = *(const f32x4*)(bg + 1024), l1 = *(const f32x4*)(bg + 1028);
#pragma unroll
        for (int ai = 0; ai < 2; ++ai)
#pragma unroll
            for (int m = 0; m < 4; ++m) { bf16* rowp = ACT + (size_t)(row0 + ai * HALF + m * 16) * 1024 + j0;
                const f32x4 a0 = acc[ai][0][m][0] + g0, a1 = acc[ai][0][m][1] + g1, b0 = acc[ai][1][m][0] + l0, b1 = acc[ai][1][m][1] + l1;
                u32x4 w; w.x = cvt_pk_bf16(swiglu1(a0[0], b0[0]), swiglu1(a0[1], b0[1])); w.y = cvt_pk_bf16(swiglu1(a0[2], b0[2]), swiglu1(a0[3], b0[3]));
                w.z = cvt_pk_bf16(swiglu1(a1[0], b1[0]), swiglu1(a1[1], b1[1])); w.w = cvt_pk_bf16(swiglu1(a1[2], b1[2]), swiglu1(a1[3], b1[3]));
                *(u32x4*)rowp = w; }
    }
};
struct EpiDown {
    static constexpr bool PERM = true;
    bf16* YE; const float* bdn; const int* list; const float* gate;
    __device__ __forceinline__ void operator()(const f32x4 (&acc)[2][2][4][2], const MoeUnit& u, int wr, int wc, int fr, int fq) const {
        const int col0 = u.pn * BM + wc * 32 + 8 * fq;
        const float* bb = bdn + (size_t)u.e * 1024 + col0;
        f32x4 bv[2][2];
#pragma unroll
        for (int bj = 0; bj < 2; ++bj)
#pragma unroll
            for (int n = 0; n < 2; ++n) bv[bj][n] = *(const f32x4*)(bb + bj * HALF + 4 * n);
#pragma unroll
        for (int ai = 0; ai < 2; ++ai)
#pragma unroll
            for (int m = 0; m < 4; ++m) { const int r = ai * HALF + wr * 64 + m * 16 + fr;
                if (r < u.nv) { const int a = list[(size_t)u.e * TR + u.l0 + r]; const float g = gate[a]; bf16* rowp = YE + (size_t)a * 1024 + col0;
#pragma unroll
                    for (int bj = 0; bj < 2; ++bj) { const f32x4 v0 = (acc[ai][bj][m][0] + bv[bj][0]) * g, v1 = (acc[ai][bj][m][1] + bv[bj][1]) * g;
                        u32x4 w; w.x = cvt_pk_bf16(v0[0], v0[1]); w.y = cvt_pk_bf16(v0[2], v0[3]); w.z = cvt_pk_bf16(v1[0], v1[1]); w.w = cvt_pk_bf16(v1[2], v1[3]);
                        *(u32x4*)(rowp + bj * HALF) = w; } } }
    }
};
}

constexpr int NWAVES = 8;
constexpr int RING_OFF = 0, RING_BYTES = 131072;
constexpr int LDSCTL_OFF = RING_BYTES;
constexpr int MISC_OFF = LDSCTL_OFF + 320;
constexpr int MOE_OFF = LDSCTL_OFF + 512;
constexpr int RT_OFF = LDSCTL_OFF + 1024;
constexpr int LDS_BYTES = 147456;

#define XB_TMO      128
#define XB_XCNT(j)  (256  + 64 * (j))
#define XB_XSUB(j)  (1280 + 64 * (j))
#define XB_XGEN(j)  (2304 + 64 * (j))
#define XB_TOP      3328
#define XB_TOPGEN   3392
#define XCD_BAR_WORDS 3456
#define XB_SPIN_CAP (1u << 18)
__device__ __forceinline__ unsigned xb_ld(unsigned* p)              { return __hip_atomic_load(p, __ATOMIC_RELAXED, __HIP_MEMORY_SCOPE_AGENT); }
__device__ __forceinline__ unsigned xb_add(unsigned* p, unsigned v) { return __hip_atomic_fetch_add(p, v, __ATOMIC_RELAXED, __HIP_MEMORY_SCOPE_AGENT); }
__device__ __forceinline__ unsigned xb_xcc_id() { return (unsigned)__builtin_amdgcn_s_getreg((3 << 11) | 20) & 0xFu; }
#define XB_SPIN(cond, bar) do { unsigned _sp = 0; while (cond) { __builtin_amdgcn_s_sleep(1); \
    if ((++_sp & 255u) == 0u) { if (xb_ld(&(bar)[XB_TMO])) break; if (_sp > XB_SPIN_CAP) { atomicAdd(&(bar)[XB_TMO], 1u); break; } } } } while (0)
struct XcdBarrier { unsigned* bar; unsigned x; volatile LAS unsigned* st; };
__device__ __forceinline__ XcdBarrier xcd_barrier_post(unsigned* bar, volatile LAS unsigned* st) {
    XcdBarrier b; b.bar = bar; b.x = xb_xcc_id(); b.st = st;
    if (threadIdx.x == 0) (void)xb_add(&bar[XB_XCNT(b.x)], 1u);
    return b;
}
__device__ __forceinline__ void xcd_barrier_complete(unsigned* bar, unsigned x, unsigned& nloc, unsigned& nx) {
    const unsigned G = gridDim.x * gridDim.y * gridDim.z;
    unsigned sum, cnt, mine, sp = 0u;
    for (;;) {
        sum = 0u; cnt = 0u; mine = 0u;
#pragma unroll
        for (unsigned j = 0; j < 16; ++j) { const unsigned c = xb_ld(&bar[XB_XCNT(j)]); sum += c; cnt += (c > 0u) ? 1u : 0u; mine = (j == x) ? c : mine; }
        if (sum == G) break;
        __builtin_amdgcn_s_sleep(1);
        if ((++sp & 255u) == 0u) { if (xb_ld(&bar[XB_TMO])) break; if (sp > XB_SPIN_CAP) { atomicAdd(&bar[XB_TMO], 1u); break; } }
    }
    nloc = mine > 0u ? mine : 1u; nx = cnt > 0u ? cnt : 1u;
}
__device__ __forceinline__ void xcd_barrier(const XcdBarrier& b) {
    asm volatile("s_waitcnt vmcnt(0)" ::: "memory");
    __syncthreads();
    if (threadIdx.x == 0) {
        unsigned* bar = b.bar;
        __builtin_amdgcn_s_waitcnt(0);
        unsigned nloc = b.st[0], nx = b.st[1];
        if (nloc == 0u) { xcd_barrier_complete(bar, b.x, nloc, nx); b.st[0] = nloc; b.st[1] = nx; }
        const unsigned old = xb_add(&bar[XB_XSUB(b.x)], 1u);
        const unsigned gen = old / nloc;
        if (old + 1u == (gen + 1u) * nloc) {
            __builtin_amdgcn_fence(__ATOMIC_RELEASE, "agent");
            asm volatile("s_waitcnt vmcnt(0)" ::: "memory");
            const unsigned og = xb_add(&bar[XB_TOP], 1u);
            const unsigned tg = og / nx;
            if (og + 1u == (tg + 1u) * nx) xb_add(&bar[XB_TOPGEN], 1u);
            else XB_SPIN(xb_ld(&bar[XB_TOPGEN]) == tg, bar);
            __builtin_amdgcn_fence(__ATOMIC_ACQUIRE, "agent");
            xb_add(&bar[XB_XGEN(b.x)], 1u);
            asm volatile("s_waitcnt vmcnt(0)" ::: "memory");
        } else {
            XB_SPIN(xb_ld(&bar[XB_XGEN(b.x)]) == gen, bar);
            __builtin_amdgcn_fence(__ATOMIC_ACQUIRE, "agent");
            asm volatile("s_waitcnt vmcnt(0)" ::: "memory");
        }
    }
    __syncthreads();
}

struct Args { const float* in[21]; float* out; unsigned char* ws; int ph_lo, ph_hi; };
enum { I_X = 0, I_META, I_NMIX, I_WIN, I_CSW, I_CNW, I_SCW, I_SCB, I_DTB, I_ALOG, I_SD, I_SNW, I_WOUT, I_NFFN, I_RW, I_RB, I_WGU, I_BGU, I_WDN, I_BDN, I_NFIN };

__device__ __forceinline__ void p0_transpose_item(const float* W, int ldw, int K, const float* kscale, bf16* WT, int row_off, int k0, int n0, LAS float* scr, int lane) {
#pragma unroll 8
    for (int i = 0; i < 32; ++i) { const int kk = 2 * i + (lane >> 5); float v = W[(size_t)(k0 + kk) * ldw + n0 + (lane & 31)]; if (kscale) v *= kscale[k0 + kk]; scr[kk * 33 + (lane & 31)] = v; }
    LDS_WAIT(); asm volatile("" ::: "memory");
    const int c = lane & 7;
#pragma unroll
    for (int j = 0; j < 4; ++j) { const int n = (lane >> 3) + 8 * j; const LAS float* s = scr + (8 * c) * 33 + n;
        u32x4 o; o.x = pk2(s[0 * 33], s[1 * 33]); o.y = pk2(s[2 * 33], s[3 * 33]); o.z = pk2(s[4 * 33], s[5 * 33]); o.w = pk2(s[6 * 33], s[7 * 33]);
        *(u32x4*)(WT + (size_t)(row_off + n) * K + k0 + 8 * c) = o; }
    LDS_WAIT(); asm volatile("" ::: "memory");
}

__device__ __forceinline__ void p0_prologue(const Args& A, LAS unsigned char* lds, int vcu, int G, int tid, int lane, int wave) {
    unsigned char* ws = A.ws;
    LAS float* scr = (LAS float*)(lds + RING_OFF + wave * 16384);
    const int gw = vcu * NWAVES + wave, NGW = G * NWAVES;
    constexpr int I_IN = 16 * 192, I_OUT = 32 * 32, I_GU = 32 * 16 * 64, I_DN = 32 * 16 * 32;
    constexpr int NITEMS = I_IN + I_OUT + I_GU + I_DN;
    for (int it = gw; it < NITEMS; it += NGW) {
        int r = it;
        if (r < I_IN) { const int kb = r / 192, nb = r % 192; p0_transpose_item(A.in[I_WIN], WIN_LD, 1024, A.in[I_NMIX], (bf16*)(ws + WS_WIN), 32 * nb, 64 * kb, 32 * nb, scr, lane); continue; } r -= I_IN;
        if (r < I_OUT) { const int kb = r / 32, nb = r % 32; const float* ks = (kb < 16) ? A.in[I_CNW] : (A.in[I_SNW] - 1024);
            p0_transpose_item(A.in[I_WOUT], 1024, 2048, ks, (bf16*)(ws + WS_WOUT), 32 * nb, 64 * kb, 32 * nb, scr, lane); continue; } r -= I_OUT;
        if (r < I_GU) { const int e = r >> 10, q = r & 1023, kb = q >> 6, nb = q & 63; const int n0 = 32 * nb;
            const int bj = n0 >> 10, j = n0 & 1023, pn = j >> 7, jj = j & 127; const int rho = 256 * pn + 128 * bj + jj;
            p0_transpose_item(A.in[I_WGU] + (size_t)e * 1024 * 2048, 2048, 1024, A.in[I_NFFN], (bf16*)(ws + WS_WGU) + (size_t)e * 2048 * 1024, rho, 64 * kb, n0, scr, lane); continue; } r -= I_GU;
        { const int e = r >> 9, q = r & 511, kb = q >> 5, nb = q & 31;
            p0_transpose_item(A.in[I_WDN] + (size_t)e * 1024 * 1024, 1024, 1024, nullptr, (bf16*)(ws + WS_WDN) + (size_t)e * 1024 * 1024, 32 * nb, 64 * kb, 32 * nb, scr, lane); }
    }
    __syncthreads();
    LAS float* wdt = (LAS float*)(lds + RING_OFF);
    for (int idx = tid; idx < 16 * 1024; idx += NWAVES * 64) { const int d = idx >> 4, j = idx & 15; wdt[j * 1024 + d] = A.in[I_WIN][(size_t)d * WIN_LD + NPROJ + j] * A.in[I_NMIX][d]; }
    LDS_WAIT(); __syncthreads();
    bf16* XN = (bf16*)(ws + WS_XN); float* DT = (float*)(ws + WS_DT);
    for (int m = gw; m < TA; m += NGW) {
        const float* src = (m < TR) ? A.in[I_X] + (size_t)m * D : ((m < MROW + NMETA) ? A.in[I_META] + (size_t)(m - MROW) * D : nullptr);
        f32x4 v[4]; float s = 0.f;
#pragma unroll
        for (int j = 0; j < 4; ++j) { v[j] = src ? *((const f32x4*)src + 64 * j + lane) : (f32x4){0.f, 0.f, 0.f, 0.f}; s += (v[j].x * v[j].x + v[j].y * v[j].y) + (v[j].z * v[j].z + v[j].w * v[j].w); }
        const float rstd = 1.0f / sqrtf(wave_sum(s) * (1.0f / D) + EPS);
        u32x2* o8 = (u32x2*)(XN + (size_t)m * D) + lane;
#pragma unroll
        for (int j = 0; j < 4; ++j) { u32x2 w; w.x = pk2(v[j].x * rstd, v[j].y * rstd); w.y = pk2(v[j].z * rstd, v[j].w * rstd); o8[64 * j] = w; }
        float mine = 0.f;
#pragma unroll 2
        for (int jj = 0; jj < 16; ++jj) { float a = 0.f;
#pragma unroll
            for (int j = 0; j < 4; ++j) { const f32x4 w = *(const LAS f32x4*)(wdt + jj * 1024 + 256 * j + 4 * lane); a += (v[j].x * w.x + v[j].y * w.y) + (v[j].z * w.z + v[j].w * w.w); }
            a = wave_sum(a); mine = (lane == jj) ? a : mine; }
        if (lane < 16) DT[(size_t)m * 16 + lane] = mine * rstd;
    }
}

__device__ __forceinline__ void p4_router(const Args& A, LAS unsigned char* lds, int vcu, int G, int tid, int lane, int wave) {
    unsigned char* ws = A.ws;
    const float* H1 = (const float*)(ws + WS_H1); bf16* XN2 = (bf16*)(ws + WS_XN);
    int* LIST = (int*)(ws + WS_LIST); float* GATE = (float*)(ws + WS_GATE); unsigned* CNT = (unsigned*)(ws + WS_CTL) + CW_CNT;
    LAS float* rwt = (LAS float*)(lds + RING_OFF);
    LAS int* sel_e = (LAS int*)(lds + RT_OFF); LAS float* sel_g = (LAS float*)(lds + RT_OFF + 2048); LAS int* rnk = (LAS int*)(lds + RT_OFF + 4096);
    LAS int* cnt_loc = (LAS int*)(lds + RT_OFF + 6144); LAS int* base_loc = (LAS int*)(lds + RT_OFF + 6144 + 128);
    for (int idx = tid; idx < 32 * 1024; idx += NWAVES * 64) { const int d = idx >> 5, e = idx & 31; rwt[e * 1024 + d] = A.in[I_RW][(size_t)d * 32 + e] * A.in[I_NFFN][d]; }
    LDS_WAIT(); __syncthreads();
    float rb[32];
#pragma unroll
    for (int e = 0; e < 32; ++e) rb[e] = A.in[I_RB][e];
    for (int ch = vcu; ch < TR / 128; ch += G) {
        if (tid < 32) cnt_loc[tid] = 0;
        LDS_WAIT(); __syncthreads();
        for (int q = 0; q < 16; ++q) {
            const int tl = wave * 16 + q, t = ch * 128 + tl;
            f32x4 v[4]; float s = 0.f;
#pragma unroll
            for (int j = 0; j < 4; ++j) { v[j] = *((const f32x4*)(H1 + (size_t)t * D) + 64 * j + lane); s += (v[j].x * v[j].x + v[j].y * v[j].y) + (v[j].z * v[j].z + v[j].w * v[j].w); }
            const float rstd = 1.0f / sqrtf(wave_sum(s) * (1.0f / D) + EPS);
            u32x2* o8 = (u32x2*)(XN2 + (size_t)t * D) + lane;
#pragma unroll
            for (int j = 0; j < 4; ++j) { u32x2 w; w.x = pk2(v[j].x * rstd, v[j].y * rstd); w.y = pk2(v[j].z * rstd, v[j].w * rstd); o8[64 * j] = w; }
            float lg[32];
#pragma unroll
            for (int e = 0; e < 32; ++e) { float a = 0.f;
#pragma unroll
                for (int j = 0; j < 4; ++j) { const f32x4 w = *(const LAS f32x4*)(rwt + e * 1024 + 256 * j + 4 * lane); a += (v[j].x * w.x + v[j].y * w.y) + (v[j].z * w.z + v[j].w * w.w); }
                lg[e] = wave_sum(a) * rstd + rb[e]; }
            float tv[4]; int ti[4];
#pragma unroll
            for (int k = 0; k < 4; ++k) { float best = lg[0]; int bi = 0;
#pragma unroll
                for (int e = 1; e < 32; ++e) { const bool gt = lg[e] > best; best = gt ? lg[e] : best; bi = gt ? e : bi; }
                tv[k] = best; ti[k] = bi;
#pragma unroll
                for (int e = 0; e < 32; ++e) lg[e] = (e == bi) ? -3.0e38f : lg[e]; }
            const float e1 = __expf(tv[1] - tv[0]), e2 = __expf(tv[2] - tv[0]), e3 = __expf(tv[3] - tv[0]); const float inv = 1.0f / (1.0f + e1 + e2 + e3);
            if (lane < 4) { const int e = lane == 0 ? ti[0] : (lane == 1 ? ti[1] : (lane == 2 ? ti[2] : ti[3]));
                const float g = (lane == 0 ? 1.0f : (lane == 1 ? e1 : (lane == 2 ? e2 : e3))) * inv;
                const int r = __hip_atomic_fetch_add(cnt_loc + e, 1, __ATOMIC_RELAXED, __HIP_MEMORY_SCOPE_WORKGROUP);
                sel_e[tl * 4 + lane] = e; sel_g[tl * 4 + lane] = g; rnk[tl * 4 + lane] = r; }
        }
        LDS_WAIT(); __syncthreads();
        if (tid < 32) base_loc[tid] = (int)__hip_atomic_fetch_add(CNT + tid, (unsigned)cnt_loc[tid], __ATOMIC_RELAXED, __HIP_MEMORY_SCOPE_AGENT);
        LDS_WAIT(); __syncthreads();
        { const int e = sel_e[tid]; const int pos = base_loc[e] + rnk[tid]; const int a = (ch * 128) * 4 + tid; LIST[(size_t)e * TR + pos] = a; GATE[a] = sel_g[tid]; }
        __syncthreads();
    }
}

__device__ __forceinline__ void p7_final(const Args& A, int vcu, int G, int lane, int wave) {
    unsigned char* ws = A.ws;
    const float* H1 = (const float*)(ws + WS_H1); const bf16* YE = (const bf16*)(ws + WS_YE);
    const int gw = vcu * NWAVES + wave, NGW = G * NWAVES;
    f32x4 wf[4];
#pragma unroll
    for (int j = 0; j < 4; ++j) wf[j] = *((const f32x4*)A.in[I_NFIN] + 64 * j + lane);
    for (int t = gw; t < TR; t += NGW) {
        f32x4 v[4]; float s = 0.f;
#pragma unroll
        for (int j = 0; j < 4; ++j) v[j] = *((const f32x4*)(H1 + (size_t)t * D) + 64 * j + lane);
#pragma unroll
        for (int k = 0; k < 4; ++k) { const u32x2* yr = (const u32x2*)(YE + ((size_t)t * 4 + k) * D) + lane;
#pragma unroll
            for (int j = 0; j < 4; ++j) { const u32x2 w = yr[64 * j]; v[j].x += bflo(w.x); v[j].y += bfhi(w.x); v[j].z += bflo(w.y); v[j].w += bfhi(w.y); } }
#pragma unroll
        for (int j = 0; j < 4; ++j) s += (v[j].x * v[j].x + v[j].y * v[j].y) + (v[j].z * v[j].z + v[j].w * v[j].w);
        const float rstd = 1.0f / sqrtf(wave_sum(s) * (1.0f / D) + EPS);
        f32x4* o = (f32x4*)(A.out + (size_t)t * D) + lane;
#pragma unroll
        for (int j = 0; j < 4; ++j) o[64 * j] = v[j] * rstd * wf[j];
    }
}

__device__ __forceinline__ void moe_tables(const Args& A, LAS unsigned char* lds, int tid) {
    LAS int* tst = (LAS int*)(lds + MOE_OFF); LAS int* cnt = tst + 40;
    const unsigned* CNT = (const unsigned*)(A.ws + WS_CTL) + CW_CNT;
    if (tid < 32) cnt[tid] = (int)__hip_atomic_load(CNT + tid, __ATOMIC_RELAXED, __HIP_MEMORY_SCOPE_AGENT);
    LDS_WAIT(); __syncthreads();
    if (tid == 0) { int s = 0; for (int e = 0; e < NE; ++e) { tst[e] = s; s += (cnt[e] + 255) >> 8; } tst[NE] = s; }
    LDS_WAIT(); __syncthreads();
}

__device__ __forceinline__ void d_conv_branch(const bf16* __restrict__ PROJ, const float* __restrict__ cw, bf16* __restrict__ Y, int m, int lane) {
    const int b = m / SEQ, s = m % SEQ, l = s + NMETA;
    const int r0 = row_of(b, l), r1 = row_of(b, l - 1), r2 = row_of(b, l - 2);
#pragma unroll
    for (int j = 0; j < 4; ++j) {
        const int c = 256 * j + 4 * lane;
        const u32x2 cb = *(const u32x2*)(PROJ + (size_t)r0 * NPROJ + C_CB + c);
        const u32x2 c0 = *(const u32x2*)(PROJ + (size_t)r0 * NPROJ + C_CC + c), x0 = *(const u32x2*)(PROJ + (size_t)r0 * NPROJ + C_CX + c);
        const u32x2 c1 = *(const u32x2*)(PROJ + (size_t)r1 * NPROJ + C_CC + c), x1 = *(const u32x2*)(PROJ + (size_t)r1 * NPROJ + C_CX + c);
        const u32x2 c2 = *(const u32x2*)(PROJ + (size_t)r2 * NPROJ + C_CC + c), x2 = *(const u32x2*)(PROJ + (size_t)r2 * NPROJ + C_CX + c);
        const f32x4 w0 = *(const f32x4*)(cw + c), w1 = *(const f32x4*)(cw + 1024 + c), w2 = *(const f32x4*)(cw + 2048 + c);
        float y[4];
        y[0] = bflo(cb.x) * (w0.x * bflo(c2.x) * bflo(x2.x) + w1.x * bflo(c1.x) * bflo(x1.x) + w2.x * bflo(c0.x) * bflo(x0.x));
        y[1] = bfhi(cb.x) * (w0.y * bfhi(c2.x) * bfhi(x2.x) + w1.y * bfhi(c1.x) * bfhi(x1.x) + w2.y * bfhi(c0.x) * bfhi(x0.x));
        y[2] = bflo(cb.y) * (w0.z * bflo(c2.y) * bflo(x2.y) + w1.z * bflo(c1.y) * bflo(x1.y) + w2.z * bflo(c0.y) * bflo(x0.y));
        y[3] = bfhi(cb.y) * (w0.w * bfhi(c2.y) * bfhi(x2.y) + w1.w * bfhi(c1.y) * bfhi(x1.y) + w2.w * bfhi(c0.y) * bfhi(x0.y));
        float ss = (y[0] * y[0] + y[1] * y[1]) + (y[2] * y[2] + y[3] * y[3]);
#pragma unroll
        for (int o = 1; o < 32; o <<= 1) ss += __shfl_xor(ss, o);
        const float rstd = 1.0f / sqrtf(ss * (1.0f / 128.0f) + EPS);
        u32x2 w; w.x = pk2(y[0] * rstd, y[1] * rstd); w.y = pk2(y[2] * rstd, y[3] * rstd);
        *(u32x2*)(Y + (size_t)m * DMIX + c) = w;
    }
}
__device__ __forceinline__ void d_xbc_act(const bf16* __restrict__ PROJ, const float* __restrict__ cw, const float* __restrict__ cb, bf16* __restrict__ XBCA, int m, int lane) {
    if (m >= MROW + NMETA) return;
    int b, l; if (m < TR) { b = m / SEQ; l = (m % SEQ) + NMETA; } else { b = 0; l = m - MROW; }
    int rk[4];
#pragma unroll
    for (int k = 0; k < 4; ++k) { const int lk = l - 3 + k; rk[k] = lk >= 0 ? row_of(b, lk) : -1; }
#pragma unroll
    for (int j = 0; j < 8; ++j) {
        const int c = 256 * j + 4 * lane;
        f32x4 a = *(const f32x4*)(cb + c);
#pragma unroll
        for (int k = 0; k < 4; ++k) if (rk[k] >= 0) { const u32x2 u = *(const u32x2*)(PROJ + (size_t)rk[k] * NPROJ + C_XS + c); const f32x4 w = *(const f32x4*)(cw + k * 2048 + c);
            a.x += w.x * bflo(u.x); a.y += w.y * bfhi(u.x); a.z += w.z * bflo(u.y); a.w += w.w * bfhi(u.y); }
        u32x2 o; o.x = pk2(silu_f(a.x), silu_f(a.y)); o.y = pk2(silu_f(a.z), silu_f(a.w));
        *(u32x2*)(XBCA + (size_t)m * 2048 + c) = o;
    }
}
__device__ __forceinline__ void d_ssd_naive(const bf16* __restrict__ XBCA, const bf16* __restrict__ PROJ, const float* __restrict__ DT, const float* __restrict__ dt_bias,
                                                   const float* __restrict__ a_log, const float* __restrict__ dpar, bf16* __restrict__ YPRE, int item, int p) {
    const int b = item >> 4, h = item & 15, g = h >> 2;
    const float Aneg = -__expf(a_log[h]), dtb = dt_bias[h], Dh = dpar[h];
    float S[128];
#pragma unroll
    for (int n = 0; n < 128; ++n) S[n] = 0.f;
    int row = row_of(b, 0);
    float n_draw = DT[(size_t)row * 16 + h]; unsigned short n_x = XBCA[(size_t)row * 2048 + h * 64 + p];
    unsigned n_bw = *(const unsigned*)(XBCA + (size_t)row * 2048 + 1024 + g * 128 + 2 * p), n_cw = *(const unsigned*)(XBCA + (size_t)row * 2048 + 1536 + g * 128 + 2 * p);
    unsigned short n_z = PROJ[(size_t)row * NPROJ + C_Z + h * 64 + p];
    for (int l = 0; l < LSEQ; ++l) {
        const int crow = row; const float draw = n_draw + dtb; const float xv = bf2f(n_x); const unsigned bw = n_bw, cw = n_cw; const float z = bf2f(n_z);
        if (l + 1 < LSEQ) { row = row_of(b, l + 1);
            n_draw = DT[(size_t)row * 16 + h]; n_x = XBCA[(size_t)row * 2048 + h * 64 + p];
            n_bw = *(const unsigned*)(XBCA + (size_t)row * 2048 + 1024 + g * 128 + 2 * p); n_cw = *(const unsigned*)(XBCA + (size_t)row * 2048 + 1536 + g * 128 + 2 * p);
            n_z = PROJ[(size_t)row * NPROJ + C_Z + h * 64 + p]; }
        const float dtv = draw > 20.f ? draw : log1pf(__expf(draw));
        const float dec = __expf(dtv * Aneg), xdt = xv * dtv;
        float y = 0.f;
#pragma unroll
        for (int n = 0; n < 128; n += 2) {
            const unsigned bb = (unsigned)__builtin_amdgcn_readlane((int)bw, n >> 1), cc = (unsigned)__builtin_amdgcn_readlane((int)cw, n >> 1);
            S[n] = S[n] * dec + xdt * bflo(bb); y += S[n] * bflo(cc);
            S[n + 1] = S[n + 1] * dec + xdt * bfhi(bb); y += S[n + 1] * bfhi(cc);
        }
        if (l >= NMETA) { const float yg = (y + Dh * xv) * silu_f(z); YPRE[(size_t)crow * 1024 + h * 64 + p] = (bf16)f2bf(yg); }
    }
}
__device__ __forceinline__ void d_ssd_norm(const bf16* __restrict__ YPRE, bf16* __restrict__ Y, int m, int lane) {
#pragma unroll
    for (int j = 0; j < 4; ++j) {
        const int c = 256 * j + 4 * lane;
        const u32x2 u = *(const u32x2*)(YPRE + (size_t)m * 1024 + c);
        const float y0 = bflo(u.x), y1 = bfhi(u.x), y2 = bflo(u.y), y3 = bfhi(u.y);
        const float ss = wave_sum((y0 * y0 + y1 * y1) + (y2 * y2 + y3 * y3));
        const float rstd = 1.0f / sqrtf(ss * (1.0f / 256.0f) + EPS);
        u32x2 w; w.x = pk2(y0 * rstd, y1 * rstd); w.y = pk2(y2 * rstd, y3 * rstd);
        *(u32x2*)(Y + (size_t)m * DMIX + 1024 + c) = w;
    }
}

enum { PH_PREP = 0, PH_INPROJ, PH_MIXA, PH_MIXB, PH_MIXC, PH_OUTPROJ, PH_ROUTER, PH_GU, PH_DOWN, PH_FINAL, PH_N };
__global__ void __launch_bounds__(NWAVES * 64, 2) mk_fwd(Args args) {
    extern __shared__ __attribute__((aligned(16))) unsigned char lds_raw[];
    LAS unsigned char* lds = (LAS unsigned char*)lds_raw;
    const int tid = threadIdx.x, lane = tid & 63, wave = __builtin_amdgcn_readfirstlane(tid >> 6);
    const int G = gridDim.x; const int bx = blockIdx.x; const int vcu = (G % 8 == 0) ? (bx % 8) * (G / 8) + bx / 8 : bx;
    unsigned char* ws = args.ws;
    for (int u = tid; u < (LDS_BYTES - LDSCTL_OFF) / 4; u += NWAVES * 64) ((LAS unsigned*)(lds + LDSCTL_OFF))[u] = 0u;
    __syncthreads();
    const int lo = args.ph_lo, hi = args.ph_hi;
    const bool multi = (hi - lo) > 1;
    XcdBarrier bar; bar.bar = (unsigned*)(ws + WS_CTL) + CW_BAR; bar.x = 0; bar.st = nullptr;
    if (multi) bar = xcd_barrier_post((unsigned*)(ws + WS_CTL) + CW_BAR, (volatile LAS unsigned*)(lds + MISC_OFF) + 8);
#ifndef PHASE_MASK
#define PHASE_MASK 0xffff
#endif
#define IN(k) (((PHASE_MASK >> (k)) & 1) && lo <= (k) && (k) < hi)
#define SEAM(k) do { if (IN(k) && IN((k) + 1)) xcd_barrier(bar); } while (0)

    if (IN(PH_PREP)) { p0_prologue(args, lds, vcu, G, tid, lane, wave); __syncthreads(); SEAM(PH_PREP); }

    if (IN(PH_INPROJ)) {
        pg8::DenseSched S; S.init(TA, NPROJ, 1024, ws + WS_WIN, G, bx);
        pg8::EpiProj E{(bf16*)(ws + WS_PROJ), NPROJ};
        pg8::gemm_phase<pg8::EpiProj, pg8::DenseSched, true, true>(lds + RING_OFF, (const char*)(ws + WS_XN), 1024, S, E);
        SEAM(PH_INPROJ);
    }
    if (IN(PH_MIXA)) {
        const int gw = vcu * NWAVES + wave, NGW = G * NWAVES;
        for (int m = gw; m < TR; m += NGW) d_conv_branch((const bf16*)(ws + WS_PROJ), args.in[I_CSW], (bf16*)(ws + WS_Y), m, lane);
        for (int m = gw; m < TA; m += NGW) d_xbc_act((const bf16*)(ws + WS_PROJ), args.in[I_SCW], args.in[I_SCB], (bf16*)(ws + WS_XBCA), m, lane);
        SEAM(PH_MIXA);
    }
    if (IN(PH_MIXB)) {
        for (int item = bx; item < BATCH * NH; item += G) if (wave == 0) d_ssd_naive((const bf16*)(ws + WS_XBCA), (const bf16*)(ws + WS_PROJ), (const float*)(ws + WS_DT), args.in[I_DTB], args.in[I_ALOG], args.in[I_SD], (bf16*)(ws + WS_XN), item, lane);
        SEAM(PH_MIXB);
    }
    if (IN(PH_MIXC)) {
        const int gw = vcu * NWAVES + wave, NGW = G * NWAVES;
        for (int m = gw; m < TR; m += NGW) d_ssd_norm((const bf16*)(ws + WS_XN), (bf16*)(ws + WS_Y), m, lane);
        SEAM(PH_MIXC);
    }
    if (IN(PH_OUTPROJ)) {
        pg8::DenseSched S; S.init(TR, 1024, 2048, ws + WS_WOUT, G, bx);
        pg8::EpiH1 E{args.in[I_X], (float*)(ws + WS_H1), 1024};
        pg8::gemm_phase<pg8::EpiH1, pg8::DenseSched, true, true>(lds + RING_OFF, (const char*)(ws + WS_Y), 2048, S, E);
        SEAM(PH_OUTPROJ);
    }
    if (IN(PH_ROUTER)) { p4_router(args, lds, vcu, G, tid, lane, wave); SEAM(PH_ROUTER); }
    if (IN(PH_GU)) {
        moe_tables(args, lds, tid);
        pg8::MoeSched<true> S; S.tst = (const LAS int*)(lds + MOE_OFF); S.cnt = S.tst + 40; S.G = G; S.c = bx; S.NP = 8; S.K = 1024; S.list = (const int*)(ws + WS_LIST);
        S.Bt = (const char*)(ws + WS_WGU); S.estride = (size_t)2048 * 1024 * 2;
        pg8::EpiSwiGLU E{(bf16*)(ws + WS_ACT), args.in[I_BGU]};
        pg8::gemm_phase<pg8::EpiSwiGLU, pg8::MoeSched<true>, true, true>(lds + RING_OFF, (const char*)(ws + WS_XN), 1024, S, E);
        SEAM(PH_GU);
    }
    if (IN(PH_DOWN)) {
        moe_tables(args, lds, tid);
        pg8::MoeSched<false> S; S.tst = (const LAS int*)(lds + MOE_OFF); S.cnt = S.tst + 40; S.G = G; S.c = bx; S.NP = 4; S.K = 1024; S.list = (const int*)(ws + WS_LIST);
        S.Bt = (const char*)(ws + WS_WDN); S.estride = (size_t)1024 * 1024 * 2;
        pg8::EpiDown E{(bf16*)(ws + WS_YE), args.in[I_BDN], (const int*)(ws + WS_LIST), (const float*)(ws + WS_GATE)};
        pg8::gemm_phase<pg8::EpiDown, pg8::MoeSched<false>, true, true>(lds + RING_OFF, (const char*)(ws + WS_ACT), 1024, S, E);
        SEAM(PH_DOWN);
    }
    if (IN(PH_FINAL)) { p7_final(args, vcu, G, lane, wave); }
#undef IN
#undef SEAM
}

extern "C" void kernel_launch(void* const* d_in, const int* in_sizes, int n_in, void* d_out, int out_size, void* d_ws, size_t ws_size, hipStream_t stream) {
    static int grid = 0;
    if (grid == 0) {
        if (n_in != 21 || in_sizes[0] != TR * D || out_size != TR * D || ws_size < WS_END) { fprintf(stderr, "kernel_launch: unexpected problem shape (n_in %d, in0 %d, out %d, ws %zu)\n", n_in, n_in > 0 ? in_sizes[0] : -1, out_size, ws_size); grid = -1; return; }
        int dev = 0, cus = 0, per_cu = 0;
        if (hipGetDevice(&dev) != hipSuccess || hipDeviceGetAttribute(&cus, hipDeviceAttributeMultiprocessorCount, dev) != hipSuccess) { grid = -1; return; }
        if (hipFuncSetAttribute((const void*)mk_fwd, hipFuncAttributeMaxDynamicSharedMemorySize, LDS_BYTES) != hipSuccess) { fprintf(stderr, "kernel_launch: hipFuncSetAttribute failed\n"); grid = -1; return; }
        if (hipOccupancyMaxActiveBlocksPerMultiprocessor(&per_cu, (const void*)mk_fwd, NWAVES * 64, LDS_BYTES) != hipSuccess || per_cu < 1) { fprintf(stderr, "kernel_launch: occupancy query says %d\n", per_cu); per_cu = 1; }
        (void)hipGetLastError();
        grid = cus;
    }
    if (grid < 0) return;
    (void)hipMemsetAsync((char*)d_ws + WS_CTL, 0, CTL_ZERO_BYTES, stream);
    Args a{};
    for (int i = 0; i < 21; ++i) a.in[i] = (const float*)d_in[i];
    a.out = (float*)d_out; a.ws = (unsigned char*)d_ws;
    unsigned char* ws = (unsigned char*)d_ws;
    auto launch = [&](int lo, int hi) { a.ph_lo = lo; a.ph_hi = hi; hipLaunchKernelGGL(mk_fwd, dim3(grid), dim3(NWAVES * 64), LDS_BYTES, stream, a); };
    launch(0, PH_N);
}
```

```cpp
#include <hip/hip_runtime.h>
#include <cstdio>
#include <cstdint>

#define LAS __attribute__((address_space(3)))
#define GAS __attribute__((address_space(1)))
typedef unsigned short bf16;
typedef short bf16x8 __attribute__((ext_vector_type(8)));
typedef float f32x4 __attribute__((ext_vector_type(4)));
typedef float f32x2 __attribute__((ext_vector_type(2)));
typedef unsigned u32x4 __attribute__((ext_vector_type(4)));
typedef unsigned u32x2 __attribute__((ext_vector_type(2)));
typedef GAS unsigned gu32;

constexpr int BATCH = 16, SEQ = 2048, D = 1024, NMETA = 16, LSEQ = SEQ + NMETA;
constexpr int TR = BATCH * SEQ;
constexpr int TA = 33024;
constexpr int MROW = TR;
constexpr int WIN_LD = 6160, NPROJ = 6144;
constexpr int C_CB = 0, C_CC = 1024, C_CX = 2048, C_Z = 3072, C_XS = 4096, C_BS = 5120, C_CS = 5632;
constexpr int NH = 16, HD = 64, NE = 32, DMIX = 2048;
constexpr float EPS = 1e-5f;
constexpr float SW_ALPHA = 1.702f, SW_LIMIT = 7.0f;

constexpr size_t MiB = 1u << 20;
constexpr size_t WS_CTL = 0, CTL_ZERO_BYTES = 1 * MiB;
constexpr size_t WS_LIST = 1 * MiB;
constexpr size_t WS_GATE = 5 * MiB;
constexpr size_t WS_DT = 6 * MiB;
constexpr size_t WS_WIN = 12 * MiB;
constexpr size_t WS_WOUT = 24 * MiB;
constexpr size_t WS_WGU = 28 * MiB;
constexpr size_t WS_WDN = 156 * MiB;
constexpr size_t WS_XN = 220 * MiB;
constexpr size_t WS_PROJ = 285 * MiB;
constexpr size_t WS_ACT = 285 * MiB;
constexpr size_t WS_YE = 557 * MiB;
constexpr size_t WS_Y = 672 * MiB;
constexpr size_t WS_H1 = 816 * MiB;
constexpr size_t WS_XBCA = 880 * MiB;
constexpr size_t WS_END = 1024 * MiB;
constexpr int CW_CNT = 64;
constexpr int CW_BAR = 4096;

__device__ __forceinline__ unsigned f2bf(float f) { unsigned u = __float_as_uint(f); return (u + 0x7fffu + ((u >> 16) & 1u)) >> 16; }
__device__ __forceinline__ unsigned pk2(float lo, float hi) { return f2bf(lo) | (f2bf(hi) << 16); }
__device__ __forceinline__ float bf2f(unsigned short b) { return __uint_as_float(((unsigned)b) << 16); }
__device__ __forceinline__ float bflo(unsigned w) { return __uint_as_float(w << 16); }
__device__ __forceinline__ float bfhi(unsigned w) { return __uint_as_float(w & 0xffff0000u); }
__device__ __forceinline__ unsigned cvt_pk_bf16(float lo, float hi) { unsigned r; asm volatile("v_cvt_pk_bf16_f32 %0, %1, %2" : "=v"(r) : "v"(lo), "v"(hi)); return r; }
__device__ __forceinline__ float wave_sum(float v) {
#pragma unroll
    for (int o = 1; o < 64; o <<= 1) v += __shfl_xor(v, o);
    return v;
}
__device__ __forceinline__ int row_of(int b, int l) { return l >= NMETA ? b * SEQ + (l - NMETA) : MROW + l; }
__device__ __forceinline__ float silu_f(float z) { return z / (1.0f + __expf(-z)); }
#define LDS_WAIT() asm volatile("s_waitcnt lgkmcnt(0)" ::: "memory")
#define VM_WAIT() asm volatile("s_waitcnt vmcnt(0)" ::: "memory")

namespace pg8 {
constexpr int BM = 256, BK = 64, HALF = 128, HTB = HALF * BK * 2, STAGE_BYTES = 8 * HTB, NXCD = 8, WGM = 8;
constexpr int NOFF_REL = STAGE_BYTES + 8192;
__host__ __device__ __forceinline__ int lds_byte(int r, int c) { const int st = (r >> 4) * 2 + (c >> 5), rr = r & 15, cc = c & 31, ob = rr * 64 + cc * 2; return st * 1024 + (ob ^ (((ob >> 9) & 1) << 5)); }
__host__ __device__ __forceinline__ void stage_rc(int b, int& R, int& C) { const int st = b / 1024, sb = b % 1024, swz = sb ^ (((sb >> 9) & 1) << 5); R = (st >> 1) * 16 + swz / 64; C = (st & 1) * 32 + (swz % 64) / 2; }
__host__ __device__ __forceinline__ int perm32(int rho) { const int n = rho >> 4, i = rho & 15; return 8 * (i >> 2) + 4 * n + (i & 3); }

template <class Epi, class Sched, bool ALIGN_EPI, bool SP2>
__device__ __forceinline__ void gemm_phase(LAS unsigned char* lds, const char* Abase, const int K, const Sched& S, const Epi& E) {
    const int tid = threadIdx.x, wid = __builtin_amdgcn_readfirstlane(tid >> 6), lane = tid & 63, wr = wid >> 2, wc = wid & 3, fr = lane & 15, fq = lane >> 4;
    const int nt = K / BK;
    int Rr[2]; unsigned cbA[2], voffB[2];
#pragma unroll
    for (int i = 0; i < 2; ++i) { int R, C; stage_rc(tid * 16 + i * 8192, R, C); const int Rb = Epi::PERM ? ((R & ~31) + perm32(R & 31)) : R;
        Rr[i] = R; cbA[i] = (unsigned)C * 2u; voffB[i] = (unsigned)(Rb * K + C) * 2u; }
    const size_t kstep = (size_t)(BK * 2);
    const size_t hstep = (size_t)HALF * K * 2;
    const unsigned ldsw = (unsigned)wid * 1024u;
    const int aoff = lds_byte(wr * 64 + fr, fq * 8), boff = lds_byte(wc * 32 + fr, fq * 8);
#define PG8_SA(b, h) (((b) * 2 + (h)) * HTB)
#define PG8_SB(b, h) ((4 + (b) * 2 + (h)) * HTB)
#define PG8_STAGEB(bufoff, gbase) do { _Pragma("unroll") for (int _i = 0; _i < 2; ++_i) \
        __builtin_amdgcn_global_load_lds((const unsigned*)((const char*)(gbase) + voffB[_i]), (LAS unsigned*)(lds + (bufoff) + ldsw + _i * 8192), 16, 0, 0); } while (0)
#define PG8_STAGEA(bufoff, offs, kt) do { const char* _gb = Abase + (size_t)(kt) * kstep; _Pragma("unroll") for (int _i = 0; _i < 2; ++_i) \
        __builtin_amdgcn_global_load_lds((const unsigned*)(_gb + (offs)[_i]), (LAS unsigned*)(lds + (bufoff) + ldsw + _i * 8192), 16, 0, 0); } while (0)
#define PG8_LDA(dst, b, h) do { _Pragma("unroll") for (int m = 0; m < 4; ++m) _Pragma("unroll") for (int k = 0; k < 2; ++k) dst[m][k] = *(const LAS bf16x8*)(lds + PG8_SA(b, h) + aoff + m * 2048 + k * 1024); } while (0)
#define PG8_LDB(dst, b, h) do { _Pragma("unroll") for (int n = 0; n < 2; ++n) _Pragma("unroll") for (int k = 0; k < 2; ++k) dst[n][k] = *(const LAS bf16x8*)(lds + PG8_SB(b, h) + boff + n * 2048 + k * 1024); } while (0)
#define PG8_MMA(ai, bj, At, Bt) do { __builtin_amdgcn_s_setprio(1); _Pragma("unroll") for (int m = 0; m < 4; ++m) _Pragma("unroll") for (int n = 0; n < 2; ++n) _Pragma("unroll") for (int k = 0; k < 2; ++k) \
        acc[ai][bj][m][n] = __builtin_amdgcn_mfma_f32_16x16x32_bf16(Bt[n][k], At[m][k], acc[ai][bj][m][n], 0, 0, 0); __builtin_amdgcn_s_setprio(0); } while (0)
#define PG8_WAIT_V(n) asm volatile("s_waitcnt vmcnt(" #n ")" ::: "memory")
#define PG8_WAIT_L(n) asm volatile("s_waitcnt lgkmcnt(" #n ")" ::: "memory")
#define PG8_BAR __builtin_amdgcn_s_barrier()
#define PG8_SCHED __builtin_amdgcn_sched_barrier(0)
    typename Sched::Unit cur, nxt; int ui = 0;
    if (!S.next(0, cur)) return;
    f32x4 acc[2][2][4][2];
#pragma unroll
    for (int a = 0; a < 2; ++a)
#pragma unroll
        for (int b = 0; b < 2; ++b)
#pragma unroll
            for (int m = 0; m < 4; ++m)
#pragma unroll
                for (int n = 0; n < 2; ++n) acc[a][b][m][n] = (f32x4){0.f, 0.f, 0.f, 0.f};
    bf16x8 At[4][2], B0[2][2], B1[2][2];
    unsigned coff[2][2];
    LAS u32x4* stash = (LAS u32x4*)(lds + NOFF_REL) + tid;
#pragma unroll
    for (int h = 0; h < 2; ++h)
#pragma unroll
        for (int i = 0; i < 2; ++i) coff[h][i] = S.aoff(cur, h * HALF + Rr[i]) + cbA[i];
    const char* cB = S.bptr(cur);
    if constexpr (SP2) {
        PG8_STAGEB(PG8_SB(0, 0), cB); PG8_STAGEB(PG8_SB(0, 1), cB + hstep); PG8_STAGEA(PG8_SA(0, 0), coff[0], 0); PG8_STAGEA(PG8_SA(0, 1), coff[1], 0);
        if (wr == 1) PG8_BAR;
        PG8_WAIT_V(2); PG8_BAR;
        PG8_STAGEB(PG8_SB(1, 0), cB + kstep); PG8_STAGEA(PG8_SA(1, 0), coff[0], 1); PG8_STAGEB(PG8_SB(1, 1), cB + hstep + kstep);
        PG8_WAIT_V(6); PG8_BAR;
    } else {
        PG8_STAGEB(PG8_SB(0, 0), cB); PG8_STAGEA(PG8_SA(0, 0), coff[0], 0); PG8_STAGEB(PG8_SB(0, 1), cB + hstep); PG8_STAGEA(PG8_SA(0, 1), coff[1], 0);
        if (wr == 1) PG8_BAR;
        PG8_WAIT_V(4); PG8_BAR;
        PG8_STAGEB(PG8_SB(1, 0), cB + kstep); PG8_STAGEA(PG8_SA(1, 0), coff[0], 1); PG8_STAGEB(PG8_SB(1, 1), cB + hstep + kstep);
        PG8_WAIT_V(6); PG8_BAR;
    }
    for (;;) {
        const bool has_next = S.next(ui + 1, nxt);
        const char* nB = has_next ? S.bptr(nxt) : cB;
        if (has_next) { u32x4 w; w.x = S.aoff(nxt, Rr[0]) + cbA[0]; w.y = S.aoff(nxt, Rr[1]) + cbA[1]; w.z = S.aoff(nxt, HALF + Rr[0]) + cbA[0]; w.w = S.aoff(nxt, HALF + Rr[1]) + cbA[1]; *stash = w; }
        for (int t = 0; t < nt; t += 2) {
            const bool last = (t == nt - 2);
            const char* b2 = last ? nB : cB + (size_t)(t + 2) * kstep;
            const char* b3 = b2 + kstep;
            const int ka = last ? 0 : t + 2;
            if constexpr (SP2) {
            PG8_LDB(B0, 0, 0); PG8_LDB(B1, 0, 1); PG8_SCHED; PG8_LDA(At, 0, 0); PG8_STAGEA(PG8_SA(1, 1), coff[1], t + 1);
            PG8_WAIT_V(8); PG8_WAIT_L(0); PG8_BAR; PG8_MMA(0, 0, At, B0); PG8_MMA(0, 1, At, B1); PG8_BAR; PG8_SCHED;
            if (last && has_next) { const u32x4 w = *stash; coff[0][0] = w.x; coff[0][1] = w.y; coff[1][0] = w.z; coff[1][1] = w.w; }
            PG8_LDA(At, 0, 1); PG8_STAGEB(PG8_SB(0, 0), b2); PG8_STAGEB(PG8_SB(0, 1), b2 + hstep); PG8_STAGEA(PG8_SA(0, 0), coff[0], ka);
            PG8_WAIT_V(8); PG8_WAIT_L(0); PG8_BAR; PG8_MMA(1, 0, At, B0); PG8_MMA(1, 1, At, B1); PG8_BAR; PG8_SCHED;
            PG8_LDB(B0, 1, 0); PG8_LDB(B1, 1, 1); PG8_SCHED; PG8_LDA(At, 1, 0); PG8_STAGEA(PG8_SA(0, 1), coff[1], ka);
            PG8_WAIT_V(8); PG8_WAIT_L(0); PG8_BAR; PG8_MMA(0, 0, At, B0); PG8_MMA(0, 1, At, B1); PG8_BAR; PG8_SCHED;
            PG8_LDA(At, 1, 1); PG8_STAGEB(PG8_SB(1, 0), b3); PG8_STAGEB(PG8_SB(1, 1), b3 + hstep); PG8_STAGEA(PG8_SA(1, 0), coff[0], ka + 1);
            PG8_WAIT_V(8); PG8_WAIT_L(0); PG8_BAR; PG8_MMA(1, 0, At, B0); PG8_MMA(1, 1, At, B1); PG8_BAR; PG8_SCHED;
            } else {
            PG8_LDB(B0, 0, 0); PG8_SCHED; PG8_LDA(At, 0, 0); PG8_STAGEA(PG8_SA(1, 1), coff[1], t + 1);
            PG8_WAIT_L(8); PG8_BAR; PG8_WAIT_L(0); PG8_MMA(0, 0, At, B0); PG8_BAR; PG8_SCHED;
            if (last && has_next) { const u32x4 w = *stash; coff[0][0] = w.x; coff[0][1] = w.y; coff[1][0] = w.z; coff[1][1] = w.w; }
            PG8_LDB(B1, 0, 1); PG8_STAGEB(PG8_SB(0, 0), b2);
            PG8_BAR; PG8_WAIT_L(0); PG8_MMA(0, 1, At, B1); PG8_BAR;
            PG8_LDA(At, 0, 1); PG8_STAGEA(PG8_SA(0, 0), coff[0], ka);
            PG8_BAR; PG8_WAIT_L(0); PG8_MMA(1, 0, At, B0); PG8_BAR; PG8_SCHED;
            PG8_STAGEB(PG8_SB(0, 1), b2 + hstep);
            PG8_WAIT_V(6); PG8_BAR; PG8_MMA(1, 1, At, B1); PG8_BAR;
            PG8_LDB(B0, 1, 0); PG8_SCHED; PG8_LDA(At, 1, 0); PG8_STAGEA(PG8_SA(0, 1), coff[1], ka);
            PG8_WAIT_L(8); PG8_BAR; PG8_WAIT_L(0); PG8_MMA(0, 0, At, B0); PG8_BAR; PG8_SCHED;
            PG8_LDB(B1, 1, 1); PG8_STAGEB(PG8_SB(1, 0), b3);
            PG8_BAR; PG8_WAIT_L(0); PG8_MMA(0, 1, At, B1); PG8_BAR;
            PG8_LDA(At, 1, 1); PG8_STAGEA(PG8_SA(1, 0), coff[0], ka + 1);
            PG8_BAR; PG8_WAIT_L(0); PG8_MMA(1, 0, At, B0); PG8_BAR; PG8_SCHED;
            PG8_STAGEB(PG8_SB(1, 1), b3 + hstep);
            PG8_WAIT_V(6); PG8_BAR; PG8_MMA(1, 1, At, B1); PG8_BAR;
            }
        }
        if constexpr (ALIGN_EPI) { if (wr == 0) PG8_BAR; }
        asm volatile("" ::: "memory");
        E(acc, cur, wr, wc, fr, fq);
        if (!has_next) break;
#pragma unroll
        for (int a = 0; a < 2; ++a)
#pragma unroll
            for (int b = 0; b < 2; ++b)
#pragma unroll
                for (int m = 0; m < 4; ++m)
#pragma unroll
                    for (int n = 0; n < 2; ++n) acc[a][b][m][n] = (f32x4){0.f, 0.f, 0.f, 0.f};
        cur = nxt; cB = nB; ++ui;
        if constexpr (ALIGN_EPI) { if (wr == 1) PG8_BAR; }
    }
    PG8_WAIT_V(0);
    if constexpr (!ALIGN_EPI) { if (wr == 0) PG8_BAR; }
    PG8_BAR;
#undef PG8_SA
#undef PG8_SB
#undef PG8_STAGEA
#undef PG8_STAGEB
#undef PG8_LDA
#undef PG8_LDB
#undef PG8_MMA
#undef PG8_WAIT_V
#undef PG8_WAIT_L
#undef PG8_BAR
#undef PG8_SCHED
}

struct DenseUnit { int pm, pn; };
struct DenseSched {
    typedef DenseUnit Unit;
    int nM, nN, nwg, G, c, K; const char* Bt;
    __device__ void init(int M, int N, int K_, const void* Bt_, int G_, int c_) { nM = M / BM; nN = N / BM; nwg = nM * nN; G = G_; c = c_; K = K_; Bt = (const char*)Bt_; }
    __device__ __forceinline__ bool next(int i, Unit& u) const {
        const long L = (long)i * G + c; if (L >= nwg) return false;
        int wgid = (int)L; { const int q = nwg / NXCD, r = nwg % NXCD, xcd = wgid % NXCD, off = wgid / NXCD; wgid = (xcd < r ? xcd * (q + 1) : r * (q + 1) + (xcd - r) * q) + off; }
        const int nig = WGM * nN, gid = wgid / nig, fm = gid * WGM, gsz = (nM - fm) < WGM ? (nM - fm) : WGM;
        u.pm = fm + ((wgid % nig) % gsz); u.pn = (wgid % nig) / gsz; return true;
    }
    __device__ __forceinline__ unsigned aoff(const Unit& u, int r) const { return (unsigned)(u.pm * BM + r) * (unsigned)(K * 2); }
    __device__ __forceinline__ const char* bptr(const Unit& u) const { return Bt + (size_t)u.pn * BM * K * 2; }
};

struct MoeUnit { int e, rt, l0, nv, pn; };
template <bool GATHER>
struct MoeSched {
    typedef MoeUnit Unit;
    const LAS int* tst;
    const LAS int* cnt;
    int G, c, NP, K; const int* list; const char* Bt; size_t estride;
    __device__ __forceinline__ bool next(int i, Unit& u) const {
        const int L = i * G + c; const int R = __builtin_amdgcn_readfirstlane(tst[NE]); if (L >= R * NP) return false;
        const int rt = L / NP; u.pn = L % NP;
        int e = 0;
#pragma unroll 1
        for (int j = 1; j < NE; ++j) e = (rt >= __builtin_amdgcn_readfirstlane(tst[j])) ? j : e;
        u.e = e; u.rt = rt; u.l0 = (rt - __builtin_amdgcn_readfirstlane(tst[e])) * BM; const int rem = __builtin_amdgcn_readfirstlane(cnt[e]) - u.l0; u.nv = rem < BM ? rem : BM; return true;
    }
    __device__ __forceinline__ unsigned aoff(const Unit& u, int r) const {
        if (GATHER) { const int j = (r < u.nv) ? (u.l0 + r) : u.l0; const int a = list[(size_t)u.e * TR + j]; return (unsigned)(a >> 2) * (unsigned)(K * 2); }
        else return (unsigned)(u.rt * BM + r) * (unsigned)(K * 2);
    }
    __device__ __forceinline__ const char* bptr(const Unit& u) const { return Bt + (size_t)u.e * estride + (size_t)u.pn * BM * K * 2; }
};

struct EpiProj {
    static constexpr bool PERM = true;
    bf16* O; int ldc;
    __device__ __forceinline__ void operator()(const f32x4 (&acc)[2][2][4][2], const DenseUnit& u, int wr, int wc, int fr, int fq) const {
        const int row0 = u.pm * BM + wr * 64 + fr; const int col0 = u.pn * BM + wc * 32 + 8 * fq;
#pragma unroll
        for (int ai = 0; ai < 2; ++ai)
#pragma unroll
            for (int m = 0; m < 4; ++m) { bf16* rowp = O + (size_t)(row0 + ai * HALF + m * 16) * ldc + col0;
#pragma unroll
                for (int bj = 0; bj < 2; ++bj) { const f32x4 v0 = acc[ai][bj][m][0], v1 = acc[ai][bj][m][1];
                    u32x4 w; w.x = cvt_pk_bf16(v0[0], v0[1]); w.y = cvt_pk_bf16(v0[2], v0[3]); w.z = cvt_pk_bf16(v1[0], v1[1]); w.w = cvt_pk_bf16(v1[2], v1[3]);
                    *(u32x4*)(rowp + bj * HALF) = w; } }
    }
};
struct EpiH1 {
    static constexpr bool PERM = false;
    const float* X; float* H; int ldc;
    __device__ __forceinline__ void operator()(const f32x4 (&acc)[2][2][4][2], const DenseUnit& u, int wr, int wc, int fr, int fq) const {
        const int row0 = u.pm * BM + wr * 64 + fr, col0 = u.pn * BM + wc * 32 + 4 * fq;
#pragma unroll
        for (int ai = 0; ai < 2; ++ai)
#pragma unroll
            for (int m = 0; m < 4; ++m) { const size_t off = (size_t)(row0 + ai * HALF + m * 16) * ldc + col0;
#pragma unroll
                for (int bj = 0; bj < 2; ++bj)
#pragma unroll
                    for (int n = 0; n < 2; ++n) { const f32x4 xv = *(const f32x4*)(X + off + bj * HALF + n * 16); *(f32x4*)(H + off + bj * HALF + n * 16) = xv + acc[ai][bj][m][n]; }
                asm volatile("" ::: "memory"); }
    }
};
__device__ __forceinline__ float swiglu1(float g, float l) {
    g = fminf(g, SW_LIMIT); l = fminf(fmaxf(l, -SW_LIMIT), SW_LIMIT);
    return g * (l + 1.0f) / (1.0f + __expf(-SW_ALPHA * g));
}
struct EpiSwiGLU {
    static constexpr bool PERM = true;
    bf16* ACT; const float* bgu;
    __device__ __forceinline__ void operator()(const f32x4 (&acc)[2][2][4][2], const MoeUnit& u, int wr, int wc, int fr, int fq) const {
        const int row0 = u.rt * BM + wr * 64 + fr; const int j0 = u.pn * HALF + wc * 32 + 8 * fq;
        const float* bg = bgu + (size_t)u.e * 2048 + j0;
        const f32x4 g0 = *(const f32x4*)(bg), g1 = *(const f32x4*)(bg + 4), l0 = *(const f32x4*)(bg + 1024), l1 = *(const f32x4*)(bg + 1028);
#pragma unroll
        for (int ai = 0; ai < 2; ++ai)
#pragma unroll
            for (int m = 0; m < 4; ++m) { bf16* rowp = ACT + (size_t)(row0 + ai * HALF + m * 16) * 1024 + j0;
                const f32x4 a0 = acc[ai][0][m][0] + g0, a1 = acc[ai][0][m][1] + g1, b0 = acc[ai][1][m][0] + l0, b1 = acc[ai][1][m][1] + l1;
                u32x4 w; w.x = cvt_pk_bf16(swiglu1(a0[0], b0[0]), swiglu1(a0[1], b0[1])); w.y = cvt_pk_bf16(swiglu1(a0[2], b0[2]), swiglu1(a0[3], b0[3]));
                w.z = cvt_pk_bf16(swiglu1(a1[0], b1[0]), swiglu1(a1[1], b1[1])); w.w = cvt_pk_bf16(swiglu1(a1[2], b1[2]), swiglu1(a1[3], b1[3]));
                *(u32x4*)rowp = w; }
    }
};
struct EpiDown {
    static constexpr bool PERM = true;
    bf16* YE; const float* bdn; const int* list; const float* gate;
    __device__ __forceinline__ void operator()(const f32x4 (&acc)[2][2][4][2], const MoeUnit& u, int wr, int wc, int fr, int fq) const {
        const int col0 = u.pn * BM + wc * 32 + 8 * fq;
        const float* bb = bdn + (size_t)u.e * 1024 + col0;
        f32x4 bv[2][2];
#pragma unroll
        for (int bj = 0; bj < 2; ++bj)
#pragma unroll
            for (int n = 0; n < 2; ++n) bv[bj][n] = *(const f32x4*)(bb + bj * HALF + 4 * n);
#pragma unroll
        for (int ai = 0; ai < 2; ++ai)
#pragma unroll
            for (int m = 0; m < 4; ++m) { const int r = ai * HALF + wr * 64 + m * 16 + fr;
                if (r < u.nv) { const int a = list[(size_t)u.e * TR + u.l0 + r]; const float g = gate[a]; bf16* rowp = YE + (size_t)a * 1024 + col0;
#pragma unroll
                    for (int bj = 0; bj < 2; ++bj) { const f32x4 v0 = (acc[ai][bj][m][0] + bv[bj][0]) * g, v1 = (acc[ai][bj][m][1] + bv[bj][1]) * g;
                        u32x4 w; w.x = cvt_pk_bf16(v0[0], v0[1]); w.y = cvt_pk_bf16(v0[2], v0[3]); w.z = cvt_pk_bf16(v1[0], v1[1]); w.w = cvt_pk_bf16(v1[2], v1[3]);
                        *(u32x4*)(rowp + bj * HALF) = w; } } }
    }
};
}

constexpr int NWAVES = 8;
constexpr int RING_OFF = 0, RING_BYTES = 131072;
constexpr int LDSCTL_OFF = RING_BYTES;
constexpr int MISC_OFF = LDSCTL_OFF + 320;
constexpr int MOE_OFF = LDSCTL_OFF + 512;
constexpr int RT_OFF = LDSCTL_OFF + 1024;
constexpr int LDS_BYTES = 147456;

#define XB_TMO      128
#define XB_XCNT(j)  (256  + 64 * (j))
#define XB_XSUB(j)  (1280 + 64 * (j))
#define XB_XGEN(j)  (2304 + 64 * (j))
#define XB_TOP      3328
#define XB_TOPGEN   3392
#define XCD_BAR_WORDS 3456
#define XB_SPIN_CAP (1u << 18)
__device__ __forceinline__ unsigned xb_ld(unsigned* p)              { return __hip_atomic_load(p, __ATOMIC_RELAXED, __HIP_MEMORY_SCOPE_AGENT); }
__device__ __forceinline__ unsigned xb_add(unsigned* p, unsigned v) { return __hip_atomic_fetch_add(p, v, __ATOMIC_RELAXED, __HIP_MEMORY_SCOPE_AGENT); }
__device__ __forceinline__ unsigned xb_xcc_id() { return (unsigned)__builtin_amdgcn_s_getreg((3 << 11) | 20) & 0xFu; }
#define XB_SPIN(cond, bar) do { unsigned _sp = 0; while (cond) { __builtin_amdgcn_s_sleep(1); \
    if ((++_sp & 255u) == 0u) { if (xb_ld(&(bar)[XB_TMO])) break; if (_sp > XB_SPIN_CAP) { atomicAdd(&(bar)[XB_TMO], 1u); break; } } } } while (0)
struct XcdBarrier { unsigned* bar; unsigned x; volatile LAS unsigned* st; };
__device__ __forceinline__ XcdBarrier xcd_barrier_post(unsigned* bar, volatile LAS unsigned* st) {
    XcdBarrier b; b.bar = bar; b.x = xb_xcc_id(); b.st = st;
    if (threadIdx.x == 0) (void)xb_add(&bar[XB_XCNT(b.x)], 1u);
    return b;
}
__device__ __forceinline__ void xcd_barrier_complete(unsigned* bar, unsigned x, unsigned& nloc, unsigned& nx) {
    const unsigned G = gridDim.x * gridDim.y * gridDim.z;
    unsigned sum, cnt, mine, sp = 0u;
    for (;;) {
        sum = 0u; cnt = 0u; mine = 0u;
#pragma unroll
        for (unsigned j = 0; j < 16; ++j) { const unsigned c = xb_ld(&bar[XB_XCNT(j)]); sum += c; cnt += (c > 0u) ? 1u : 0u; mine = (j == x) ? c : mine; }
        if (sum == G) break;
        __builtin_amdgcn_s_sleep(1);
        if ((++sp & 255u) == 0u) { if (xb_ld(&bar[XB_TMO])) break; if (sp > XB_SPIN_CAP) { atomicAdd(&bar[XB_TMO], 1u); break; } }
    }
    nloc = mine > 0u ? mine : 1u; nx = cnt > 0u ? cnt : 1u;
}
__device__ __forceinline__ void xcd_barrier(const XcdBarrier& b) {
    asm volatile("s_waitcnt vmcnt(0)" ::: "memory");
    __syncthreads();
    if (threadIdx.x == 0) {
        unsigned* bar = b.bar;
        __builtin_amdgcn_s_waitcnt(0);
        unsigned nloc = b.st[0], nx = b.st[1];
        if (nloc == 0u) { xcd_barrier_complete(bar, b.x, nloc, nx); b.st[0] = nloc; b.st[1] = nx; }
        const unsigned old = xb_add(&bar[XB_XSUB(b.x)], 1u);
        const unsigned gen = old / nloc;
        if (old + 1u == (gen + 1u) * nloc) {
            __builtin_amdgcn_fence(__ATOMIC_RELEASE, "agent");
            asm volatile("s_waitcnt vmcnt(0)" ::: "memory");
            const unsigned og = xb_add(&bar[XB_TOP], 1u);
            const unsigned tg = og / nx;
            if (og + 1u == (tg + 1u) * nx) xb_add(&bar[XB_TOPGEN], 1u);
            else XB_SPIN(xb_ld(&bar[XB_TOPGEN]) == tg, bar);
            __builtin_amdgcn_fence(__ATOMIC_ACQUIRE, "agent");
            xb_add(&bar[XB_XGEN(b.x)], 1u);
            asm volatile("s_waitcnt vmcnt(0)" ::: "memory");
        } else {
            XB_SPIN(xb_ld(&bar[XB_XGEN(b.x)]) == gen, bar);
            __builtin_amdgcn_fence(__ATOMIC_ACQUIRE, "agent");
            asm volatile("s_waitcnt vmcnt(0)" ::: "memory");
        }
    }
    __syncthreads();
}

struct Args { const float* in[21]; float* out; unsigned char* ws; int ph_lo, ph_hi; };
enum { I_X = 0, I_META, I_NMIX, I_WIN, I_CSW, I_CNW, I_SCW, I_SCB, I_DTB, I_ALOG, I_SD, I_SNW, I_WOUT, I_NFFN, I_RW, I_RB, I_WGU, I_BGU, I_WDN, I_BDN, I_NFIN };

__device__ __forceinline__ void p0_transpose_item(const float* W, int ldw, int K, const float* kscale, bf16* WT, int row_off, int k0, int n0, LAS float* scr, int lane) {
#pragma unroll 8
    for (int i = 0; i < 32; ++i) { const int kk = 2 * i + (lane >> 5); float v = W[(size_t)(k0 + kk) * ldw + n0 + (lane & 31)]; if (kscale) v *= kscale[k0 + kk]; scr[kk * 33 + (lane & 31)] = v; }
    LDS_WAIT(); asm volatile("" ::: "memory");
    const int c = lane & 7;
#pragma unroll
    for (int j = 0; j < 4; ++j) { const int n = (lane >> 3) + 8 * j; const LAS float* s = scr + (8 * c) * 33 + n;
        u32x4 o; o.x = pk2(s[0 * 33], s[1 * 33]); o.y = pk2(s[2 * 33], s[3 * 33]); o.z = pk2(s[4 * 33], s[5 * 33]); o.w = pk2(s[6 * 33], s[7 * 33]);
        *(u32x4*)(WT + (size_t)(row_off + n) * K + k0 + 8 * c) = o; }
    LDS_WAIT(); asm volatile("" ::: "memory");
}

__device__ __forceinline__ void p0_prologue(const Args& A, LAS unsigned char* lds, int vcu, int G, int tid, int lane, int wave) {
    unsigned char* ws = A.ws;
    LAS float* scr = (LAS float*)(lds + RING_OFF + wave * 16384);
    const int gw = vcu * NWAVES + wave, NGW = G * NWAVES;
    constexpr int I_IN = 16 * 192, I_OUT = 32 * 32, I_GU = 32 * 16 * 64, I_DN = 32 * 16 * 32;
    constexpr int NITEMS = I_IN + I_OUT + I_GU + I_DN;
    for (int it = gw; it < NITEMS; it += NGW) {
        int r = it;
        if (r < I_IN) { const int kb = r / 192, nb = r % 192; p0_transpose_item(A.in[I_WIN], WIN_LD, 1024, A.in[I_NMIX], (bf16*)(ws + WS_WIN), 32 * nb, 64 * kb, 32 * nb, scr, lane); continue; } r -= I_IN;
        if (r < I_OUT) { const int kb = r / 32, nb = r % 32; const float* ks = (kb < 16) ? A.in[I_CNW] : (A.in[I_SNW] - 1024);
            p0_transpose_item(A.in[I_WOUT], 1024, 2048, ks, (bf16*)(ws + WS_WOUT), 32 * nb, 64 * kb, 32 * nb, scr, lane); continue; } r -= I_OUT;
        if (r < I_GU) { const int e = r >> 10, q = r & 1023, kb = q >> 6, nb = q & 63; const int n0 = 32 * nb;
            const int bj = n0 >> 10, j = n0 & 1023, pn = j >> 7, jj = j & 127; const int rho = 256 * pn + 128 * bj + jj;
            p0_transpose_item(A.in[I_WGU] + (size_t)e * 1024 * 2048, 2048, 1024, A.in[I_NFFN], (bf16*)(ws + WS_WGU) + (size_t)e * 2048 * 1024, rho, 64 * kb, n0, scr, lane); continue; } r -= I_GU;
        { const int e = r >> 9, q = r & 511, kb = q >> 5, nb = q & 31;
            p0_transpose_item(A.in[I_WDN] + (size_t)e * 1024 * 1024, 1024, 1024, nullptr, (bf16*)(ws + WS_WDN) + (size_t)e * 1024 * 1024, 32 * nb, 64 * kb, 32 * nb, scr, lane); }
    }
    __syncthreads();
    LAS float* wdt = (LAS float*)(lds + RING_OFF);
    for (int idx = tid; idx < 16 * 1024; idx += NWAVES * 64) { const int d = idx >> 4, j = idx & 15; wdt[j * 1024 + d] = A.in[I_WIN][(size_t)d * WIN_LD + NPROJ + j] * A.in[I_NMIX][d]; }
    LDS_WAIT(); __syncthreads();
    bf16* XN = (bf16*)(ws + WS_XN); float* DT = (float*)(ws + WS_DT);
    for (int m = gw; m < TA; m += NGW) {
        const float* src = (m < TR) ? A.in[I_X] + (size_t)m * D : ((m < MROW + NMETA) ? A.in[I_META] + (size_t)(m - MROW) * D : nullptr);
        f32x4 v[4]; float s = 0.f;
#pragma unroll
        for (int j = 0; j < 4; ++j) { v[j] = src ? *((const f32x4*)src + 64 * j + lane) : (f32x4){0.f, 0.f, 0.f, 0.f}; s += (v[j].x * v[j].x + v[j].y * v[j].y) + (v[j].z * v[j].z + v[j].w * v[j].w); }
        const float rstd = 1.0f / sqrtf(wave_sum(s) * (1.0f / D) + EPS);
        u32x2* o8 = (u32x2*)(XN + (size_t)m * D) + lane;
#pragma unroll
        for (int j = 0; j < 4; ++j) { u32x2 w; w.x = pk2(v[j].x * rstd, v[j].y * rstd); w.y = pk2(v[j].z * rstd, v[j].w * rstd); o8[64 * j] = w; }
        float mine = 0.f;
#pragma unroll 2
        for (int jj = 0; jj < 16; ++jj) { float a = 0.f;
#pragma unroll
            for (int j = 0; j < 4; ++j) { const f32x4 w = *(const LAS f32x4*)(wdt + jj * 1024 + 256 * j + 4 * lane); a += (v[j].x * w.x + v[j].y * w.y) + (v[j].z * w.z + v[j].w * w.w); }
            a = wave_sum(a); mine = (lane == jj) ? a : mine; }
        if (lane < 16) DT[(size_t)m * 16 + lane] = mine * rstd;
    }
}

__device__ __forceinline__ void p4_router(const Args& A, LAS unsigned char* lds, int vcu, int G, int tid, int lane, int wave) {
    unsigned char* ws = A.ws;
    const float* H1 = (const float*)(ws + WS_H1); bf16* XN2 = (bf16*)(ws + WS_XN);
    int* LIST = (int*)(ws + WS_LIST); float* GATE = (float*)(ws + WS_GATE); unsigned* CNT = (unsigned*)(ws + WS_CTL) + CW_CNT;
    LAS float* rwt = (LAS float*)(lds + RING_OFF);
    LAS int* sel_e = (LAS int*)(lds + RT_OFF); LAS float* sel_g = (LAS float*)(lds + RT_OFF + 2048); LAS int* rnk = (LAS int*)(lds + RT_OFF + 4096);
    LAS int* cnt_loc = (LAS int*)(lds + RT_OFF + 6144); LAS int* base_loc = (LAS int*)(lds + RT_OFF + 6144 + 128);
    for (int idx = tid; idx < 32 * 1024; idx += NWAVES * 64) { const int d = idx >> 5, e = idx & 31; rwt[e * 1024 + d] = A.in[I_RW][(size_t)d * 32 + e] * A.in[I_NFFN][d]; }
    LDS_WAIT(); __syncthreads();
    float rb[32];
#pragma unroll
    for (int e = 0; e < 32; ++e) rb[e] = A.in[I_RB][e];
    for (int ch = vcu; ch < TR / 128; ch += G) {
        if (tid < 32) cnt_loc[tid] = 0;
        LDS_WAIT(); __syncthreads();
        for (int q = 0; q < 16; ++q) {
            const int tl = wave * 16 + q, t = ch * 128 + tl;
            f32x4 v[4]; float s = 0.f;
#pragma unroll
            for (int j = 0; j < 4; ++j) { v[j] = *((const f32x4*)(H1 + (size_t)t * D) + 64 * j + lane); s += (v[j].x * v[j].x + v[j].y * v[j].y) + (v[j].z * v[j].z + v[j].w * v[j].w); }
            const float rstd = 1.0f / sqrtf(wave_sum(s) * (1.0f / D) + EPS);
            u32x2* o8 = (u32x2*)(XN2 + (size_t)t * D) + lane;
#pragma unroll
            for (int j = 0; j < 4; ++j) { u32x2 w; w.x = pk2(v[j].x * rstd, v[j].y * rstd); w.y = pk2(v[j].z * rstd, v[j].w * rstd); o8[64 * j] = w; }
            float lg[32];
#pragma unroll
            for (int e = 0; e < 32; ++e) { float a = 0.f;
#pragma unroll
                for (int j = 0; j < 4; ++j) { const f32x4 w = *(const LAS f32x4*)(rwt + e * 1024 + 256 * j + 4 * lane); a += (v[j].x * w.x + v[j].y * w.y) + (v[j].z * w.z + v[j].w * w.w); }
                lg[e] = wave_sum(a) * rstd + rb[e]; }
            float tv[4]; int ti[4];
#pragma unroll
            for (int k = 0; k < 4; ++k) { float best = lg[0]; int bi = 0;
#pragma unroll
                for (int e = 1; e < 32; ++e) { const bool gt = lg[e] > best; best = gt ? lg[e] : best; bi = gt ? e : bi; }
                tv[k] = best; ti[k] = bi;
#pragma unroll
                for (int e = 0; e < 32; ++e) lg[e] = (e == bi) ? -3.0e38f : lg[e]; }
            const float e1 = __expf(tv[1] - tv[0]), e2 = __expf(tv[2] - tv[0]), e3 = __expf(tv[3] - tv[0]); const float inv = 1.0f / (1.0f + e1 + e2 + e3);
            if (lane < 4) { const int e = lane == 0 ? ti[0] : (lane == 1 ? ti[1] : (lane == 2 ? ti[2] : ti[3]));
                const float g = (lane == 0 ? 1.0f : (lane == 1 ? e1 : (lane == 2 ? e2 : e3))) * inv;
                const int r = __hip_atomic_fetch_add(cnt_loc + e, 1, __ATOMIC_RELAXED, __HIP_MEMORY_SCOPE_WORKGROUP);
                sel_e[tl * 4 + lane] = e; sel_g[tl * 4 + lane] = g; rnk[tl * 4 + lane] = r; }
        }
        LDS_WAIT(); __syncthreads();
        if (tid < 32) base_loc[tid] = (int)__hip_atomic_fetch_add(CNT + tid, (unsigned)cnt_loc[tid], __ATOMIC_RELAXED, __HIP_MEMORY_SCOPE_AGENT);
        LDS_WAIT(); __syncthreads();
        { const int e = sel_e[tid]; const int pos = base_loc[e] + rnk[tid]; const int a = (ch * 128) * 4 + tid; LIST[(size_t)e * TR + pos] = a; GATE[a] = sel_g[tid]; }
        __syncthreads();
    }
}

__device__ __forceinline__ void p7_final(const Args& A, int vcu, int G, int lane, int wave) {
    unsigned char* ws = A.ws;
    const float* H1 = (const float*)(ws + WS_H1); const bf16* YE = (const bf16*)(ws + WS_YE);
    const int gw = vcu * NWAVES + wave, NGW = G * NWAVES;
    f32x4 wf[4];
#pragma unroll
    for (int j = 0; j < 4; ++j) wf[j] = *((const f32x4*)A.in[I_NFIN] + 64 * j + lane);
    for (int t = gw; t < TR; t += NGW) {
        f32x4 v[4]; float s = 0.f;
#pragma unroll
        for (int j = 0; j < 4; ++j) v[j] = *((const f32x4*)(H1 + (size_t)t * D) + 64 * j + lane);
#pragma unroll
        for (int k = 0; k < 4; ++k) { const u32x2* yr = (const u32x2*)(YE + ((size_t)t * 4 + k) * D) + lane;
#pragma unroll
            for (int j = 0; j < 4; ++j) { const u32x2 w = yr[64 * j]; v[j].x += bflo(w.x); v[j].y += bfhi(w.x); v[j].z += bflo(w.y); v[j].w += bfhi(w.y); } }
#pragma unroll
        for (int j = 0; j < 4; ++j) s += (v[j].x * v[j].x + v[j].y * v[j].y) + (v[j].z * v[j].z + v[j].w * v[j].w);
        const float rstd = 1.0f / sqrtf(wave_sum(s) * (1.0f / D) + EPS);
        f32x4* o = (f32x4*)(A.out + (size_t)t * D) + lane;
#pragma unroll
        for (int j = 0; j < 4; ++j) o[64 * j] = v[j] * rstd * wf[j];
    }
}

__device__ __forceinline__ void moe_tables(const Args& A, LAS unsigned char* lds, int tid) {
    LAS int* tst = (LAS int*)(lds + MOE_OFF); LAS int* cnt = tst + 40;
    const unsigned* CNT = (const unsigned*)(A.ws + WS_CTL) + CW_CNT;
    if (tid < 32) cnt[tid] = (int)__hip_atomic_load(CNT + tid, __ATOMIC_RELAXED, __HIP_MEMORY_SCOPE_AGENT);
    LDS_WAIT(); __syncthreads();
    if (tid == 0) { int s = 0; for (int e = 0; e < NE; ++e) { tst[e] = s; s += (cnt[e] + 255) >> 8; } tst[NE] = s; }
    LDS_WAIT(); __syncthreads();
}

__device__ __forceinline__ void d_conv_branch(const bf16* __restrict__ PROJ, const float* __restrict__ cw, bf16* __restrict__ Y, int m, int lane) {
    const int b = m / SEQ, s = m % SEQ, l = s + NMETA;
    const int r0 = row_of(b, l), r1 = row_of(b, l - 1), r2 = row_of(b, l - 2);
#pragma unroll
    for (int j = 0; j < 4; ++j) {
        const int c = 256 * j + 4 * lane;
        const u32x2 cb = *(const u32x2*)(PROJ + (size_t)r0 * NPROJ + C_CB + c);
        const u32x2 c0 = *(const u32x2*)(PROJ + (size_t)r0 * NPROJ + C_CC + c), x0 = *(const u32x2*)(PROJ + (size_t)r0 * NPROJ + C_CX + c);
        const u32x2 c1 = *(const u32x2*)(PROJ + (size_t)r1 * NPROJ + C_CC + c), x1 = *(const u32x2*)(PROJ + (size_t)r1 * NPROJ + C_CX + c);
        const u32x2 c2 = *(const u32x2*)(PROJ + (size_t)r2 * NPROJ + C_CC + c), x2 = *(const u32x2*)(PROJ + (size_t)r2 * NPROJ + C_CX + c);
        const f32x4 w0 = *(const f32x4*)(cw + c), w1 = *(const f32x4*)(cw + 1024 + c), w2 = *(const f32x4*)(cw + 2048 + c);
        float y[4];
        y[0] = bflo(cb.x) * (w0.x * bflo(c2.x) * bflo(x2.x) + w1.x * bflo(c1.x) * bflo(x1.x) + w2.x * bflo(c0.x) * bflo(x0.x));
        y[1] = bfhi(cb.x) * (w0.y * bfhi(c2.x) * bfhi(x2.x) + w1.y * bfhi(c1.x) * bfhi(x1.x) + w2.y * bfhi(c0.x) * bfhi(x0.x));
        y[2] = bflo(cb.y) * (w0.z * bflo(c2.y) * bflo(x2.y) + w1.z * bflo(c1.y) * bflo(x1.y) + w2.z * bflo(c0.y) * bflo(x0.y));
        y[3] = bfhi(cb.y) * (w0.w * bfhi(c2.y) * bfhi(x2.y) + w1.w * bfhi(c1.y) * bfhi(x1.y) + w2.w * bfhi(c0.y) * bfhi(x0.y));
        float ss = (y[0] * y[0] + y[1] * y[1]) + (y[2] * y[2] + y[3] * y[3]);
#pragma unroll
        for (int o = 1; o < 32; o <<= 1) ss += __shfl_xor(ss, o);
        const float rstd = 1.0f / sqrtf(ss * (1.0f / 128.0f) + EPS);
        u32x2 w; w.x = pk2(y[0] * rstd, y[1] * rstd); w.y = pk2(y[2] * rstd, y[3] * rstd);
        *(u32x2*)(Y + (size_t)m * DMIX + c) = w;
    }
}
__device__ __forceinline__ void d_xbc_act(const bf16* __restrict__ PROJ, const float* __restrict__ cw, const float* __restrict__ cb, bf16* __restrict__ XBCA, int m, int lane) {
    if (m >= MROW + NMETA) return;
    int b, l; if (m < TR) { b = m / SEQ; l = (m % SEQ) + NMETA; } else { b = 0; l = m - MROW; }
    int rk[4];
#pragma unroll
    for (int k = 0; k < 4; ++k) { const int lk = l - 3 + k; rk[k] = lk >= 0 ? row_of(b, lk) : -1; }
#pragma unroll
    for (int j = 0; j < 8; ++j) {
        const int c = 256 * j + 4 * lane;
        f32x4 a = *(const f32x4*)(cb + c);
#pragma unroll
        for (int k = 0; k < 4; ++k) if (rk[k] >= 0) { const u32x2 u = *(const u32x2*)(PROJ + (size_t)rk[k] * NPROJ + C_XS + c); const f32x4 w = *(const f32x4*)(cw + k * 2048 + c);
            a.x += w.x * bflo(u.x); a.y += w.y * bfhi(u.x); a.z += w.z * bflo(u.y); a.w += w.w * bfhi(u.y); }
        u32x2 o; o.x = pk2(silu_f(a.x), silu_f(a.y)); o.y = pk2(silu_f(a.z), silu_f(a.w));
        *(u32x2*)(XBCA + (size_t)m * 2048 + c) = o;
    }
}
__device__ __forceinline__ void d_ssd_naive(const bf16* __restrict__ XBCA, const bf16* __restrict__ PROJ, const float* __restrict__ DT, const float* __restrict__ dt_bias,
                                                   const float* __restrict__ a_log, const float* __restrict__ dpar, bf16* __restrict__ YPRE, int item, int p) {
    const int b = item >> 4, h = item & 15, g = h >> 2;
    const float Aneg = -__expf(a_log[h]), dtb = dt_bias[h], Dh = dpar[h];
    float S[128];
#pragma unroll
    for (int n = 0; n < 128; ++n) S[n] = 0.f;
    int row = row_of(b, 0);
    float n_draw = DT[(size_t)row * 16 + h]; unsigned short n_x = XBCA[(size_t)row * 2048 + h * 64 + p];
    unsigned n_bw = *(const unsigned*)(XBCA + (size_t)row * 2048 + 1024 + g * 128 + 2 * p), n_cw = *(const unsigned*)(XBCA + (size_t)row * 2048 + 1536 + g * 128 + 2 * p);
    unsigned short n_z = PROJ[(size_t)row * NPROJ + C_Z + h * 64 + p];
    for (int l = 0; l < LSEQ; ++l) {
        const int crow = row; const float draw = n_draw + dtb; const float xv = bf2f(n_x); const unsigned bw = n_bw, cw = n_cw; const float z = bf2f(n_z);
        if (l + 1 < LSEQ) { row = row_of(b, l + 1);
            n_draw = DT[(size_t)row * 16 + h]; n_x = XBCA[(size_t)row * 2048 + h * 64 + p];
            n_bw = *(const unsigned*)(XBCA + (size_t)row * 2048 + 1024 + g * 128 + 2 * p); n_cw = *(const unsigned*)(XBCA + (size_t)row * 2048 + 1536 + g * 128 + 2 * p);
            n_z = PROJ[(size_t)row * NPROJ + C_Z + h * 64 + p]; }
        const float dtv = draw > 20.f ? draw : log1pf(__expf(draw));
        const float dec = __expf(dtv * Aneg), xdt = xv * dtv;
        float y = 0.f;
#pragma unroll
        for (int n = 0; n < 128; n += 2) {
            const unsigned bb = (unsigned)__builtin_amdgcn_readlane((int)bw, n >> 1), cc = (unsigned)__builtin_amdgcn_readlane((int)cw, n >> 1);
            S[n] = S[n] * dec + xdt * bflo(bb); y += S[n] * bflo(cc);
            S[n + 1] = S[n + 1] * dec + xdt * bfhi(bb); y += S[n + 1] * bfhi(cc);
        }
        if (l >= NMETA) { const float yg = (y + Dh * xv) * silu_f(z); YPRE[(size_t)crow * 1024 + h * 64 + p] = (bf16)f2bf(yg); }
    }
}
__device__ __forceinline__ void d_ssd_norm(const bf16* __restrict__ YPRE, bf16* __restrict__ Y, int m, int lane) {
#pragma unroll
    for (int j = 0; j < 4; ++j) {
        const int c = 256 * j + 4 * lane;
        const u32x2 u = *(const u32x2*)(YPRE + (size_t)m * 1024 + c);
        const float y0 = bflo(u.x), y1 = bfhi(u.x), y2 = bflo(u.y), y3 = bfhi(u.y);
        const float ss = wave_sum((y0 * y0 + y1 * y1) + (y2 * y2 + y3 * y3));
        const float rstd = 1.0f / sqrtf(ss * (1.0f / 256.0f) + EPS);
        u32x2 w; w.x = pk2(y0 * rstd, y1 * rstd); w.y = pk2(y2 * rstd, y3 * rstd);
        *(u32x2*)(Y + (size_t)m * DMIX + 1024 + c) = w;
    }
}

namespace ssd {
constexpr int XP = 144, BP = 272;
constexpr int O_XDT = 0, O_XW = 18432, O_B = 36864, O_C = 71680, O_S = 106496, O_TAB = 123904;
constexpr int NCH = 17;
template <int STEP, int PITCH> __device__ __forceinline__ void tr4(unsigned a, bf16x8 (&f)[4]) {
    u32x2 r0, r1, r2, r3, r4, r5, r6, r7;
    asm volatile("ds_read_b64_tr_b16 %0, %8 offset:%9\n\tds_read_b64_tr_b16 %1, %8 offset:%10\n\tds_read_b64_tr_b16 %2, %8 offset:%11\n\tds_read_b64_tr_b16 %3, %8 offset:%12\n\t"
                 "ds_read_b64_tr_b16 %4, %8 offset:%13\n\tds_read_b64_tr_b16 %5, %8 offset:%14\n\tds_read_b64_tr_b16 %6, %8 offset:%15\n\tds_read_b64_tr_b16 %7, %8 offset:%16\n\ts_waitcnt lgkmcnt(0)"
                 : "=&v"(r0), "=&v"(r1), "=&v"(r2), "=&v"(r3), "=&v"(r4), "=&v"(r5), "=&v"(r6), "=&v"(r7)
                 : "v"(a), "i"(0 * STEP), "i"(0 * STEP + 4 * PITCH), "i"(1 * STEP), "i"(1 * STEP + 4 * PITCH), "i"(2 * STEP), "i"(2 * STEP + 4 * PITCH), "i"(3 * STEP), "i"(3 * STEP + 4 * PITCH) : "memory");
    u32x4 w;
    w.x = r0.x; w.y = r0.y; w.z = r1.x; w.w = r1.y; f[0] = __builtin_bit_cast(bf16x8, w);
    w.x = r2.x; w.y = r2.y; w.z = r3.x; w.w = r3.y; f[1] = __builtin_bit_cast(bf16x8, w);
    w.x = r4.x; w.y = r4.y; w.z = r5.x; w.w = r5.y; f[2] = __builtin_bit_cast(bf16x8, w);
    w.x = r6.x; w.y = r6.y; w.z = r7.x; w.w = r7.y; f[3] = __builtin_bit_cast(bf16x8, w);
}
#define SSD_MFMA(a, b, c) __builtin_amdgcn_mfma_f32_16x16x32_bf16((a), (b), (c), 0, 0, 0)
__device__ __forceinline__ int grow_of(int b, int c, int r) { return c > 0 ? b * SEQ + 128 * (c - 1) + r : (r >= 112 ? MROW + r - 112 : MROW); }

__device__ __forceinline__ void chain(const Args& A, LAS unsigned char* lds, int item, int tid, int lane, int wave) {
    const int b = item >> 4, h = item & 15, g = h >> 2, fr = lane & 15, fq = lane >> 4;
    const bf16* XB = (const bf16*)(A.ws + WS_XBCA); const bf16* PROJ = (const bf16*)(A.ws + WS_PROJ); const float* DT = (const float*)(A.ws + WS_DT); bf16* YPRE = (bf16*)(A.ws + WS_XN);
    const float Aneg = -__expf(A.in[I_ALOG][h]), dtb = A.in[I_DTB][h], Dh = A.in[I_SD][h];
    const unsigned lbase = (unsigned)(size_t)lds;
    for (int i = tid; i < 64 * BP / 16; i += NWAVES * 64) *(LAS u32x4*)(lds + O_S + i * 16) = (u32x4){0u, 0u, 0u, 0u};
    f32x4 st[4];
#pragma unroll
    for (int t = 0; t < 4; ++t) st[t] = (f32x4){0.f, 0.f, 0.f, 0.f};
    u32x4 pfx[2], pfb[4], pfc[4]; float pdt[2];
#define SSD_LOAD(c) do { \
        _Pragma("unroll") for (int i = 0; i < 2; ++i) { const int q = tid + 512 * i, row = q >> 3, c16 = q & 7; const bool ok = (c) > 0 || row >= 112; \
            const u32x4 v = *(const u32x4*)(XB + (size_t)grow_of(b, (c), row) * 2048 + h * 64 + c16 * 8); pfx[i] = ok ? v : (u32x4){0u, 0u, 0u, 0u}; } \
        _Pragma("unroll") for (int i = 0; i < 4; ++i) { const int q = tid + 512 * i, row = q >> 4, c16 = q & 15; const bool ok = (c) > 0 || row >= 112; \
            const bf16* src = XB + (size_t)grow_of(b, (c), row) * 2048 + 1024 + g * 128 + c16 * 8; \
            const u32x4 vb = *(const u32x4*)src, vc = *(const u32x4*)(src + 512); pfb[i] = ok ? vb : (u32x4){0u, 0u, 0u, 0u}; pfc[i] = ok ? vc : (u32x4){0u, 0u, 0u, 0u}; } \
        _Pragma("unroll") for (int i = 0; i < 2; ++i) { const int row = 2 * lane + i; const bool ok = (c) > 0 || row >= 112; const float v = DT[(size_t)grow_of(b, (c), row) * 16 + h]; pdt[i] = ok ? v : -1.0e30f; } \
    } while (0)
#define SSD_TABLES(buf) do { \
        float d0 = pdt[0] + dtb, d1 = pdt[1] + dtb; d0 = d0 > 20.f ? d0 : log1pf(__expf(d0)); d1 = d1 > 20.f ? d1 : log1pf(__expf(d1)); \
        if (pdt[0] < -1.0e29f) d0 = 0.f; if (pdt[1] < -1.0e29f) d1 = 0.f; \
        const float a0 = d0 * Aneg, a1 = d1 * Aneg; float incl = a0 + a1; \
        _Pragma("unroll") for (int o = 1; o < 64; o <<= 1) { const float t = __shfl_up(incl, o); incl += (lane >= o) ? t : 0.f; } \
        const float c1 = incl, c0 = incl - a1; const float aend = __shfl(incl, 63); \
        if (wave == 0) { LAS float* tb = (LAS float*)(lds + O_TAB + (buf) * 2048); \
            *(LAS f32x2*)(tb + 2 * lane) = (f32x2){c0, c1}; *(LAS f32x2*)(tb + 128 + 2 * lane) = (f32x2){d0, d1}; \
            *(LAS f32x2*)(tb + 256 + 2 * lane) = (f32x2){__expf(aend - c0), __expf(aend - c1)}; *(LAS f32x2*)(tb + 384 + 2 * lane) = (f32x2){__expf(c0), __expf(c1)}; } \
    } while (0)
    SSD_LOAD(0);
    SSD_TABLES(0);
    LDS_WAIT(); __syncthreads();
    for (int c = 0; c < NCH; ++c) {
        const LAS float* tb = (const LAS float*)(lds + O_TAB + (c & 1) * 2048);
#pragma unroll
        for (int i = 0; i < 2; ++i) { const int q = tid + 512 * i, row = q >> 3, c16 = q & 7; const float dv = tb[128 + row], wv = dv * tb[256 + row];
            const u32x4 v = pfx[i]; u32x4 a, w;
            a.x = pk2(bflo(v.x) * dv, bfhi(v.x) * dv); a.y = pk2(bflo(v.y) * dv, bfhi(v.y) * dv); a.z = pk2(bflo(v.z) * dv, bfhi(v.z) * dv); a.w = pk2(bflo(v.w) * dv, bfhi(v.w) * dv);
            w.x = pk2(bflo(v.x) * wv, bfhi(v.x) * wv); w.y = pk2(bflo(v.y) * wv, bfhi(v.y) * wv); w.z = pk2(bflo(v.z) * wv, bfhi(v.z) * wv); w.w = pk2(bflo(v.w) * wv, bfhi(v.w) * wv);
            *(LAS u32x4*)(lds + O_XDT + row * XP + c16 * 16) = a; *(LAS u32x4*)(lds + O_XW + row * XP + c16 * 16) = w; }
#pragma unroll
        for (int i = 0; i < 4; ++i) { const int q = tid + 512 * i, row = q >> 4, c16 = q & 15;
            *(LAS u32x4*)(lds + O_B + row * BP + c16 * 16) = pfb[i]; *(LAS u32x4*)(lds + O_C + row * BP + c16 * 16) = pfc[i]; }
        if (c + 1 < NCH) SSD_LOAD(c + 1);
        LDS_WAIT(); __syncthreads();
        const int lrow = 16 * wave + fr;
        bf16x8 Cf[4];
#pragma unroll
        for (int ks = 0; ks < 4; ++ks) Cf[ks] = *(const LAS bf16x8*)(lds + O_C + lrow * BP + ks * 64 + fq * 16);
        f32x4 cb[8];
#pragma unroll
        for (int nt = 0; nt < 8; ++nt) { cb[nt] = (f32x4){0.f, 0.f, 0.f, 0.f};
#pragma unroll
            for (int ks = 0; ks < 4; ++ks) { const bf16x8 Bf = *(const LAS bf16x8*)(lds + O_B + (16 * nt + fr) * BP + ks * 64 + fq * 16); cb[nt] = SSD_MFMA(Bf, Cf[ks], cb[nt]); }
            __builtin_amdgcn_sched_barrier(0); }
        f32x4 y[4];
#pragma unroll
        for (int pt = 0; pt < 4; ++pt) { y[pt] = (f32x4){0.f, 0.f, 0.f, 0.f};
#pragma unroll
            for (int ks = 0; ks < 4; ++ks) { const bf16x8 Sf = *(const LAS bf16x8*)(lds + O_S + (16 * pt + fr) * BP + ks * 64 + fq * 16); y[pt] = SSD_MFMA(Sf, Cf[ks], y[pt]); }
            if (pt & 1) __builtin_amdgcn_sched_barrier(0); }
        u32x2 ex[4], ez[4];
        { const int gr = grow_of(b, c, 16 * wave + fr);
#pragma unroll
          for (int pt = 0; pt < 4; ++pt) { ex[pt] = *(const u32x2*)(XB + (size_t)gr * 2048 + h * 64 + 16 * pt + 4 * fq); ez[pt] = *(const u32x2*)(PROJ + (size_t)gr * NPROJ + C_Z + h * 64 + 16 * pt + 4 * fq); } }
        { const float al = tb[lrow];
#pragma unroll
          for (int nt = 0; nt < 8; ++nt) { const int s0 = 16 * nt + 4 * fq; const f32x4 as4 = *(const LAS f32x4*)(tb + s0); float m[4];
#pragma unroll
              for (int j = 0; j < 4; ++j) m[j] = (s0 + j <= lrow) ? cb[nt][j] * __expf(al - as4[j]) : 0.f;
              u32x2 w; w.x = pk2(m[0], m[1]); w.y = pk2(m[2], m[3]); *(LAS u32x2*)(lds + O_C + lrow * BP + s0 * 2) = w; } }
        { const float el = tb[384 + lrow];
#pragma unroll
          for (int pt = 0; pt < 4; ++pt) y[pt] = y[pt] * el; }
        bf16x8 Mf[4];
#pragma unroll
        for (int ks = 0; ks < 4; ++ks) Mf[ks] = *(const LAS bf16x8*)(lds + O_C + lrow * BP + ks * 64 + fq * 16);
        const unsigned tra = (unsigned)((8 * fq + ((lane & 15) >> 2)) * XP + 8 * (lane & 3));
        const unsigned trb = (unsigned)((8 * fq + ((lane & 15) >> 2)) * BP + 8 * (lane & 3));
#pragma unroll
        for (int pt = 0; pt < 4; ++pt) { bf16x8 Xf[4]; tr4<32 * XP, XP>(lbase + O_XDT + tra + 32 * pt, Xf);
#pragma unroll
            for (int ks = 0; ks < 4; ++ks) y[pt] = SSD_MFMA(Xf[ks], Mf[ks], y[pt]); }
        if (c > 0) { const size_t orow = (size_t)(b * SEQ + 128 * (c - 1) + lrow) * 1024 + h * 64 + 4 * fq;
#pragma unroll
            for (int pt = 0; pt < 4; ++pt) { const f32x4 v = y[pt]; const u32x2 xv = ex[pt], zv = ez[pt];
                const float o0 = (v[0] + Dh * bflo(xv.x)) * silu_f(bflo(zv.x)), o1 = (v[1] + Dh * bfhi(xv.x)) * silu_f(bfhi(zv.x));
                const float o2 = (v[2] + Dh * bflo(xv.y)) * silu_f(bflo(zv.y)), o3 = (v[3] + Dh * bfhi(xv.y)) * silu_f(bfhi(zv.y));
                u32x2 w; w.x = pk2(o0, o1); w.y = pk2(o2, o3); *(u32x2*)(YPRE + orow + 16 * pt) = w; } }
        __syncthreads();
        { const int pt4 = wave & 3, nt0 = 4 * (wave >> 2); const float dec = __expf(tb[127]);
          bf16x8 Xw[4]; tr4<32 * XP, XP>(lbase + O_XW + tra + 32 * pt4, Xw);
#pragma unroll
          for (int t = 0; t < 4; ++t) { bf16x8 Bf[4]; tr4<32 * BP, BP>(lbase + O_B + trb + 32 * (nt0 + t), Bf); st[t] = st[t] * dec;
#pragma unroll
              for (int ks = 0; ks < 4; ++ks) st[t] = SSD_MFMA(Bf[ks], Xw[ks], st[t]);
              u32x2 w; w.x = pk2(st[t][0], st[t][1]); w.y = pk2(st[t][2], st[t][3]);
              *(LAS u32x2*)(lds + O_S + (16 * pt4 + fr) * BP + (16 * (nt0 + t) + 4 * fq) * 2) = w; } }
        if (c + 1 < NCH) SSD_TABLES((c + 1) & 1);
        LDS_WAIT(); __syncthreads();
    }
#undef SSD_LOAD
#undef SSD_TABLES
}
}

enum { PH_PREP = 0, PH_INPROJ, PH_MIXA, PH_MIXB, PH_MIXC, PH_OUTPROJ, PH_ROUTER, PH_GU, PH_DOWN, PH_FINAL, PH_N };
__global__ void __launch_bounds__(NWAVES * 64, 2) mk_fwd(Args args) {
    extern __shared__ __attribute__((aligned(16))) unsigned char lds_raw[];
    LAS unsigned char* lds = (LAS unsigned char*)lds_raw;
    const int tid = threadIdx.x, lane = tid & 63, wave = __builtin_amdgcn_readfirstlane(tid >> 6);
    const int G = gridDim.x; const int bx = blockIdx.x; const int vcu = (G % 8 == 0) ? (bx % 8) * (G / 8) + bx / 8 : bx;
    unsigned char* ws = args.ws;
    for (int u = tid; u < (LDS_BYTES - LDSCTL_OFF) / 4; u += NWAVES * 64) ((LAS unsigned*)(lds + LDSCTL_OFF))[u] = 0u;
    __syncthreads();
    const int lo = args.ph_lo, hi = args.ph_hi;
    const bool multi = (hi - lo) > 1;
    XcdBarrier bar; bar.bar = (unsigned*)(ws + WS_CTL) + CW_BAR; bar.x = 0; bar.st = nullptr;
    if (multi) bar = xcd_barrier_post((unsigned*)(ws + WS_CTL) + CW_BAR, (volatile LAS unsigned*)(lds + MISC_OFF) + 8);
#ifndef PHASE_MASK
#define PHASE_MASK 0xffff
#endif
#define IN(k) (((PHASE_MASK >> (k)) & 1) && lo <= (k) && (k) < hi)
#define SEAM(k) do { if (IN(k) && IN((k) + 1)) xcd_barrier(bar); } while (0)

    if (IN(PH_PREP)) { p0_prologue(args, lds, vcu, G, tid, lane, wave); __syncthreads(); SEAM(PH_PREP); }

    if (IN(PH_INPROJ)) {
        pg8::DenseSched S; S.init(TA, NPROJ, 1024, ws + WS_WIN, G, bx);
        pg8::EpiProj E{(bf16*)(ws + WS_PROJ), NPROJ};
        pg8::gemm_phase<pg8::EpiProj, pg8::DenseSched, true, true>(lds + RING_OFF, (const char*)(ws + WS_XN), 1024, S, E);
        SEAM(PH_INPROJ);
    }
    if (IN(PH_MIXA)) {
        const int gw = vcu * NWAVES + wave, NGW = G * NWAVES;
        for (int m = gw; m < TR; m += NGW) d_conv_branch((const bf16*)(ws + WS_PROJ), args.in[I_CSW], (bf16*)(ws + WS_Y), m, lane);
        for (int m = gw; m < TA; m += NGW) d_xbc_act((const bf16*)(ws + WS_PROJ), args.in[I_SCW], args.in[I_SCB], (bf16*)(ws + WS_XBCA), m, lane);
        SEAM(PH_MIXA);
    }
    if (IN(PH_MIXB)) {
#ifdef SSD_NAIVE
        for (int item = bx; item < BATCH * NH; item += G) if (wave == 0) d_ssd_naive((const bf16*)(ws + WS_XBCA), (const bf16*)(ws + WS_PROJ), (const float*)(ws + WS_DT), args.in[I_DTB], args.in[I_ALOG], args.in[I_SD], (bf16*)(ws + WS_XN), item, lane);
#else
        for (int item = vcu; item < BATCH * NH; item += G) ssd::chain(args, lds, item, tid, lane, wave);
#endif
        SEAM(PH_MIXB);
    }
    if (IN(PH_MIXC)) {
        const int gw = vcu * NWAVES + wave, NGW = G * NWAVES;
        for (int m = gw; m < TR; m += NGW) d_ssd_norm((const bf16*)(ws + WS_XN), (bf16*)(ws + WS_Y), m, lane);
        SEAM(PH_MIXC);
    }
    if (IN(PH_OUTPROJ)) {
        pg8::DenseSched S; S.init(TR, 1024, 2048, ws + WS_WOUT, G, bx);
        pg8::EpiH1 E{args.in[I_X], (float*)(ws + WS_H1), 1024};
        pg8::gemm_phase<pg8::EpiH1, pg8::DenseSched, true, true>(lds + RING_OFF, (const char*)(ws + WS_Y), 2048, S, E);
        SEAM(PH_OUTPROJ);
    }
    if (IN(PH_ROUTER)) { p4_router(args, lds, vcu, G, tid, lane, wave); SEAM(PH_ROUTER); }
    if (IN(PH_GU)) {
        moe_tables(args, lds, tid);
        pg8::MoeSched<true> S; S.tst = (const LAS int*)(lds + MOE_OFF); S.cnt = S.tst + 40; S.G = G; S.c = bx; S.NP = 8; S.K = 1024; S.list = (const int*)(ws + WS_LIST);
        S.Bt = (const char*)(ws + WS_WGU); S.estride = (size_t)2048 * 1024 * 2;
        pg8::EpiSwiGLU E{(bf16*)(ws + WS_ACT), args.in[I_BGU]};
        pg8::gemm_phase<pg8::EpiSwiGLU, pg8::MoeSched<true>, true, true>(lds + RING_OFF, (const char*)(ws + WS_XN), 1024, S, E);
        SEAM(PH_GU);
    }
    if (IN(PH_DOWN)) {
        moe_tables(args, lds, tid);
        pg8::MoeSched<false> S; S.tst = (const LAS int*)(lds + MOE_OFF); S.cnt = S.tst + 40; S.G = G; S.c = bx; S.NP = 4; S.K = 1024; S.list = (const int*)(ws + WS_LIST);
        S.Bt = (const char*)(ws + WS_WDN); S.estride = (size_t)1024 * 1024 * 2;
        pg8::EpiDown E{(bf16*)(ws + WS_YE), args.in[I_BDN], (const int*)(ws + WS_LIST), (const float*)(ws + WS_GATE)};
        pg8::gemm_phase<pg8::EpiDown, pg8::MoeSched<false>, true, true>(lds + RING_OFF, (const char*)(ws + WS_ACT), 1024, S, E);
        SEAM(PH_DOWN);
    }
    if (IN(PH_FINAL)) { p7_final(args, vcu, G, lane, wave); }
#undef IN
#undef SEAM
}

extern "C" void kernel_launch(void* const* d_in, const int* in_sizes, int n_in, void* d_out, int out_size, void* d_ws, size_t ws_size, hipStream_t stream) {
    static int grid = 0;
    if (grid == 0) {
        if (n_in != 21 || in_sizes[0] != TR * D || out_size != TR * D || ws_size < WS_END) { fprintf(stderr, "kernel_launch: unexpected problem shape (n_in %d, in0 %d, out %d, ws %zu)\n", n_in, n_in > 0 ? in_sizes[0] : -1, out_size, ws_size); grid = -1; return; }
        int dev = 0, cus = 0, per_cu = 0;
        if (hipGetDevice(&dev) != hipSuccess || hipDeviceGetAttribute(&cus, hipDeviceAttributeMultiprocessorCount, dev) != hipSuccess) { grid = -1; return; }
        if (hipFuncSetAttribute((const void*)mk_fwd, hipFuncAttributeMaxDynamicSharedMemorySize, LDS_BYTES) != hipSuccess) { fprintf(stderr, "kernel_launch: hipFuncSetAttribute failed\n"); grid = -1; return; }
        if (hipOccupancyMaxActiveBlocksPerMultiprocessor(&per_cu, (const void*)mk_fwd, NWAVES * 64, LDS_BYTES) != hipSuccess || per_cu < 1) { fprintf(stderr, "kernel_launch: occupancy query says %d\n", per_cu); per_cu = 1; }
        (void)hipGetLastError();
        grid = cus;
    }
    if (grid < 0) return;
    (void)hipMemsetAsync((char*)d_ws + WS_CTL, 0, CTL_ZERO_BYTES, stream);
    Args a{};
    for (int i = 0; i < 21; ++i) a.in[i] = (const float*)d_in[i];
    a.out = (float*)d_out; a.ws = (unsigned char*)d_ws;
    unsigned char* ws = (unsigned char*)d_ws;
    auto launch = [&](int lo, int hi) { a.ph_lo = lo; a.ph_hi = hi; hipLaunchKernelGGL(mk_fwd, dim3(grid), dim3(NWAVES * 64), LDS_BYTES, stream, a); };
    launch(0, PH_N);
}
```

```cpp
#include <hip/hip_runtime.h>
#include <cstdio>
#include <cstdint>

#define LAS __attribute__((address_space(3)))
#define GAS __attribute__((address_space(1)))
typedef unsigned short bf16;
typedef short bf16x8 __attribute__((ext_vector_type(8)));
typedef float f32x4 __attribute__((ext_vector_type(4)));
typedef float f32x2 __attribute__((ext_vector_type(2)));
typedef unsigned u32x4 __attribute__((ext_vector_type(4)));
typedef unsigned u32x2 __attribute__((ext_vector_type(2)));
typedef GAS unsigned gu32;

constexpr int BATCH = 16, SEQ = 2048, D = 1024, NMETA = 16, LSEQ = SEQ + NMETA;
constexpr int TR = BATCH * SEQ;
constexpr int TA = 33024;
constexpr int MROW = TR;
constexpr int WIN_LD = 6160, NPROJ = 6144;
constexpr int C_CB = 0, C_CC = 1024, C_CX = 2048, C_Z = 3072, C_XS = 4096, C_BS = 5120, C_CS = 5632;
constexpr int NH = 16, HD = 64, NE = 32, DMIX = 2048;
constexpr float EPS = 1e-5f;
constexpr float SW_ALPHA = 1.702f, SW_LIMIT = 7.0f;

constexpr size_t MiB = 1u << 20;
constexpr size_t WS_CTL = 0, CTL_ZERO_BYTES = 1 * MiB;
constexpr size_t WS_LIST = 1 * MiB;
constexpr size_t WS_GATE = 5 * MiB;
constexpr size_t WS_DT = 6 * MiB;
constexpr size_t WS_WIN = 12 * MiB;
constexpr size_t WS_WOUT = 24 * MiB;
constexpr size_t WS_WGU = 28 * MiB;
constexpr size_t WS_WDN = 156 * MiB;
constexpr size_t WS_XN = 220 * MiB;
constexpr size_t WS_PROJ = 285 * MiB;
constexpr size_t WS_ACT = 285 * MiB;
constexpr size_t WS_YE = 557 * MiB;
constexpr size_t WS_Y = 672 * MiB;
constexpr size_t WS_H1 = 816 * MiB;
constexpr size_t WS_XBCA = 880 * MiB;
constexpr size_t WS_END = 1024 * MiB;
constexpr int CW_CNT = 64;
constexpr int CW_BAR = 4096;

__device__ __forceinline__ unsigned f2bf(float f) { unsigned u = __float_as_uint(f); return (u + 0x7fffu + ((u >> 16) & 1u)) >> 16; }
__device__ __forceinline__ unsigned pk2(float lo, float hi) { return f2bf(lo) | (f2bf(hi) << 16); }
__device__ __forceinline__ float bf2f(unsigned short b) { return __uint_as_float(((unsigned)b) << 16); }
__device__ __forceinline__ float bflo(unsigned w) { return __uint_as_float(w << 16); }
__device__ __forceinline__ float bfhi(unsigned w) { return __uint_as_float(w & 0xffff0000u); }
__device__ __forceinline__ unsigned cvt_pk_bf16(float lo, float hi) { unsigned r; asm volatile("v_cvt_pk_bf16_f32 %0, %1, %2" : "=v"(r) : "v"(lo), "v"(hi)); return r; }
__device__ __forceinline__ float wave_sum(float v) {
#pragma unroll
    for (int o = 1; o < 64; o <<= 1) v += __shfl_xor(v, o);
    return v;
}
__device__ __forceinline__ int row_of(int b, int l) { return l >= NMETA ? b * SEQ + (l - NMETA) : MROW + l; }
__device__ __forceinline__ float silu_f(float z) { return z / (1.0f + __expf(-z)); }
#define LDS_WAIT() asm volatile("s_waitcnt lgkmcnt(0)" ::: "memory")
#define VM_WAIT() asm volatile("s_waitcnt vmcnt(0)" ::: "memory")

namespace pg8 {
constexpr int BM = 256, BK = 64, HALF = 128, HTB = HALF * BK * 2, STAGE_BYTES = 8 * HTB, NXCD = 8, WGM = 8;
constexpr int NOFF_REL = STAGE_BYTES + 8192;
__host__ __device__ __forceinline__ int lds_byte(int r, int c) { const int st = (r >> 4) * 2 + (c >> 5), rr = r & 15, cc = c & 31, ob = rr * 64 + cc * 2; return st * 1024 + (ob ^ (((ob >> 9) & 1) << 5)); }
__host__ __device__ __forceinline__ void stage_rc(int b, int& R, int& C) { const int st = b / 1024, sb = b % 1024, swz = sb ^ (((sb >> 9) & 1) << 5); R = (st >> 1) * 16 + swz / 64; C = (st & 1) * 32 + (swz % 64) / 2; }
__host__ __device__ __forceinline__ int perm32(int rho) { const int n = rho >> 4, i = rho & 15; return 8 * (i >> 2) + 4 * n + (i & 3); }

template <class Epi, class Sched, bool ALIGN_EPI, bool SP2>
__device__ __forceinline__ void gemm_phase(LAS unsigned char* lds, const char* Abase, const int K, const Sched& S, const Epi& E) {
    const int tid = threadIdx.x, wid = __builtin_amdgcn_readfirstlane(tid >> 6), lane = tid & 63, wr = wid >> 2, wc = wid & 3, fr = lane & 15, fq = lane >> 4;
    const int nt = K / BK;
    int Rr[2]; unsigned cbA[2], voffB[2];
#pragma unroll
    for (int i = 0; i < 2; ++i) { int R, C; stage_rc(tid * 16 + i * 8192, R, C); const int Rb = Epi::PERM ? ((R & ~31) + perm32(R & 31)) : R;
        Rr[i] = R; cbA[i] = (unsigned)C * 2u; voffB[i] = (unsigned)(Rb * K + C) * 2u; }
    const size_t kstep = (size_t)(BK * 2);
    const size_t hstep = (size_t)HALF * K * 2;
    const unsigned ldsw = (unsigned)wid * 1024u;
    const int aoff = lds_byte(wr * 64 + fr, fq * 8), boff = lds_byte(wc * 32 + fr, fq * 8);
#define PG8_SA(b, h) (((b) * 2 + (h)) * HTB)
#define PG8_SB(b, h) ((4 + (b) * 2 + (h)) * HTB)
#define PG8_STAGEB(bufoff, gbase) do { _Pragma("unroll") for (int _i = 0; _i < 2; ++_i) \
        __builtin_amdgcn_global_load_lds((const unsigned*)((const char*)(gbase) + voffB[_i]), (LAS unsigned*)(lds + (bufoff) + ldsw + _i * 8192), 16, 0, 0); } while (0)
#define PG8_STAGEA(bufoff, offs, kt) do { const char* _gb = Abase + (size_t)(kt) * kstep; _Pragma("unroll") for (int _i = 0; _i < 2; ++_i) \
        __builtin_amdgcn_global_load_lds((const unsigned*)(_gb + (offs)[_i]), (LAS unsigned*)(lds + (bufoff) + ldsw + _i * 8192), 16, 0, 0); } while (0)
#define PG8_LDA(dst, b, h) do { _Pragma("unroll") for (int m = 0; m < 4; ++m) _Pragma("unroll") for (int k = 0; k < 2; ++k) dst[m][k] = *(const LAS bf16x8*)(lds + PG8_SA(b, h) + aoff + m * 2048 + k * 1024); } while (0)
#define PG8_LDB(dst, b, h) do { _Pragma("unroll") for (int n = 0; n < 2; ++n) _Pragma("unroll") for (int k = 0; k < 2; ++k) dst[n][k] = *(const LAS bf16x8*)(lds + PG8_SB(b, h) + boff + n * 2048 + k * 1024); } while (0)
#define PG8_MMA(ai, bj, At, Bt) do { __builtin_amdgcn_s_setprio(1); _Pragma("unroll") for (int m = 0; m < 4; ++m) _Pragma("unroll") for (int n = 0; n < 2; ++n) _Pragma("unroll") for (int k = 0; k < 2; ++k) \
        acc[ai][bj][m][n] = __builtin_amdgcn_mfma_f32_16x16x32_bf16(Bt[n][k], At[m][k], acc[ai][bj][m][n], 0, 0, 0); __builtin_amdgcn_s_setprio(0); } while (0)
#define PG8_WAIT_V(n) asm volatile("s_waitcnt vmcnt(" #n ")" ::: "memory")
#define PG8_WAIT_L(n) asm volatile("s_waitcnt lgkmcnt(" #n ")" ::: "memory")
#define PG8_BAR __builtin_amdgcn_s_barrier()
#define PG8_SCHED __builtin_amdgcn_sched_barrier(0)
    typename Sched::Unit cur, nxt; int ui = 0;
    if (!S.next(0, cur)) return;
    f32x4 acc[2][2][4][2];
#pragma unroll
    for (int a = 0; a < 2; ++a)
#pragma unroll
        for (int b = 0; b < 2; ++b)
#pragma unroll
            for (int m = 0; m < 4; ++m)
#pragma unroll
                for (int n = 0; n < 2; ++n) acc[a][b][m][n] = (f32x4){0.f, 0.f, 0.f, 0.f};
    bf16x8 At[4][2], B0[2][2], B1[2][2];
    unsigned coff[2][2];
    LAS u32x4* stash = (LAS u32x4*)(lds + NOFF_REL) + tid;
#pragma unroll
    for (int h = 0; h < 2; ++h)
#pragma unroll
        for (int i = 0; i < 2; ++i) coff[h][i] = S.aoff(cur, h * HALF + Rr[i]) + cbA[i];
    const char* cB = S.bptr(cur);
    if constexpr (SP2) {
        PG8_STAGEB(PG8_SB(0, 0), cB); PG8_STAGEB(PG8_SB(0, 1), cB + hstep); PG8_STAGEA(PG8_SA(0, 0), coff[0], 0); PG8_STAGEA(PG8_SA(0, 1), coff[1], 0);
        if (wr == 1) PG8_BAR;
        PG8_WAIT_V(2); PG8_BAR;
        PG8_STAGEB(PG8_SB(1, 0), cB + kstep); PG8_STAGEA(PG8_SA(1, 0), coff[0], 1); PG8_STAGEB(PG8_SB(1, 1), cB + hstep + kstep);
        PG8_WAIT_V(6); PG8_BAR;
    } else {
        PG8_STAGEB(PG8_SB(0, 0), cB); PG8_STAGEA(PG8_SA(0, 0), coff[0], 0); PG8_STAGEB(PG8_SB(0, 1), cB + hstep); PG8_STAGEA(PG8_SA(0, 1), coff[1], 0);
        if (wr == 1) PG8_BAR;
        PG8_WAIT_V(4); PG8_BAR;
        PG8_STAGEB(PG8_SB(1, 0), cB + kstep); PG8_STAGEA(PG8_SA(1, 0), coff[0], 1); PG8_STAGEB(PG8_SB(1, 1), cB + hstep + kstep);
        PG8_WAIT_V(6); PG8_BAR;
    }
    for (;;) {
        const bool has_next = S.next(ui + 1, nxt);
        const char* nB = has_next ? S.bptr(nxt) : cB;
        if (has_next) { u32x4 w; w.x = S.aoff(nxt, Rr[0]) + cbA[0]; w.y = S.aoff(nxt, Rr[1]) + cbA[1]; w.z = S.aoff(nxt, HALF + Rr[0]) + cbA[0]; w.w = S.aoff(nxt, HALF + Rr[1]) + cbA[1]; *stash = w; }
        for (int t = 0; t < nt; t += 2) {
            const bool last = (t == nt - 2);
            const char* b2 = last ? nB : cB + (size_t)(t + 2) * kstep;
            const char* b3 = b2 + kstep;
            const int ka = last ? 0 : t + 2;
            if constexpr (SP2) {
            PG8_LDB(B0, 0, 0); PG8_LDB(B1, 0, 1); PG8_SCHED; PG8_LDA(At, 0, 0); PG8_STAGEA(PG8_SA(1, 1), coff[1], t + 1);
            PG8_WAIT_V(8); PG8_WAIT_L(0); PG8_BAR; PG8_MMA(0, 0, At, B0); PG8_MMA(0, 1, At, B1); PG8_BAR; PG8_SCHED;
            if (last && has_next) { const u32x4 w = *stash; coff[0][0] = w.x; coff[0][1] = w.y; coff[1][0] = w.z; coff[1][1] = w.w; }
            PG8_LDA(At, 0, 1); PG8_STAGEB(PG8_SB(0, 0), b2); PG8_STAGEB(PG8_SB(0, 1), b2 + hstep); PG8_STAGEA(PG8_SA(0, 0), coff[0], ka);
            PG8_WAIT_V(8); PG8_WAIT_L(0); PG8_BAR; PG8_MMA(1, 0, At, B0); PG8_MMA(1, 1, At, B1); PG8_BAR; PG8_SCHED;
            PG8_LDB(B0, 1, 0); PG8_LDB(B1, 1, 1); PG8_SCHED; PG8_LDA(At, 1, 0); PG8_STAGEA(PG8_SA(0, 1), coff[1], ka);
            PG8_WAIT_V(8); PG8_WAIT_L(0); PG8_BAR; PG8_MMA(0, 0, At, B0); PG8_MMA(0, 1, At, B1); PG8_BAR; PG8_SCHED;
            PG8_LDA(At, 1, 1); PG8_STAGEB(PG8_SB(1, 0), b3); PG8_STAGEB(PG8_SB(1, 1), b3 + hstep); PG8_STAGEA(PG8_SA(1, 0), coff[0], ka + 1);
            PG8_WAIT_V(8); PG8_WAIT_L(0); PG8_BAR; PG8_MMA(1, 0, At, B0); PG8_MMA(1, 1, At, B1); PG8_BAR; PG8_SCHED;
            } else {
            PG8_LDB(B0, 0, 0); PG8_SCHED; PG8_LDA(At, 0, 0); PG8_STAGEA(PG8_SA(1, 1), coff[1], t + 1);
            PG8_WAIT_L(8); PG8_BAR; PG8_WAIT_L(0); PG8_MMA(0, 0, At, B0); PG8_BAR; PG8_SCHED;
            if (last && has_next) { const u32x4 w = *stash; coff[0][0] = w.x; coff[0][1] = w.y; coff[1][0] = w.z; coff[1][1] = w.w; }
            PG8_LDB(B1, 0, 1); PG8_STAGEB(PG8_SB(0, 0), b2);
            PG8_BAR; PG8_WAIT_L(0); PG8_MMA(0, 1, At, B1); PG8_BAR;
            PG8_LDA(At, 0, 1); PG8_STAGEA(PG8_SA(0, 0), coff[0], ka);
            PG8_BAR; PG8_WAIT_L(0); PG8_MMA(1, 0, At, B0); PG8_BAR; PG8_SCHED;
            PG8_STAGEB(PG8_SB(0, 1), b2 + hstep);
            PG8_WAIT_V(6); PG8_BAR; PG8_MMA(1, 1, At, B1); PG8_BAR;
            PG8_LDB(B0, 1, 0); PG8_SCHED; PG8_LDA(At, 1, 0); PG8_STAGEA(PG8_SA(0, 1), coff[1], ka);
            PG8_WAIT_L(8); PG8_BAR; PG8_WAIT_L(0); PG8_MMA(0, 0, At, B0); PG8_BAR; PG8_SCHED;
            PG8_LDB(B1, 1, 1); PG8_STAGEB(PG8_SB(1, 0), b3);
            PG8_BAR; PG8_WAIT_L(0); PG8_MMA(0, 1, At, B1); PG8_BAR;
            PG8_LDA(At, 1, 1); PG8_STAGEA(PG8_SA(1, 0), coff[0], ka + 1);
            PG8_BAR; PG8_WAIT_L(0); PG8_MMA(1, 0, At, B0); PG8_BAR; PG8_SCHED;
            PG8_STAGEB(PG8_SB(1, 1), b3 + hstep);
            PG8_WAIT_V(6); PG8_BAR; PG8_MMA(1, 1, At, B1); PG8_BAR;
            }
        }
        if constexpr (ALIGN_EPI) { if (wr == 0) PG8_BAR; }
        asm volatile("" ::: "memory");
        E(acc, cur, wr, wc, fr, fq);
        if (!has_next) break;
#pragma unroll
        for (int a = 0; a < 2; ++a)
#pragma unroll
            for (int b = 0; b < 2; ++b)
#pragma unroll
                for (int m = 0; m < 4; ++m)
#pragma unroll
                    for (int n = 0; n < 2; ++n) acc[a][b][m][n] = (f32x4){0.f, 0.f, 0.f, 0.f};
        cur = nxt; cB = nB; ++ui;
        if constexpr (ALIGN_EPI) { if (wr == 1) PG8_BAR; }
    }
    PG8_WAIT_V(0);
    if constexpr (!ALIGN_EPI) { if (wr == 0) PG8_BAR; }
    PG8_BAR;
#undef PG8_SA
#undef PG8_SB
#undef PG8_STAGEA
#undef PG8_STAGEB
#undef PG8_LDA
#undef PG8_LDB
#undef PG8_MMA
#undef PG8_WAIT_V
#undef PG8_WAIT_L
#undef PG8_BAR
#undef PG8_SCHED
}

struct DenseUnit { int pm, pn; };
struct DenseSched {
    typedef DenseUnit Unit;
    int nM, nN, nwg, G, c, K; const char* Bt;
    __device__ void init(int M, int N, int K_, const void* Bt_, int G_, int c_) { nM = M / BM; nN = N / BM; nwg = nM * nN; G = G_; c = c_; K = K_; Bt = (const char*)Bt_; }
    __device__ __forceinline__ bool next(int i, Unit& u) const {
        const long L = (long)i * G + c; if (L >= nwg) return false;
        int wgid = (int)L; { const int q = nwg / NXCD, r = nwg % NXCD, xcd = wgid % NXCD, off = wgid / NXCD; wgid = (xcd < r ? xcd * (q + 1) : r * (q + 1) + (xcd - r) * q) + off; }
        const int nig = WGM * nN, gid = wgid / nig, fm = gid * WGM, gsz = (nM - fm) < WGM ? (nM - fm) : WGM;
        u.pm = fm + ((wgid % nig) % gsz); u.pn = (wgid % nig) / gsz; return true;
    }
    __device__ __forceinline__ unsigned aoff(const Unit& u, int r) const { return (unsigned)(u.pm * BM + r) * (unsigned)(K * 2); }
    __device__ __forceinline__ const char* bptr(const Unit& u) const { return Bt + (size_t)u.pn * BM * K * 2; }
};

struct MoeUnit { int e, rt, l0, nv, pn; };
template <bool GATHER>
struct MoeSched {
    typedef MoeUnit Unit;
    const LAS int* tst;
    const LAS int* cnt;
    int G, c, NP, K; const int* list; const char* Bt; size_t estride;
    __device__ __forceinline__ bool next(int i, Unit& u) const {
        const int L = i * G + c; const int R = __builtin_amdgcn_readfirstlane(tst[NE]); if (L >= R * NP) return false;
        const int rt = L / NP; u.pn = L % NP;
        int e = 0;
#pragma unroll 1
        for (int j = 1; j < NE; ++j) e = (rt >= __builtin_amdgcn_readfirstlane(tst[j])) ? j : e;
        u.e = e; u.rt = rt; u.l0 = (rt - __builtin_amdgcn_readfirstlane(tst[e])) * BM; const int rem = __builtin_amdgcn_readfirstlane(cnt[e]) - u.l0; u.nv = rem < BM ? rem : BM; return true;
    }
    __device__ __forceinline__ unsigned aoff(const Unit& u, int r) const {
        if (GATHER) { const int j = (r < u.nv) ? (u.l0 + r) : u.l0; const int a = list[(size_t)u.e * TR + j]; return (unsigned)(a >> 2) * (unsigned)(K * 2); }
        else return (unsigned)(u.rt * BM + r) * (unsigned)(K * 2);
    }
    __device__ __forceinline__ const char* bptr(const Unit& u) const { return Bt + (size_t)u.e * estride + (size_t)u.pn * BM * K * 2; }
};

struct EpiProj {
    static constexpr bool PERM = true;
    bf16* O; int ldc;
    __device__ __forceinline__ void operator()(const f32x4 (&acc)[2][2][4][2], const DenseUnit& u, int wr, int wc, int fr, int fq) const {
        const int row0 = u.pm * BM + wr * 64 + fr; const int col0 = u.pn * BM + wc * 32 + 8 * fq;
#pragma unroll
        for (int ai = 0; ai < 2; ++ai)
#pragma unroll
            for (int m = 0; m < 4; ++m) { bf16* rowp = O + (size_t)(row0 + ai * HALF + m * 16) * ldc + col0;
#pragma unroll
                for (int bj = 0; bj < 2; ++bj) { const f32x4 v0 = acc[ai][bj][m][0], v1 = acc[ai][bj][m][1];
                    u32x4 w; w.x = cvt_pk_bf16(v0[0], v0[1]); w.y = cvt_pk_bf16(v0[2], v0[3]); w.z = cvt_pk_bf16(v1[0], v1[1]); w.w = cvt_pk_bf16(v1[2], v1[3]);
                    *(u32x4*)(rowp + bj * HALF) = w; } }
    }
};
struct EpiH1 {
    static constexpr bool PERM = false;
    const float* X; float* H; int ldc;
    __device__ __forceinline__ void operator()(const f32x4 (&acc)[2][2][4][2], const DenseUnit& u, int wr, int wc, int fr, int fq) const {
        const int row0 = u.pm * BM + wr * 64 + fr, col0 = u.pn * BM + wc * 32 + 4 * fq;
#pragma unroll
        for (int ai = 0; ai < 2; ++ai)
#pragma unroll
            for (int m = 0; m < 4; ++m) { const size_t off = (size_t)(row0 + ai * HALF + m * 16) * ldc + col0;
#pragma unroll
                for (int bj = 0; bj < 2; ++bj)
#pragma unroll
                    for (int n = 0; n < 2; ++n) { const f32x4 xv = *(const f32x4*)(X + off + bj * HALF + n * 16); *(f32x4*)(H + off + bj * HALF + n * 16) = xv + acc[ai][bj][m][n]; }
                asm volatile("" ::: "memory"); }
    }
};
__device__ __forceinline__ float swiglu1(float g, float l) {
    g = fminf(g, SW_LIMIT); l = fminf(fmaxf(l, -SW_LIMIT), SW_LIMIT);
    return g * (l + 1.0f) / (1.0f + __expf(-SW_ALPHA * g));
}
struct EpiSwiGLU {
    static constexpr bool PERM = true;
    bf16* ACT; const float* bgu;
    __device__ __forceinline__ void operator()(const f32x4 (&acc)[2][2][4][2], const MoeUnit& u, int wr, int wc, int fr, int fq) const {
        const int row0 = u.rt * BM + wr * 64 + fr; const int j0 = u.pn * HALF + wc * 32 + 8 * fq;
        const float* bg = bgu + (size_t)u.e * 2048 + j0;
        const f32x4 g0 = *(const f32x4*)(bg), g1 = *(const f32x4*)(bg + 4), l0 = *(const f32x4*)(bg + 1024), l1 = *(const f32x4*)(bg + 1028);
#pragma unroll
        for (int ai = 0; ai < 2; ++ai)
#pragma unroll
            for (int m = 0; m < 4; ++m) { bf16* rowp = ACT + (size_t)(row0 + ai * HALF + m * 16) * 1024 + j0;
                const f32x4 a0 = acc[ai][0][m][0] + g0, a1 = acc[ai][0][m][1] + g1, b0 = acc[ai][1][m][0] + l0, b1 = acc[ai][1][m][1] + l1;
                u32x4 w; w.x = cvt_pk_bf16(swiglu1(a0[0], b0[0]), swiglu1(a0[1], b0[1])); w.y = cvt_pk_bf16(swiglu1(a0[2], b0[2]), swiglu1(a0[3], b0[3]));
                w.z = cvt_pk_bf16(swiglu1(a1[0], b1[0]), swiglu1(a1[1], b1[1])); w.w = cvt_pk_bf16(swiglu1(a1[2], b1[2]), swiglu1(a1[3], b1[3]));
                *(u32x4*)rowp = w; }
    }
};
struct EpiDown {
    static constexpr bool PERM = true;
    bf16* YE; const float* bdn; const int* list; const float* gate;
    __device__ __forceinline__ void operator()(const f32x4 (&acc)[2][2][4][2], const MoeUnit& u, int wr, int wc, int fr, int fq) const {
        const int col0 = u.pn * BM + wc * 32 + 8 * fq;
        const float* bb = bdn + (size_t)u.e * 1024 + col0;
        f32x4 bv[2][2];
#pragma unroll
        for (int bj = 0; bj < 2; ++bj)
#pragma unroll
            for (int n = 0; n < 2; ++n) bv[bj][n] = *(const f32x4*)(bb + bj * HALF + 4 * n);
#pragma unroll
        for (int ai = 0; ai < 2; ++ai)
#pragma unroll
            for (int m = 0; m < 4; ++m) { const int r = ai * HALF + wr * 64 + m * 16 + fr;
                if (r < u.nv) { const int a = list[(size_t)u.e * TR + u.l0 + r]; const float g = gate[a]; bf16* rowp = YE + (size_t)a * 1024 + col0;
#pragma unroll
                    for (int bj = 0; bj < 2; ++bj) { const f32x4 v0 = (acc[ai][bj][m][0] + bv[bj][0]) * g, v1 = (acc[ai][bj][m][1] + bv[bj][1]) * g;
                        u32x4 w; w.x = cvt_pk_bf16(v0[0], v0[1]); w.y = cvt_pk_bf16(v0[2], v0[3]); w.z = cvt_pk_bf16(v1[0], v1[1]); w.w = cvt_pk_bf16(v1[2], v1[3]);
                        *(u32x4*)(rowp + bj * HALF) = w; } } }
    }
};
}

constexpr int NWAVES = 8;
constexpr int RING_OFF = 0, RING_BYTES = 131072;
constexpr int LDSCTL_OFF = RING_BYTES;
constexpr int MISC_OFF = LDSCTL_OFF + 320;
constexpr int MOE_OFF = LDSCTL_OFF + 512;
constexpr int RT_OFF = LDSCTL_OFF + 1024;
constexpr int LDS_BYTES = 147456;

#define XB_TMO      128
#define XB_XCNT(j)  (256  + 64 * (j))
#define XB_XSUB(j)  (1280 + 64 * (j))
#define XB_XGEN(j)  (2304 + 64 * (j))
#define XB_TOP      3328
#define XB_TOPGEN   3392
#define XCD_BAR_WORDS 3456
#define XB_SPIN_CAP (1u << 18)
__device__ __forceinline__ unsigned xb_ld(unsigned* p)              { return __hip_atomic_load(p, __ATOMIC_RELAXED, __HIP_MEMORY_SCOPE_AGENT); }
__device__ __forceinline__ unsigned xb_add(unsigned* p, unsigned v) { return __hip_atomic_fetch_add(p, v, __ATOMIC_RELAXED, __HIP_MEMORY_SCOPE_AGENT); }
__device__ __forceinline__ unsigned xb_xcc_id() { return (unsigned)__builtin_amdgcn_s_getreg((3 << 11) | 20) & 0xFu; }
#define XB_SPIN(cond, bar) do { unsigned _sp = 0; while (cond) { __builtin_amdgcn_s_sleep(1); \
    if ((++_sp & 255u) == 0u) { if (xb_ld(&(bar)[XB_TMO])) break; if (_sp > XB_SPIN_CAP) { atomicAdd(&(bar)[XB_TMO], 1u); break; } } } } while (0)
struct XcdBarrier { unsigned* bar; unsigned x; volatile LAS unsigned* st; };
__device__ __forceinline__ XcdBarrier xcd_barrier_post(unsigned* bar, volatile LAS unsigned* st) {
    XcdBarrier b; b.bar = bar; b.x = xb_xcc_id(); b.st = st;
    if (threadIdx.x == 0) (void)xb_add(&bar[XB_XCNT(b.x)], 1u);
    return b;
}
__device__ __forceinline__ void xcd_barrier_complete(unsigned* bar, unsigned x, unsigned& nloc, unsigned& nx) {
    const unsigned G = gridDim.x * gridDim.y * gridDim.z;
    unsigned sum, cnt, mine, sp = 0u;
    for (;;) {
        sum = 0u; cnt = 0u; mine = 0u;
#pragma unroll
        for (unsigned j = 0; j < 16; ++j) { const unsigned c = xb_ld(&bar[XB_XCNT(j)]); sum += c; cnt += (c > 0u) ? 1u : 0u; mine = (j == x) ? c : mine; }
        if (sum == G) break;
        __builtin_amdgcn_s_sleep(1);
        if ((++sp & 255u) == 0u) { if (xb_ld(&bar[XB_TMO])) break; if (sp > XB_SPIN_CAP) { atomicAdd(&bar[XB_TMO], 1u); break; } }
    }
    nloc = mine > 0u ? mine : 1u; nx = cnt > 0u ? cnt : 1u;
}
__device__ __forceinline__ void xcd_barrier(const XcdBarrier& b) {
    asm volatile("s_waitcnt vmcnt(0)" ::: "memory");
    __syncthreads();
    if (threadIdx.x == 0) {
        unsigned* bar = b.bar;
        __builtin_amdgcn_s_waitcnt(0);
        unsigned nloc = b.st[0], nx = b.st[1];
        if (nloc == 0u) { xcd_barrier_complete(bar, b.x, nloc, nx); b.st[0] = nloc; b.st[1] = nx; }
        const unsigned old = xb_add(&bar[XB_XSUB(b.x)], 1u);
        const unsigned gen = old / nloc;
        if (old + 1u == (gen + 1u) * nloc) {
            __builtin_amdgcn_fence(__ATOMIC_RELEASE, "agent");
            asm volatile("s_waitcnt vmcnt(0)" ::: "memory");
            const unsigned og = xb_add(&bar[XB_TOP], 1u);
            const unsigned tg = og / nx;
            if (og + 1u == (tg + 1u) * nx) xb_add(&bar[XB_TOPGEN], 1u);
            else XB_SPIN(xb_ld(&bar[XB_TOPGEN]) == tg, bar);
            __builtin_amdgcn_fence(__ATOMIC_ACQUIRE, "agent");
            xb_add(&bar[XB_XGEN(b.x)], 1u);
            asm volatile("s_waitcnt vmcnt(0)" ::: "memory");
        } else {
            XB_SPIN(xb_ld(&bar[XB_XGEN(b.x)]) == gen, bar);
            __builtin_amdgcn_fence(__ATOMIC_ACQUIRE, "agent");
            asm volatile("s_waitcnt vmcnt(0)" ::: "memory");
        }
    }
    __syncthreads();
}

struct Args { const float* in[21]; float* out; unsigned char* ws; int ph_lo, ph_hi; };
enum { I_X = 0, I_META, I_NMIX, I_WIN, I_CSW, I_CNW, I_SCW, I_SCB, I_DTB, I_ALOG, I_SD, I_SNW, I_WOUT, I_NFFN, I_RW, I_RB, I_WGU, I_BGU, I_WDN, I_BDN, I_NFIN };

__device__ __forceinline__ void p0_transpose_item(const float* W, int ldw, int K, const float* kscale, bf16* WT, int row_off, int k0, int n0, LAS float* scr, int lane) {
    float v[32];
#pragma unroll
    for (int i = 0; i < 32; ++i) v[i] = W[(size_t)(k0 + 2 * i + (lane >> 5)) * ldw + n0 + (lane & 31)];
    if (kscale) {
#pragma unroll
        for (int i = 0; i < 32; ++i) v[i] *= kscale[k0 + 2 * i + (lane >> 5)];
    }
#pragma unroll
    for (int i = 0; i < 32; ++i) scr[(2 * i + (lane >> 5)) * 33 + (lane & 31)] = v[i];
    LDS_WAIT(); asm volatile("" ::: "memory");
    const int c = lane & 7;
#pragma unroll
    for (int j = 0; j < 4; ++j) { const int n = (lane >> 3) + 8 * j; const LAS float* s = scr + (8 * c) * 33 + n;
        u32x4 o; o.x = pk2(s[0 * 33], s[1 * 33]); o.y = pk2(s[2 * 33], s[3 * 33]); o.z = pk2(s[4 * 33], s[5 * 33]); o.w = pk2(s[6 * 33], s[7 * 33]);
        *(u32x4*)(WT + (size_t)(row_off + n) * K + k0 + 8 * c) = o; }
    LDS_WAIT(); asm volatile("" ::: "memory");
}

__device__ __forceinline__ void p0_prologue(const Args& A, LAS unsigned char* lds, int vcu, int G, int tid, int lane, int wave) {
    unsigned char* ws = A.ws;
    LAS float* scr = (LAS float*)(lds + RING_OFF + wave * 16384);
    const int gw = vcu * NWAVES + wave, NGW = G * NWAVES;
    constexpr int I_IN = 16 * 192, I_OUT = 32 * 32, I_GU = 32 * 16 * 64, I_DN = 32 * 16 * 32;
    constexpr int NITEMS = I_IN + I_OUT + I_GU + I_DN;
    for (int it = gw; it < NITEMS; it += NGW) {
        int r = it;
        if (r < I_IN) { const int kb = r / 192, nb = r % 192; p0_transpose_item(A.in[I_WIN], WIN_LD, 1024, A.in[I_NMIX], (bf16*)(ws + WS_WIN), 32 * nb, 64 * kb, 32 * nb, scr, lane); continue; } r -= I_IN;
        if (r < I_OUT) { const int kb = r / 32, nb = r % 32; const float* ks = (kb < 16) ? A.in[I_CNW] : (A.in[I_SNW] - 1024);
            p0_transpose_item(A.in[I_WOUT], 1024, 2048, ks, (bf16*)(ws + WS_WOUT), 32 * nb, 64 * kb, 32 * nb, scr, lane); continue; } r -= I_OUT;
        if (r < I_GU) { const int e = r >> 10, q = r & 1023, kb = q >> 6, nb = q & 63; const int n0 = 32 * nb;
            const int bj = n0 >> 10, j = n0 & 1023, pn = j >> 7, jj = j & 127; const int rho = 256 * pn + 128 * bj + jj;
            p0_transpose_item(A.in[I_WGU] + (size_t)e * 1024 * 2048, 2048, 1024, A.in[I_NFFN], (bf16*)(ws + WS_WGU) + (size_t)e * 2048 * 1024, rho, 64 * kb, n0, scr, lane); continue; } r -= I_GU;
        { const int e = r >> 9, q = r & 511, kb = q >> 5, nb = q & 31;
            p0_transpose_item(A.in[I_WDN] + (size_t)e * 1024 * 1024, 1024, 1024, nullptr, (bf16*)(ws + WS_WDN) + (size_t)e * 1024 * 1024, 32 * nb, 64 * kb, 32 * nb, scr, lane); }
    }
    __syncthreads();
    LAS float* wdt = (LAS float*)(lds + RING_OFF);
    for (int idx = tid; idx < 16 * 1024; idx += NWAVES * 64) { const int d = idx >> 4, j = idx & 15; wdt[j * 1024 + d] = A.in[I_WIN][(size_t)d * WIN_LD + NPROJ + j] * A.in[I_NMIX][d]; }
    LDS_WAIT(); __syncthreads();
    bf16* XN = (bf16*)(ws + WS_XN); float* DT = (float*)(ws + WS_DT);
    f32x4 nv[4];
#define P0_ROWLOAD(mm) do { const int _m = (mm); const float* src = (_m < TR) ? A.in[I_X] + (size_t)_m * D : ((_m < MROW + NMETA) ? A.in[I_META] + (size_t)(_m - MROW) * D : nullptr); \
        _Pragma("unroll") for (int j = 0; j < 4; ++j) nv[j] = src ? *((const f32x4*)src + 64 * j + lane) : (f32x4){0.f, 0.f, 0.f, 0.f}; } while (0)
    if (gw < TA) P0_ROWLOAD(gw);
    for (int m = gw; m < TA; m += NGW) {
        f32x4 v[4]; float s = 0.f;
#pragma unroll
        for (int j = 0; j < 4; ++j) { v[j] = nv[j]; s += (v[j].x * v[j].x + v[j].y * v[j].y) + (v[j].z * v[j].z + v[j].w * v[j].w); }
        if (m + NGW < TA) P0_ROWLOAD(m + NGW);
        const float rstd = 1.0f / sqrtf(wave_sum(s) * (1.0f / D) + EPS);
        u32x2* o8 = (u32x2*)(XN + (size_t)m * D) + lane;
#pragma unroll
        for (int j = 0; j < 4; ++j) { u32x2 w; w.x = pk2(v[j].x * rstd, v[j].y * rstd); w.y = pk2(v[j].z * rstd, v[j].w * rstd); o8[64 * j] = w; }
        float mine = 0.f;
#pragma unroll 2
        for (int jj = 0; jj < 16; ++jj) { float a = 0.f;
#pragma unroll
            for (int j = 0; j < 4; ++j) { const f32x4 w = *(const LAS f32x4*)(wdt + jj * 1024 + 256 * j + 4 * lane); a += (v[j].x * w.x + v[j].y * w.y) + (v[j].z * w.z + v[j].w * w.w); }
            a = wave_sum(a); mine = (lane == jj) ? a : mine; }
        if (lane < 16) DT[(size_t)m * 16 + lane] = mine * rstd;
    }
}

__device__ __forceinline__ void p4_router(const Args& A, LAS unsigned char* lds, int vcu, int G, int tid, int lane, int wave) {
    unsigned char* ws = A.ws;
    const float* H1 = (const float*)(ws + WS_H1); bf16* XN2 = (bf16*)(ws + WS_XN);
    int* LIST = (int*)(ws + WS_LIST); float* GATE = (float*)(ws + WS_GATE); unsigned* CNT = (unsigned*)(ws + WS_CTL) + CW_CNT;
    LAS float* rwt = (LAS float*)(lds + RING_OFF);
    LAS int* sel_e = (LAS int*)(lds + RT_OFF); LAS float* sel_g = (LAS float*)(lds + RT_OFF + 2048); LAS int* rnk = (LAS int*)(lds + RT_OFF + 4096);
    LAS int* cnt_loc = (LAS int*)(lds + RT_OFF + 6144); LAS int* base_loc = (LAS int*)(lds + RT_OFF + 6144 + 128);
    for (int idx = tid; idx < 32 * 1024; idx += NWAVES * 64) { const int d = idx >> 5, e = idx & 31; rwt[e * 1024 + d] = A.in[I_RW][(size_t)d * 32 + e] * A.in[I_NFFN][d]; }
    LDS_WAIT(); __syncthreads();
    float rb[32];
#pragma unroll
    for (int e = 0; e < 32; ++e) rb[e] = A.in[I_RB][e];
    for (int ch = vcu; ch < TR / 128; ch += G) {
        if (tid < 32) cnt_loc[tid] = 0;
        LDS_WAIT(); __syncthreads();
        for (int q = 0; q < 16; ++q) {
            const int tl = wave * 16 + q, t = ch * 128 + tl;
            f32x4 v[4]; float s = 0.f;
#pragma unroll
            for (int j = 0; j < 4; ++j) { v[j] = *((const f32x4*)(H1 + (size_t)t * D) + 64 * j + lane); s += (v[j].x * v[j].x + v[j].y * v[j].y) + (v[j].z * v[j].z + v[j].w * v[j].w); }
            const float rstd = 1.0f / sqrtf(wave_sum(s) * (1.0f / D) + EPS);
            u32x2* o8 = (u32x2*)(XN2 + (size_t)t * D) + lane;
#pragma unroll
            for (int j = 0; j < 4; ++j) { u32x2 w; w.x = pk2(v[j].x * rstd, v[j].y * rstd); w.y = pk2(v[j].z * rstd, v[j].w * rstd); o8[64 * j] = w; }
            float lg[32];
#pragma unroll
            for (int e = 0; e < 32; ++e) { float a = 0.f;
#pragma unroll
                for (int j = 0; j < 4; ++j) { const f32x4 w = *(const LAS f32x4*)(rwt + e * 1024 + 256 * j + 4 * lane); a += (v[j].x * w.x + v[j].y * w.y) + (v[j].z * w.z + v[j].w * w.w); }
                lg[e] = wave_sum(a) * rstd + rb[e]; }
            float tv[4]; int ti[4];
#pragma unroll
            for (int k = 0; k < 4; ++k) { float best = lg[0]; int bi = 0;
#pragma unroll
                for (int e = 1; e < 32; ++e) { const bool gt = lg[e] > best; best = gt ? lg[e] : best; bi = gt ? e : bi; }
                tv[k] = best; ti[k] = bi;
#pragma unroll
                for (int e = 0; e < 32; ++e) lg[e] = (e == bi) ? -3.0e38f : lg[e]; }
            const float e1 = __expf(tv[1] - tv[0]), e2 = __expf(tv[2] - tv[0]), e3 = __expf(tv[3] - tv[0]); const float inv = 1.0f / (1.0f + e1 + e2 + e3);
            if (lane < 4) { const int e = lane == 0 ? ti[0] : (lane == 1 ? ti[1] : (lane == 2 ? ti[2] : ti[3]));
                const float g = (lane == 0 ? 1.0f : (lane == 1 ? e1 : (lane == 2 ? e2 : e3))) * inv;
                const int r = __hip_atomic_fetch_add(cnt_loc + e, 1, __ATOMIC_RELAXED, __HIP_MEMORY_SCOPE_WORKGROUP);
                sel_e[tl * 4 + lane] = e; sel_g[tl * 4 + lane] = g; rnk[tl * 4 + lane] = r; }
        }
        LDS_WAIT(); __syncthreads();
        if (tid < 32) base_loc[tid] = (int)__hip_atomic_fetch_add(CNT + tid, (unsigned)cnt_loc[tid], __ATOMIC_RELAXED, __HIP_MEMORY_SCOPE_AGENT);
        LDS_WAIT(); __syncthreads();
        { const int e = sel_e[tid]; const int pos = base_loc[e] + rnk[tid]; const int a = (ch * 128) * 4 + tid; LIST[(size_t)e * TR + pos] = a; GATE[a] = sel_g[tid]; }
        __syncthreads();
    }
}

__device__ __forceinline__ void p7_final(const Args& A, int vcu, int G, int lane, int wave) {
    unsigned char* ws = A.ws;
    const float* H1 = (const float*)(ws + WS_H1); const bf16* YE = (const bf16*)(ws + WS_YE);
    const int gw = vcu * NWAVES + wave, NGW = G * NWAVES;
    f32x4 wf[4];
#pragma unroll
    for (int j = 0; j < 4; ++j) wf[j] = *((const f32x4*)A.in[I_NFIN] + 64 * j + lane);
    for (int t = gw; t < TR; t += NGW) {
        f32x4 v[4]; float s = 0.f;
#pragma unroll
        for (int j = 0; j < 4; ++j) v[j] = *((const f32x4*)(H1 + (size_t)t * D) + 64 * j + lane);
#pragma unroll
        for (int k = 0; k < 4; ++k) { const u32x2* yr = (const u32x2*)(YE + ((size_t)t * 4 + k) * D) + lane;
#pragma unroll
            for (int j = 0; j < 4; ++j) { const u32x2 w = yr[64 * j]; v[j].x += bflo(w.x); v[j].y += bfhi(w.x); v[j].z += bflo(w.y); v[j].w += bfhi(w.y); } }
#pragma unroll
        for (int j = 0; j < 4; ++j) s += (v[j].x * v[j].x + v[j].y * v[j].y) + (v[j].z * v[j].z + v[j].w * v[j].w);
        const float rstd = 1.0f / sqrtf(wave_sum(s) * (1.0f / D) + EPS);
        f32x4* o = (f32x4*)(A.out + (size_t)t * D) + lane;
#pragma unroll
        for (int j = 0; j < 4; ++j) o[64 * j] = v[j] * rstd * wf[j];
    }
}

__device__ __forceinline__ void moe_tables(const Args& A, LAS unsigned char* lds, int tid) {
    LAS int* tst = (LAS int*)(lds + MOE_OFF); LAS int* cnt = tst + 40;
    const unsigned* CNT = (const unsigned*)(A.ws + WS_CTL) + CW_CNT;
    if (tid < 32) cnt[tid] = (int)__hip_atomic_load(CNT + tid, __ATOMIC_RELAXED, __HIP_MEMORY_SCOPE_AGENT);
    LDS_WAIT(); __syncthreads();
    if (tid == 0) { int s = 0; for (int e = 0; e < NE; ++e) { tst[e] = s; s += (cnt[e] + 255) >> 8; } tst[NE] = s; }
    LDS_WAIT(); __syncthreads();
}

__device__ __forceinline__ void d_conv_branch(const bf16* __restrict__ PROJ, const float* __restrict__ cw, bf16* __restrict__ Y, int m, int lane) {
    const int b = m / SEQ, s = m % SEQ, l = s + NMETA;
    const int r0 = row_of(b, l), r1 = row_of(b, l - 1), r2 = row_of(b, l - 2);
#pragma unroll
    for (int j = 0; j < 4; ++j) {
        const int c = 256 * j + 4 * lane;
        const u32x2 cb = *(const u32x2*)(PROJ + (size_t)r0 * NPROJ + C_CB + c);
        const u32x2 c0 = *(const u32x2*)(PROJ + (size_t)r0 * NPROJ + C_CC + c), x0 = *(const u32x2*)(PROJ + (size_t)r0 * NPROJ + C_CX + c);
        const u32x2 c1 = *(const u32x2*)(PROJ + (size_t)r1 * NPROJ + C_CC + c), x1 = *(const u32x2*)(PROJ + (size_t)r1 * NPROJ + C_CX + c);
        const u32x2 c2 = *(const u32x2*)(PROJ + (size_t)r2 * NPROJ + C_CC + c), x2 = *(const u32x2*)(PROJ + (size_t)r2 * NPROJ + C_CX + c);
        const f32x4 w0 = *(const f32x4*)(cw + c), w1 = *(const f32x4*)(cw + 1024 + c), w2 = *(const f32x4*)(cw + 2048 + c);
        float y[4];
        y[0] = bflo(cb.x) * (w0.x * bflo(c2.x) * bflo(x2.x) + w1.x * bflo(c1.x) * bflo(x1.x) + w2.x * bflo(c0.x) * bflo(x0.x));
        y[1] = bfhi(cb.x) * (w0.y * bfhi(c2.x) * bfhi(x2.x) + w1.y * bfhi(c1.x) * bfhi(x1.x) + w2.y * bfhi(c0.x) * bfhi(x0.x));
        y[2] = bflo(cb.y) * (w0.z * bflo(c2.y) * bflo(x2.y) + w1.z * bflo(c1.y) * bflo(x1.y) + w2.z * bflo(c0.y) * bflo(x0.y));
        y[3] = bfhi(cb.y) * (w0.w * bfhi(c2.y) * bfhi(x2.y) + w1.w * bfhi(c1.y) * bfhi(x1.y) + w2.w * bfhi(c0.y) * bfhi(x0.y));
        float ss = (y[0] * y[0] + y[1] * y[1]) + (y[2] * y[2] + y[3] * y[3]);
#pragma unroll
        for (int o = 1; o < 32; o <<= 1) ss += __shfl_xor(ss, o);
        const float rstd = 1.0f / sqrtf(ss * (1.0f / 128.0f) + EPS);
        u32x2 w; w.x = pk2(y[0] * rstd, y[1] * rstd); w.y = pk2(y[2] * rstd, y[3] * rstd);
        *(u32x2*)(Y + (size_t)m * DMIX + c) = w;
    }
}
__device__ __forceinline__ void d_xbc_act(const bf16* __restrict__ PROJ, const float* __restrict__ cw, const float* __restrict__ cb, bf16* __restrict__ XBCA, int m, int lane) {
    if (m >= MROW + NMETA) return;
    int b, l; if (m < TR) { b = m / SEQ; l = (m % SEQ) + NMETA; } else { b = 0; l = m - MROW; }
    int rk[4];
#pragma unroll
    for (int k = 0; k < 4; ++k) { const int lk = l - 3 + k; rk[k] = lk >= 0 ? row_of(b, lk) : -1; }
#pragma unroll
    for (int j = 0; j < 8; ++j) {
        const int c = 256 * j + 4 * lane;
        f32x4 a = *(const f32x4*)(cb + c);
#pragma unroll
        for (int k = 0; k < 4; ++k) if (rk[k] >= 0) { const u32x2 u = *(const u32x2*)(PROJ + (size_t)rk[k] * NPROJ + C_XS + c); const f32x4 w = *(const f32x4*)(cw + k * 2048 + c);
            a.x += w.x * bflo(u.x); a.y += w.y * bfhi(u.x); a.z += w.z * bflo(u.y); a.w += w.w * bfhi(u.y); }
        u32x2 o; o.x = pk2(silu_f(a.x), silu_f(a.y)); o.y = pk2(silu_f(a.z), silu_f(a.w));
        *(u32x2*)(XBCA + (size_t)m * 2048 + c) = o;
    }
}
__device__ __forceinline__ void d_ssd_naive(const bf16* __restrict__ XBCA, const bf16* __restrict__ PROJ, const float* __restrict__ DT, const float* __restrict__ dt_bias,
                                                   const float* __restrict__ a_log, const float* __restrict__ dpar, bf16* __restrict__ YPRE, int item, int p) {
    const int b = item >> 4, h = item & 15, g = h >> 2;
    const float Aneg = -__expf(a_log[h]), dtb = dt_bias[h], Dh = dpar[h];
    float S[128];
#pragma unroll
    for (int n = 0; n < 128; ++n) S[n] = 0.f;
    int row = row_of(b, 0);
    float n_draw = DT[(size_t)row * 16 + h]; unsigned short n_x = XBCA[(size_t)row * 2048 + h * 64 + p];
    unsigned n_bw = *(const unsigned*)(XBCA + (size_t)row * 2048 + 1024 + g * 128 + 2 * p), n_cw = *(const unsigned*)(XBCA + (size_t)row * 2048 + 1536 + g * 128 + 2 * p);
    unsigned short n_z = PROJ[(size_t)row * NPROJ + C_Z + h * 64 + p];
    for (int l = 0; l < LSEQ; ++l) {
        const int crow = row; const float draw = n_draw + dtb; const float xv = bf2f(n_x); const unsigned bw = n_bw, cw = n_cw; const float z = bf2f(n_z);
        if (l + 1 < LSEQ) { row = row_of(b, l + 1);
            n_draw = DT[(size_t)row * 16 + h]; n_x = XBCA[(size_t)row * 2048 + h * 64 + p];
            n_bw = *(const unsigned*)(XBCA + (size_t)row * 2048 + 1024 + g * 128 + 2 * p); n_cw = *(const unsigned*)(XBCA + (size_t)row * 2048 + 1536 + g * 128 + 2 * p);
            n_z = PROJ[(size_t)row * NPROJ + C_Z + h * 64 + p]; }
        const float dtv = draw > 20.f ? draw : log1pf(__expf(draw));
        const float dec = __expf(dtv * Aneg), xdt = xv * dtv;
        float y = 0.f;
#pragma unroll
        for (int n = 0; n < 128; n += 2) {
            const unsigned bb = (unsigned)__builtin_amdgcn_readlane((int)bw, n >> 1), cc = (unsigned)__builtin_amdgcn_readlane((int)cw, n >> 1);
            S[n] = S[n] * dec + xdt * bflo(bb); y += S[n] * bflo(cc);
            S[n + 1] = S[n + 1] * dec + xdt * bfhi(bb); y += S[n + 1] * bfhi(cc);
        }
        if (l >= NMETA) { const float yg = (y + Dh * xv) * silu_f(z); YPRE[(size_t)crow * 1024 + h * 64 + p] = (bf16)f2bf(yg); }
    }
}
__device__ __forceinline__ void d_ssd_norm(const bf16* __restrict__ YPRE, bf16* __restrict__ Y, int m, int lane) {
#pragma unroll
    for (int j = 0; j < 4; ++j) {
        const int c = 256 * j + 4 * lane;
        const u32x2 u = *(const u32x2*)(YPRE + (size_t)m * 1024 + c);
        const float y0 = bflo(u.x), y1 = bfhi(u.x), y2 = bflo(u.y), y3 = bfhi(u.y);
        const float ss = wave_sum((y0 * y0 + y1 * y1) + (y2 * y2 + y3 * y3));
        const float rstd = 1.0f / sqrtf(ss * (1.0f / 256.0f) + EPS);
        u32x2 w; w.x = pk2(y0 * rstd, y1 * rstd); w.y = pk2(y2 * rstd, y3 * rstd);
        *(u32x2*)(Y + (size_t)m * DMIX + 1024 + c) = w;
    }
}

namespace ssd {
constexpr int XP = 144, BP = 272;
constexpr int O_XDT = 0, O_XW = 18432, O_B = 36864, O_C = 71680, O_S = 106496, O_TAB = 123904;
constexpr int NCH = 17;
template <int STEP, int PITCH> __device__ __forceinline__ void tr4(unsigned a, bf16x8 (&f)[4]) {
    u32x2 r0, r1, r2, r3, r4, r5, r6, r7;
    asm volatile("ds_read_b64_tr_b16 %0, %8 offset:%9\n\tds_read_b64_tr_b16 %1, %8 offset:%10\n\tds_read_b64_tr_b16 %2, %8 offset:%11\n\tds_read_b64_tr_b16 %3, %8 offset:%12\n\t"
                 "ds_read_b64_tr_b16 %4, %8 offset:%13\n\tds_read_b64_tr_b16 %5, %8 offset:%14\n\tds_read_b64_tr_b16 %6, %8 offset:%15\n\tds_read_b64_tr_b16 %7, %8 offset:%16\n\ts_waitcnt lgkmcnt(0)"
                 : "=&v"(r0), "=&v"(r1), "=&v"(r2), "=&v"(r3), "=&v"(r4), "=&v"(r5), "=&v"(r6), "=&v"(r7)
                 : "v"(a), "i"(0 * STEP), "i"(0 * STEP + 4 * PITCH), "i"(1 * STEP), "i"(1 * STEP + 4 * PITCH), "i"(2 * STEP), "i"(2 * STEP + 4 * PITCH), "i"(3 * STEP), "i"(3 * STEP + 4 * PITCH) : "memory");
    u32x4 w;
    w.x = r0.x; w.y = r0.y; w.z = r1.x; w.w = r1.y; f[0] = __builtin_bit_cast(bf16x8, w);
    w.x = r2.x; w.y = r2.y; w.z = r3.x; w.w = r3.y; f[1] = __builtin_bit_cast(bf16x8, w);
    w.x = r4.x; w.y = r4.y; w.z = r5.x; w.w = r5.y; f[2] = __builtin_bit_cast(bf16x8, w);
    w.x = r6.x; w.y = r6.y; w.z = r7.x; w.w = r7.y; f[3] = __builtin_bit_cast(bf16x8, w);
}
#define SSD_MFMA(a, b, c) __builtin_amdgcn_mfma_f32_16x16x32_bf16((a), (b), (c), 0, 0, 0)
__device__ __forceinline__ int grow_of(int b, int c, int r) { return c > 0 ? b * SEQ + 128 * (c - 1) + r : (r >= 112 ? MROW + r - 112 : MROW); }

__device__ __forceinline__ void chain(const Args& A, LAS unsigned char* lds, int item, int tid, int lane, int wave) {
    const int b = item >> 4, h = item & 15, g = h >> 2, fr = lane & 15, fq = lane >> 4;
    const bf16* XB = (const bf16*)(A.ws + WS_XBCA); const bf16* PROJ = (const bf16*)(A.ws + WS_PROJ); const float* DT = (const float*)(A.ws + WS_DT); bf16* YPRE = (bf16*)(A.ws + WS_XN);
    const float Aneg = -__expf(A.in[I_ALOG][h]), dtb = A.in[I_DTB][h], Dh = A.in[I_SD][h];
    const unsigned lbase = (unsigned)(size_t)lds;
    for (int i = tid; i < 64 * BP / 16; i += NWAVES * 64) *(LAS u32x4*)(lds + O_S + i * 16) = (u32x4){0u, 0u, 0u, 0u};
    f32x4 st[4];
#pragma unroll
    for (int t = 0; t < 4; ++t) st[t] = (f32x4){0.f, 0.f, 0.f, 0.f};
    u32x4 pfx[2], pfb[4], pfc[4]; float pdt[2];
#define SSD_LOAD(c) do { \
        _Pragma("unroll") for (int i = 0; i < 2; ++i) { const int q = tid + 512 * i, row = q >> 3, c16 = q & 7; const bool ok = (c) > 0 || row >= 112; \
            const u32x4 v = *(const u32x4*)(XB + (size_t)grow_of(b, (c), row) * 2048 + h * 64 + c16 * 8); pfx[i] = ok ? v : (u32x4){0u, 0u, 0u, 0u}; } \
        _Pragma("unroll") for (int i = 0; i < 4; ++i) { const int q = tid + 512 * i, row = q >> 4, c16 = q & 15; const bool ok = (c) > 0 || row >= 112; \
            const bf16* src = XB + (size_t)grow_of(b, (c), row) * 2048 + 1024 + g * 128 + c16 * 8; \
            const u32x4 vb = *(const u32x4*)src, vc = *(const u32x4*)(src + 512); pfb[i] = ok ? vb : (u32x4){0u, 0u, 0u, 0u}; pfc[i] = ok ? vc : (u32x4){0u, 0u, 0u, 0u}; } \
        _Pragma("unroll") for (int i = 0; i < 2; ++i) { const int row = 2 * lane + i; const bool ok = (c) > 0 || row >= 112; const float v = DT[(size_t)grow_of(b, (c), row) * 16 + h]; pdt[i] = ok ? v : -1.0e30f; } \
    } while (0)
#define SSD_TABLES(buf) do { \
        float d0 = pdt[0] + dtb, d1 = pdt[1] + dtb; d0 = d0 > 20.f ? d0 : log1pf(__expf(d0)); d1 = d1 > 20.f ? d1 : log1pf(__expf(d1)); \
        if (pdt[0] < -1.0e29f) d0 = 0.f; if (pdt[1] < -1.0e29f) d1 = 0.f; \
        const float a0 = d0 * Aneg, a1 = d1 * Aneg; float incl = a0 + a1; \
        _Pragma("unroll") for (int o = 1; o < 64; o <<= 1) { const float t = __shfl_up(incl, o); incl += (lane >= o) ? t : 0.f; } \
        const float c1 = incl, c0 = incl - a1; const float aend = __shfl(incl, 63); \
        if (wave == 0) { LAS float* tb = (LAS float*)(lds + O_TAB + (buf) * 2048); \
            *(LAS f32x2*)(tb + 2 * lane) = (f32x2){c0, c1}; *(LAS f32x2*)(tb + 128 + 2 * lane) = (f32x2){d0, d1}; \
            *(LAS f32x2*)(tb + 256 + 2 * lane) = (f32x2){__expf(aend - c0), __expf(aend - c1)}; *(LAS f32x2*)(tb + 384 + 2 * lane) = (f32x2){__expf(c0), __expf(c1)}; } \
    } while (0)
    SSD_LOAD(0);
    SSD_TABLES(0);
    LDS_WAIT(); __syncthreads();
    for (int c = 0; c < NCH; ++c) {
        const LAS float* tb = (const LAS float*)(lds + O_TAB + (c & 1) * 2048);
#pragma unroll
        for (int i = 0; i < 2; ++i) { const int q = tid + 512 * i, row = q >> 3, c16 = q & 7; const float dv = tb[128 + row], wv = dv * tb[256 + row];
            const u32x4 v = pfx[i]; u32x4 a, w;
            a.x = pk2(bflo(v.x) * dv, bfhi(v.x) * dv); a.y = pk2(bflo(v.y) * dv, bfhi(v.y) * dv); a.z = pk2(bflo(v.z) * dv, bfhi(v.z) * dv); a.w = pk2(bflo(v.w) * dv, bfhi(v.w) * dv);
            w.x = pk2(bflo(v.x) * wv, bfhi(v.x) * wv); w.y = pk2(bflo(v.y) * wv, bfhi(v.y) * wv); w.z = pk2(bflo(v.z) * wv, bfhi(v.z) * wv); w.w = pk2(bflo(v.w) * wv, bfhi(v.w) * wv);
            *(LAS u32x4*)(lds + O_XDT + row * XP + c16 * 16) = a; *(LAS u32x4*)(lds + O_XW + row * XP + c16 * 16) = w; }
#pragma unroll
        for (int i = 0; i < 4; ++i) { const int q = tid + 512 * i, row = q >> 4, c16 = q & 15;
            *(LAS u32x4*)(lds + O_B + row * BP + c16 * 16) = pfb[i]; *(LAS u32x4*)(lds + O_C + row * BP + c16 * 16) = pfc[i]; }
        if (c + 1 < NCH) SSD_LOAD(c + 1);
        LDS_WAIT(); __syncthreads();
        const int lrow = 16 * wave + fr;
        bf16x8 Cf[4];
#pragma unroll
        for (int ks = 0; ks < 4; ++ks) Cf[ks] = *(const LAS bf16x8*)(lds + O_C + lrow * BP + ks * 64 + fq * 16);
        f32x4 cb[8];
#pragma unroll
        for (int nt = 0; nt < 8; ++nt) { cb[nt] = (f32x4){0.f, 0.f, 0.f, 0.f};
#pragma unroll
            for (int ks = 0; ks < 4; ++ks) { const bf16x8 Bf = *(const LAS bf16x8*)(lds + O_B + (16 * nt + fr) * BP + ks * 64 + fq * 16); cb[nt] = SSD_MFMA(Bf, Cf[ks], cb[nt]); }
            __builtin_amdgcn_sched_barrier(0); }
        f32x4 y[4];
#pragma unroll
        for (int pt = 0; pt < 4; ++pt) { y[pt] = (f32x4){0.f, 0.f, 0.f, 0.f};
#pragma unroll
            for (int ks = 0; ks < 4; ++ks) { const bf16x8 Sf = *(const LAS bf16x8*)(lds + O_S + (16 * pt + fr) * BP + ks * 64 + fq * 16); y[pt] = SSD_MFMA(Sf, Cf[ks], y[pt]); }
            if (pt & 1) __builtin_amdgcn_sched_barrier(0); }
        u32x2 ex[4], ez[4];
        { const int gr = grow_of(b, c, 16 * wave + fr);
#pragma unroll
          for (int pt = 0; pt < 4; ++pt) { ex[pt] = *(const u32x2*)(XB + (size_t)gr * 2048 + h * 64 + 16 * pt + 4 * fq); ez[pt] = *(const u32x2*)(PROJ + (size_t)gr * NPROJ + C_Z + h * 64 + 16 * pt + 4 * fq); } }
        { const float al = tb[lrow];
#pragma unroll
          for (int nt = 0; nt < 8; ++nt) { const int s0 = 16 * nt + 4 * fq; const f32x4 as4 = *(const LAS f32x4*)(tb + s0); float m[4];
#pragma unroll
              for (int j = 0; j < 4; ++j) m[j] = (s0 + j <= lrow) ? cb[nt][j] * __expf(al - as4[j]) : 0.f;
              u32x2 w; w.x = pk2(m[0], m[1]); w.y = pk2(m[2], m[3]); *(LAS u32x2*)(lds + O_C + lrow * BP + s0 * 2) = w; } }
        { const float el = tb[384 + lrow];
#pragma unroll
          for (int pt = 0; pt < 4; ++pt) y[pt] = y[pt] * el; }
        bf16x8 Mf[4];
#pragma unroll
        for (int ks = 0; ks < 4; ++ks) Mf[ks] = *(const LAS bf16x8*)(lds + O_C + lrow * BP + ks * 64 + fq * 16);
        const unsigned tra = (unsigned)((8 * fq + ((lane & 15) >> 2)) * XP + 8 * (lane & 3));
        const unsigned trb = (unsigned)((8 * fq + ((lane & 15) >> 2)) * BP + 8 * (lane & 3));
#pragma unroll
        for (int pt = 0; pt < 4; ++pt) { bf16x8 Xf[4]; tr4<32 * XP, XP>(lbase + O_XDT + tra + 32 * pt, Xf);
#pragma unroll
            for (int ks = 0; ks < 4; ++ks) y[pt] = SSD_MFMA(Xf[ks], Mf[ks], y[pt]); }
        if (c > 0) { const size_t orow = (size_t)(b * SEQ + 128 * (c - 1) + lrow) * 1024 + h * 64 + 4 * fq;
#pragma unroll
            for (int pt = 0; pt < 4; ++pt) { const f32x4 v = y[pt]; const u32x2 xv = ex[pt], zv = ez[pt];
                const float o0 = (v[0] + Dh * bflo(xv.x)) * silu_f(bflo(zv.x)), o1 = (v[1] + Dh * bfhi(xv.x)) * silu_f(bfhi(zv.x));
                const float o2 = (v[2] + Dh * bflo(xv.y)) * silu_f(bflo(zv.y)), o3 = (v[3] + Dh * bfhi(xv.y)) * silu_f(bfhi(zv.y));
                u32x2 w; w.x = pk2(o0, o1); w.y = pk2(o2, o3); *(u32x2*)(YPRE + orow + 16 * pt) = w; } }
        __syncthreads();
        { const int pt4 = wave & 3, nt0 = 4 * (wave >> 2); const float dec = __expf(tb[127]);
          bf16x8 Xw[4]; tr4<32 * XP, XP>(lbase + O_XW + tra + 32 * pt4, Xw);
#pragma unroll
          for (int t = 0; t < 4; ++t) { bf16x8 Bf[4]; tr4<32 * BP, BP>(lbase + O_B + trb + 32 * (nt0 + t), Bf); st[t] = st[t] * dec;
#pragma unroll
              for (int ks = 0; ks < 4; ++ks) st[t] = SSD_MFMA(Bf[ks], Xw[ks], st[t]);
              u32x2 w; w.x = pk2(st[t][0], st[t][1]); w.y = pk2(st[t][2], st[t][3]);
              *(LAS u32x2*)(lds + O_S + (16 * pt4 + fr) * BP + (16 * (nt0 + t) + 4 * fq) * 2) = w; } }
        if (c + 1 < NCH) SSD_TABLES((c + 1) & 1);
        LDS_WAIT(); __syncthreads();
    }
#undef SSD_LOAD
#undef SSD_TABLES
}
}

enum { PH_PREP = 0, PH_INPROJ, PH_MIXA, PH_MIXB, PH_MIXC, PH_OUTPROJ, PH_ROUTER, PH_GU, PH_DOWN, PH_FINAL, PH_N };
__global__ void __launch_bounds__(NWAVES * 64, 2) mk_fwd(Args args) {
    extern __shared__ __attribute__((aligned(16))) unsigned char lds_raw[];
    LAS unsigned char* lds = (LAS unsigned char*)lds_raw;
    const int tid = threadIdx.x, lane = tid & 63, wave = __builtin_amdgcn_readfirstlane(tid >> 6);
    const int G = gridDim.x; const int bx = blockIdx.x; const int vcu = (G % 8 == 0) ? (bx % 8) * (G / 8) + bx / 8 : bx;
    unsigned char* ws = args.ws;
    for (int u = tid; u < (LDS_BYTES - LDSCTL_OFF) / 4; u += NWAVES * 64) ((LAS unsigned*)(lds + LDSCTL_OFF))[u] = 0u;
    __syncthreads();
    const int lo = args.ph_lo, hi = args.ph_hi;
    const bool multi = (hi - lo) > 1;
    XcdBarrier bar; bar.bar = (unsigned*)(ws + WS_CTL) + CW_BAR; bar.x = 0; bar.st = nullptr;
    if (multi) bar = xcd_barrier_post((unsigned*)(ws + WS_CTL) + CW_BAR, (volatile LAS unsigned*)(lds + MISC_OFF) + 8);
#ifndef PHASE_MASK
#define PHASE_MASK 0xffff
#endif
#ifndef REPEAT_MASK
#define REPEAT_MASK 0
#endif
#define IN(k) (((PHASE_MASK >> (k)) & 1) && lo <= (k) && (k) < hi)
#define REP(k) for (int _rep = 0; _rep < (((REPEAT_MASK >> (k)) & 1) ? 2 : 1); ++_rep)
#define SEAM(k) do { if (IN(k) && IN((k) + 1)) xcd_barrier(bar); } while (0)

    if (IN(PH_PREP)) REP(PH_PREP) { p0_prologue(args, lds, vcu, G, tid, lane, wave); __syncthreads(); SEAM(PH_PREP); }

    if (IN(PH_INPROJ)) REP(PH_INPROJ) {
        pg8::DenseSched S; S.init(TA, NPROJ, 1024, ws + WS_WIN, G, bx);
        pg8::EpiProj E{(bf16*)(ws + WS_PROJ), NPROJ};
        pg8::gemm_phase<pg8::EpiProj, pg8::DenseSched, true, true>(lds + RING_OFF, (const char*)(ws + WS_XN), 1024, S, E);
        SEAM(PH_INPROJ);
    }
    if (IN(PH_MIXA)) REP(PH_MIXA) {
        const int gw = vcu * NWAVES + wave, NGW = G * NWAVES;
        for (int m = gw; m < TR; m += NGW) d_conv_branch((const bf16*)(ws + WS_PROJ), args.in[I_CSW], (bf16*)(ws + WS_Y), m, lane);
        for (int m = gw; m < TA; m += NGW) d_xbc_act((const bf16*)(ws + WS_PROJ), args.in[I_SCW], args.in[I_SCB], (bf16*)(ws + WS_XBCA), m, lane);
        SEAM(PH_MIXA);
    }
    if (IN(PH_MIXB)) REP(PH_MIXB) {
#ifdef SSD_NAIVE
        for (int item = bx; item < BATCH * NH; item += G) if (wave == 0) d_ssd_naive((const bf16*)(ws + WS_XBCA), (const bf16*)(ws + WS_PROJ), (const float*)(ws + WS_DT), args.in[I_DTB], args.in[I_ALOG], args.in[I_SD], (bf16*)(ws + WS_XN), item, lane);
#else
        for (int item = vcu; item < BATCH * NH; item += G) ssd::chain(args, lds, item, tid, lane, wave);
#endif
        SEAM(PH_MIXB);
    }
    if (IN(PH_MIXC)) REP(PH_MIXC) {
        const int gw = vcu * NWAVES + wave, NGW = G * NWAVES;
        for (int m = gw; m < TR; m += NGW) d_ssd_norm((const bf16*)(ws + WS_XN), (bf16*)(ws + WS_Y), m, lane);
        SEAM(PH_MIXC);
    }
    if (IN(PH_OUTPROJ)) REP(PH_OUTPROJ) {
        pg8::DenseSched S; S.init(TR, 1024, 2048, ws + WS_WOUT, G, bx);
        pg8::EpiH1 E{args.in[I_X], (float*)(ws + WS_H1), 1024};
        pg8::gemm_phase<pg8::EpiH1, pg8::DenseSched, true, true>(lds + RING_OFF, (const char*)(ws + WS_Y), 2048, S, E);
        SEAM(PH_OUTPROJ);
    }
    if (IN(PH_ROUTER)) { p4_router(args, lds, vcu, G, tid, lane, wave); SEAM(PH_ROUTER); }
    if (IN(PH_GU)) REP(PH_GU) {
        moe_tables(args, lds, tid);
        pg8::MoeSched<true> S; S.tst = (const LAS int*)(lds + MOE_OFF); S.cnt = S.tst + 40; S.G = G; S.c = bx; S.NP = 8; S.K = 1024; S.list = (const int*)(ws + WS_LIST);
        S.Bt = (const char*)(ws + WS_WGU); S.estride = (size_t)2048 * 1024 * 2;
        pg8::EpiSwiGLU E{(bf16*)(ws + WS_ACT), args.in[I_BGU]};
        pg8::gemm_phase<pg8::EpiSwiGLU, pg8::MoeSched<true>, true, true>(lds + RING_OFF, (const char*)(ws + WS_XN), 1024, S, E);
        SEAM(PH_GU);
    }
    if (IN(PH_DOWN)) REP(PH_DOWN) {
        moe_tables(args, lds, tid);
        pg8::MoeSched<false> S; S.tst = (const LAS int*)(lds + MOE_OFF); S.cnt = S.tst + 40; S.G = G; S.c = bx; S.NP = 4; S.K = 1024; S.list = (const int*)(ws + WS_LIST);
        S.Bt = (const char*)(ws + WS_WDN); S.estride = (size_t)1024 * 1024 * 2;
        pg8::EpiDown E{(bf16*)(ws + WS_YE), args.in[I_BDN], (const int*)(ws + WS_LIST), (const float*)(ws + WS_GATE)};
        pg8::gemm_phase<pg8::EpiDown, pg8::MoeSched<false>, true, true>(lds + RING_OFF, (const char*)(ws + WS_ACT), 1024, S, E);
        SEAM(PH_DOWN);
    }
    if (IN(PH_FINAL)) REP(PH_FINAL) { p7_final(args, vcu, G, lane, wave); }
#undef IN
#undef SEAM
}

extern "C" void kernel_launch(void* const* d_in, const int* in_sizes, int n_in, void* d_out, int out_size, void* d_ws, size_t ws_size, hipStream_t stream) {
    static int grid = 0;
    if (grid == 0) {
        if (n_in != 21 || in_sizes[0] != TR * D || out_size != TR * D || ws_size < WS_END) { fprintf(stderr, "kernel_launch: unexpected problem shape (n_in %d, in0 %d, out %d, ws %zu)\n", n_in, n_in > 0 ? in_sizes[0] : -1, out_size, ws_size); grid = -1; return; }
        int dev = 0, cus = 0, per_cu = 0;
        if (hipGetDevice(&dev) != hipSuccess || hipDeviceGetAttribute(&cus, hipDeviceAttributeMultiprocessorCount, dev) != hipSuccess) { grid = -1; return; }
        if (hipFuncSetAttribute((const void*)mk_fwd, hipFuncAttributeMaxDynamicSharedMemorySize, LDS_BYTES) != hipSuccess) { fprintf(stderr, "kernel_launch: hipFuncSetAttribute failed\n"); grid = -1; return; }
        if (hipOccupancyMaxActiveBlocksPerMultiprocessor(&per_cu, (const void*)mk_fwd, NWAVES * 64, LDS_BYTES) != hipSuccess || per_cu < 1) { fprintf(stderr, "kernel_launch: occupancy query says %d\n", per_cu); per_cu = 1; }
        (void)hipGetLastError();
        grid = cus;
    }
    if (grid < 0) return;
    (void)hipMemsetAsync((char*)d_ws + WS_CTL, 0, CTL_ZERO_BYTES, stream);
    Args a{};
    for (int i = 0; i < 21; ++i) a.in[i] = (const float*)d_in[i];
    a.out = (float*)d_out; a.ws = (unsigned char*)d_ws;
    unsigned char* ws = (unsigned char*)d_ws;
    auto launch = [&](int lo, int hi) { a.ph_lo = lo; a.ph_hi = hi; hipLaunchKernelGGL(mk_fwd, dim3(grid), dim3(NWAVES * 64), LDS_BYTES, stream, a); };
    launch(0, PH_N);
}
```

```cpp
#include <hip/hip_runtime.h>
#include <cstdio>
#include <cstdint>

#define LAS __attribute__((address_space(3)))
#define GAS __attribute__((address_space(1)))
typedef unsigned short bf16;
typedef short bf16x8 __attribute__((ext_vector_type(8)));
typedef float f32x4 __attribute__((ext_vector_type(4)));
typedef float f32x2 __attribute__((ext_vector_type(2)));
typedef unsigned u32x4 __attribute__((ext_vector_type(4)));
typedef unsigned u32x2 __attribute__((ext_vector_type(2)));
typedef GAS unsigned gu32;

constexpr int BATCH = 16, SEQ = 2048, D = 1024, NMETA = 16, LSEQ = SEQ + NMETA;
constexpr int TR = BATCH * SEQ;
constexpr int TA = 33024;
constexpr int MROW = TR;
constexpr int WIN_LD = 6160, NPROJ = 6144;
constexpr int C_CB = 0, C_CC = 1024, C_CX = 2048, C_Z = 3072, C_XS = 4096, C_BS = 5120, C_CS = 5632;
constexpr int NH = 16, HD = 64, NE = 32, DMIX = 2048;
constexpr float EPS = 1e-5f;
constexpr float SW_ALPHA = 1.702f, SW_LIMIT = 7.0f;

constexpr size_t MiB = 1u << 20;
constexpr size_t WS_CTL = 0, CTL_ZERO_BYTES = 1 * MiB;
constexpr size_t WS_LIST = 1 * MiB;
constexpr size_t WS_GATE = 5 * MiB;
constexpr size_t WS_DT = 6 * MiB;
constexpr size_t WS_WIN = 12 * MiB;
constexpr size_t WS_WOUT = 24 * MiB;
constexpr size_t WS_WGU = 28 * MiB;
constexpr size_t WS_WDN = 156 * MiB;
constexpr size_t WS_XN = 220 * MiB;
constexpr size_t WS_PROJ = 285 * MiB;
constexpr size_t WS_ACT = 285 * MiB;
constexpr size_t WS_YE = 557 * MiB;
constexpr size_t WS_Y = 672 * MiB;
constexpr size_t WS_H1 = 816 * MiB;
constexpr size_t WS_XBCA = 880 * MiB;
constexpr size_t WS_END = 1024 * MiB;
constexpr int CW_CNT = 64;
constexpr int CW_BAR = 4096;

__device__ __forceinline__ unsigned f2bf(float f) { unsigned u = __float_as_uint(f); return (u + 0x7fffu + ((u >> 16) & 1u)) >> 16; }
__device__ __forceinline__ unsigned pk2(float lo, float hi) { return f2bf(lo) | (f2bf(hi) << 16); }
__device__ __forceinline__ float bf2f(unsigned short b) { return __uint_as_float(((unsigned)b) << 16); }
__device__ __forceinline__ float bflo(unsigned w) { return __uint_as_float(w << 16); }
__device__ __forceinline__ float bfhi(unsigned w) { return __uint_as_float(w & 0xffff0000u); }
__device__ __forceinline__ unsigned cvt_pk_bf16(float lo, float hi) { unsigned r; asm volatile("v_cvt_pk_bf16_f32 %0, %1, %2" : "=v"(r) : "v"(lo), "v"(hi)); return r; }
__device__ __forceinline__ float wave_sum(float v) {
#pragma unroll
    for (int o = 1; o < 64; o <<= 1) v += __shfl_xor(v, o);
    return v;
}
__device__ __forceinline__ int row_of(int b, int l) { return l >= NMETA ? b * SEQ + (l - NMETA) : MROW + l; }
__device__ __forceinline__ float silu_f(float z) { return z / (1.0f + __expf(-z)); }
#define LDS_WAIT() asm volatile("s_waitcnt lgkmcnt(0)" ::: "memory")
#define VM_WAIT() asm volatile("s_waitcnt vmcnt(0)" ::: "memory")

namespace pg8 {
constexpr int BM = 256, BK = 64, HALF = 128, HTB = HALF * BK * 2, STAGE_BYTES = 8 * HTB, NXCD = 8, WGM = 8;
constexpr int NOFF_REL = STAGE_BYTES + 8192;
__host__ __device__ __forceinline__ int lds_byte(int r, int c) { const int st = (r >> 4) * 2 + (c >> 5), rr = r & 15, cc = c & 31, ob = rr * 64 + cc * 2; return st * 1024 + (ob ^ (((ob >> 9) & 1) << 5)); }
__host__ __device__ __forceinline__ void stage_rc(int b, int& R, int& C) { const int st = b / 1024, sb = b % 1024, swz = sb ^ (((sb >> 9) & 1) << 5); R = (st >> 1) * 16 + swz / 64; C = (st & 1) * 32 + (swz % 64) / 2; }
__host__ __device__ __forceinline__ int perm32(int rho) { const int n = rho >> 4, i = rho & 15; return 8 * (i >> 2) + 4 * n + (i & 3); }

template <class Epi, class Sched, bool ALIGN_EPI, bool SP2>
__device__ __forceinline__ void gemm_phase(LAS unsigned char* lds, const char* Abase, const int K, const Sched& S, const Epi& E) {
    const int tid = threadIdx.x, wid = __builtin_amdgcn_readfirstlane(tid >> 6), lane = tid & 63, wr = wid >> 2, wc = wid & 3, fr = lane & 15, fq = lane >> 4;
    const int nt = K / BK;
    int Rr[2]; unsigned cbA[2], voffB[2];
#pragma unroll
    for (int i = 0; i < 2; ++i) { int R, C; stage_rc(tid * 16 + i * 8192, R, C); const int Rb = Epi::PERM ? ((R & ~31) + perm32(R & 31)) : R;
        Rr[i] = R; cbA[i] = (unsigned)C * 2u; voffB[i] = (unsigned)(Rb * K + C) * 2u; }
    const size_t kstep = (size_t)(BK * 2);
    const size_t hstep = (size_t)HALF * K * 2;
    const unsigned ldsw = (unsigned)wid * 1024u;
    const int aoff = lds_byte(wr * 64 + fr, fq * 8), boff = lds_byte(wc * 32 + fr, fq * 8);
#define PG8_SA(b, h) (((b) * 2 + (h)) * HTB)
#define PG8_SB(b, h) ((4 + (b) * 2 + (h)) * HTB)
#define PG8_STAGEB(bufoff, gbase) do { _Pragma("unroll") for (int _i = 0; _i < 2; ++_i) \
        __builtin_amdgcn_global_load_lds((const unsigned*)((const char*)(gbase) + voffB[_i]), (LAS unsigned*)(lds + (bufoff) + ldsw + _i * 8192), 16, 0, 0); } while (0)
#define PG8_STAGEA(bufoff, offs, kt) do { const char* _gb = Abase + (size_t)(kt) * kstep; _Pragma("unroll") for (int _i = 0; _i < 2; ++_i) \
        __builtin_amdgcn_global_load_lds((const unsigned*)(_gb + (offs)[_i]), (LAS unsigned*)(lds + (bufoff) + ldsw + _i * 8192), 16, 0, 0); } while (0)
#define PG8_LDA(dst, b, h) do { _Pragma("unroll") for (int m = 0; m < 4; ++m) _Pragma("unroll") for (int k = 0; k < 2; ++k) dst[m][k] = *(const LAS bf16x8*)(lds + PG8_SA(b, h) + aoff + m * 2048 + k * 1024); } while (0)
#define PG8_LDB(dst, b, h) do { _Pragma("unroll") for (int n = 0; n < 2; ++n) _Pragma("unroll") for (int k = 0; k < 2; ++k) dst[n][k] = *(const LAS bf16x8*)(lds + PG8_SB(b, h) + boff + n * 2048 + k * 1024); } while (0)
#define PG8_MMA(ai, bj, At, Bt) do { __builtin_amdgcn_s_setprio(1); _Pragma("unroll") for (int m = 0; m < 4; ++m) _Pragma("unroll") for (int n = 0; n < 2; ++n) _Pragma("unroll") for (int k = 0; k < 2; ++k) \
        acc[ai][bj][m][n] = __builtin_amdgcn_mfma_f32_16x16x32_bf16(Bt[n][k], At[m][k], acc[ai][bj][m][n], 0, 0, 0); __builtin_amdgcn_s_setprio(0); } while (0)
#define PG8_WAIT_V(n) asm volatile("s_waitcnt vmcnt(" #n ")" ::: "memory")
#define PG8_WAIT_L(n) asm volatile("s_waitcnt lgkmcnt(" #n ")" ::: "memory")
#define PG8_BAR __builtin_amdgcn_s_barrier()
#define PG8_SCHED __builtin_amdgcn_sched_barrier(0)
    typename Sched::Unit cur, nxt; int ui = 0;
    if (!S.next(0, cur)) return;
    f32x4 acc[2][2][4][2];
#pragma unroll
    for (int a = 0; a < 2; ++a)
#pragma unroll
        for (int b = 0; b < 2; ++b)
#pragma unroll
            for (int m = 0; m < 4; ++m)
#pragma unroll
                for (int n = 0; n < 2; ++n) acc[a][b][m][n] = (f32x4){0.f, 0.f, 0.f, 0.f};
    bf16x8 At[4][2], B0[2][2], B1[2][2];
    unsigned coff[2][2];
    LAS u32x4* stash = (LAS u32x4*)(lds + NOFF_REL) + tid;
#pragma unroll
    for (int h = 0; h < 2; ++h)
#pragma unroll
        for (int i = 0; i < 2; ++i) coff[h][i] = S.aoff(cur, h * HALF + Rr[i]) + cbA[i];
    const char* cB = S.bptr(cur);
    if constexpr (SP2) {
        PG8_STAGEB(PG8_SB(0, 0), cB); PG8_STAGEB(PG8_SB(0, 1), cB + hstep); PG8_STAGEA(PG8_SA(0, 0), coff[0], 0); PG8_STAGEA(PG8_SA(0, 1), coff[1], 0);
        if (wr == 1) PG8_BAR;
        PG8_WAIT_V(2); PG8_BAR;
        PG8_STAGEB(PG8_SB(1, 0), cB + kstep); PG8_STAGEA(PG8_SA(1, 0), coff[0], 1); PG8_STAGEB(PG8_SB(1, 1), cB + hstep + kstep);
        PG8_WAIT_V(6); PG8_BAR;
    } else {
        PG8_STAGEB(PG8_SB(0, 0), cB); PG8_STAGEA(PG8_SA(0, 0), coff[0], 0); PG8_STAGEB(PG8_SB(0, 1), cB + hstep); PG8_STAGEA(PG8_SA(0, 1), coff[1], 0);
        if (wr == 1) PG8_BAR;
        PG8_WAIT_V(4); PG8_BAR;
        PG8_STAGEB(PG8_SB(1, 0), cB + kstep); PG8_STAGEA(PG8_SA(1, 0), coff[0], 1); PG8_STAGEB(PG8_SB(1, 1), cB + hstep + kstep);
        PG8_WAIT_V(6); PG8_BAR;
    }
    for (;;) {
        const bool has_next = S.next(ui + 1, nxt);
        const char* nB = has_next ? S.bptr(nxt) : cB;
        if (has_next) { u32x4 w; w.x = S.aoff(nxt, Rr[0]) + cbA[0]; w.y = S.aoff(nxt, Rr[1]) + cbA[1]; w.z = S.aoff(nxt, HALF + Rr[0]) + cbA[0]; w.w = S.aoff(nxt, HALF + Rr[1]) + cbA[1]; *stash = w; }
        for (int t = 0; t < nt; t += 2) {
            const bool last = (t == nt - 2);
            const char* b2 = last ? nB : cB + (size_t)(t + 2) * kstep;
            const char* b3 = b2 + kstep;
            const int ka = last ? 0 : t + 2;
            if constexpr (SP2) {
            PG8_LDB(B0, 0, 0); PG8_LDB(B1, 0, 1); PG8_SCHED; PG8_LDA(At, 0, 0); PG8_STAGEA(PG8_SA(1, 1), coff[1], t + 1);
            PG8_WAIT_V(8); PG8_WAIT_L(0); PG8_BAR; PG8_MMA(0, 0, At, B0); PG8_MMA(0, 1, At, B1); PG8_BAR; PG8_SCHED;
            if (last && has_next) { const u32x4 w = *stash; coff[0][0] = w.x; coff[0][1] = w.y; coff[1][0] = w.z; coff[1][1] = w.w; }
            PG8_LDA(At, 0, 1); PG8_STAGEB(PG8_SB(0, 0), b2); PG8_STAGEB(PG8_SB(0, 1), b2 + hstep); PG8_STAGEA(PG8_SA(0, 0), coff[0], ka);
            PG8_WAIT_V(8); PG8_WAIT_L(0); PG8_BAR; PG8_MMA(1, 0, At, B0); PG8_MMA(1, 1, At, B1); PG8_BAR; PG8_SCHED;
            PG8_LDB(B0, 1, 0); PG8_LDB(B1, 1, 1); PG8_SCHED; PG8_LDA(At, 1, 0); PG8_STAGEA(PG8_SA(0, 1), coff[1], ka);
            PG8_WAIT_V(8); PG8_WAIT_L(0); PG8_BAR; PG8_MMA(0, 0, At, B0); PG8_MMA(0, 1, At, B1); PG8_BAR; PG8_SCHED;
            PG8_LDA(At, 1, 1); PG8_STAGEB(PG8_SB(1, 0), b3); PG8_STAGEB(PG8_SB(1, 1), b3 + hstep); PG8_STAGEA(PG8_SA(1, 0), coff[0], ka + 1);
            PG8_WAIT_V(8); PG8_WAIT_L(0); PG8_BAR; PG8_MMA(1, 0, At, B0); PG8_MMA(1, 1, At, B1); PG8_BAR; PG8_SCHED;
            } else {
            PG8_LDB(B0, 0, 0); PG8_SCHED; PG8_LDA(At, 0, 0); PG8_STAGEA(PG8_SA(1, 1), coff[1], t + 1);
            PG8_WAIT_L(8); PG8_BAR; PG8_WAIT_L(0); PG8_MMA(0, 0, At, B0); PG8_BAR; PG8_SCHED;
            if (last && has_next) { const u32x4 w = *stash; coff[0][0] = w.x; coff[0][1] = w.y; coff[1][0] = w.z; coff[1][1] = w.w; }
            PG8_LDB(B1, 0, 1); PG8_STAGEB(PG8_SB(0, 0), b2);
            PG8_BAR; PG8_WAIT_L(0); PG8_MMA(0, 1, At, B1); PG8_BAR;
            PG8_LDA(At, 0, 1); PG8_STAGEA(PG8_SA(0, 0), coff[0], ka);
            PG8_BAR; PG8_WAIT_L(0); PG8_MMA(1, 0, At, B0); PG8_BAR; PG8_SCHED;
            PG8_STAGEB(PG8_SB(0, 1), b2 + hstep);
            PG8_WAIT_V(6); PG8_BAR; PG8_MMA(1, 1, At, B1); PG8_BAR;
            PG8_LDB(B0, 1, 0); PG8_SCHED; PG8_LDA(At, 1, 0); PG8_STAGEA(PG8_SA(0, 1), coff[1], ka);
            PG8_WAIT_L(8); PG8_BAR; PG8_WAIT_L(0); PG8_MMA(0, 0, At, B0); PG8_BAR; PG8_SCHED;
            PG8_LDB(B1, 1, 1); PG8_STAGEB(PG8_SB(1, 0), b3);
            PG8_BAR; PG8_WAIT_L(0); PG8_MMA(0, 1, At, B1); PG8_BAR;
            PG8_LDA(At, 1, 1); PG8_STAGEA(PG8_SA(1, 0), coff[0], ka + 1);
            PG8_BAR; PG8_WAIT_L(0); PG8_MMA(1, 0, At, B0); PG8_BAR; PG8_SCHED;
            PG8_STAGEB(PG8_SB(1, 1), b3 + hstep);
            PG8_WAIT_V(6); PG8_BAR; PG8_MMA(1, 1, At, B1); PG8_BAR;
            }
        }
        if constexpr (ALIGN_EPI) { if (wr == 0) PG8_BAR; }
        asm volatile("" ::: "memory");
        E(acc, cur, wr, wc, fr, fq);
        if (!has_next) break;
#pragma unroll
        for (int a = 0; a < 2; ++a)
#pragma unroll
            for (int b = 0; b < 2; ++b)
#pragma unroll
                for (int m = 0; m < 4; ++m)
#pragma unroll
                    for (int n = 0; n < 2; ++n) acc[a][b][m][n] = (f32x4){0.f, 0.f, 0.f, 0.f};
        cur = nxt; cB = nB; ++ui;
        if constexpr (ALIGN_EPI) { if (wr == 1) PG8_BAR; }
    }
    PG8_WAIT_V(0);
    if constexpr (!ALIGN_EPI) { if (wr == 0) PG8_BAR; }
    PG8_BAR;
#undef PG8_SA
#undef PG8_SB
#undef PG8_STAGEA
#undef PG8_STAGEB
#undef PG8_LDA
#undef PG8_LDB
#undef PG8_MMA
#undef PG8_WAIT_V
#undef PG8_WAIT_L
#undef PG8_BAR
#undef PG8_SCHED
}

struct DenseUnit { int pm, pn; };
struct DenseSched {
    typedef DenseUnit Unit;
    int nM, nN, nwg, G, c, K; const char* Bt;
    __device__ void init(int M, int N, int K_, const void* Bt_, int G_, int c_) { nM = M / BM; nN = N / BM; nwg = nM * nN; G = G_; c = c_; K = K_; Bt = (const char*)Bt_; }
    __device__ __forceinline__ bool next(int i, Unit& u) const {
        const long L = (long)i * G + c; if (L >= nwg) return false;
        int wgid = (int)L; { const int q = nwg / NXCD, r = nwg % NXCD, xcd = wgid % NXCD, off = wgid / NXCD; wgid = (xcd < r ? xcd * (q + 1) : r * (q + 1) + (xcd - r) * q) + off; }
        const int nig = WGM * nN, gid = wgid / nig, fm = gid * WGM, gsz = (nM - fm) < WGM ? (nM - fm) : WGM;
        u.pm = fm + ((wgid % nig) % gsz); u.pn = (wgid % nig) / gsz; return true;
    }
    __device__ __forceinline__ unsigned aoff(const Unit& u, int r) const { return (unsigned)(u.pm * BM + r) * (unsigned)(K * 2); }
    __device__ __forceinline__ const char* bptr(const Unit& u) const { return Bt + (size_t)u.pn * BM * K * 2; }
};

struct MoeUnit { int e, rt, l0, nv, pn; };
template <bool GATHER>
struct MoeSched {
    typedef MoeUnit Unit;
    const LAS int* tst;
    const LAS int* cnt;
    int G, c, NP, K; const int* list; const char* Bt; size_t estride;
    __device__ __forceinline__ bool next(int i, Unit& u) const {
        const int L = i * G + c; const int R = __builtin_amdgcn_readfirstlane(tst[NE]); if (L >= R * NP) return false;
        const int rt = L / NP; u.pn = L % NP;
        int e = 0;
#pragma unroll 1
        for (int j = 1; j < NE; ++j) e = (rt >= __builtin_amdgcn_readfirstlane(tst[j])) ? j : e;
        u.e = e; u.rt = rt; u.l0 = (rt - __builtin_amdgcn_readfirstlane(tst[e])) * BM; const int rem = __builtin_amdgcn_readfirstlane(cnt[e]) - u.l0; u.nv = rem < BM ? rem : BM; return true;
    }
    __device__ __forceinline__ unsigned aoff(const Unit& u, int r) const {
        if (GATHER) { const int j = (r < u.nv) ? (u.l0 + r) : u.l0; const int a = list[(size_t)u.e * TR + j]; return (unsigned)(a >> 2) * (unsigned)(K * 2); }
        else return (unsigned)(u.rt * BM + r) * (unsigned)(K * 2);
    }
    __device__ __forceinline__ const char* bptr(const Unit& u) const { return Bt + (size_t)u.e * estride + (size_t)u.pn * BM * K * 2; }
};

struct EpiProj {
    static constexpr bool PERM = true;
    bf16* O; int ldc;
    __device__ __forceinline__ void operator()(const f32x4 (&acc)[2][2][4][2], const DenseUnit& u, int wr, int wc, int fr, int fq) const {
        const int row0 = u.pm * BM + wr * 64 + fr; const int col0 = u.pn * BM + wc * 32 + 8 * fq;
#pragma unroll
        for (int ai = 0; ai < 2; ++ai)
#pragma unroll
            for (int m = 0; m < 4; ++m) { bf16* rowp = O + (size_t)(row0 + ai * HALF + m * 16) * ldc + col0;
#pragma unroll
                for (int bj = 0; bj < 2; ++bj) { const f32x4 v0 = acc[ai][bj][m][0], v1 = acc[ai][bj][m][1];
                    u32x4 w; w.x = cvt_pk_bf16(v0[0], v0[1]); w.y = cvt_pk_bf16(v0[2], v0[3]); w.z = cvt_pk_bf16(v1[0], v1[1]); w.w = cvt_pk_bf16(v1[2], v1[3]);
                    *(u32x4*)(rowp + bj * HALF) = w; } }
    }
};
struct EpiH1 {
    static constexpr bool PERM = false;
    const float* X; float* H; int ldc;
    __device__ __forceinline__ void operator()(const f32x4 (&acc)[2][2][4][2], const DenseUnit& u, int wr, int wc, int fr, int fq) const {
        const int row0 = u.pm * BM + wr * 64 + fr, col0 = u.pn * BM + wc * 32 + 4 * fq;
#pragma unroll
        for (int ai = 0; ai < 2; ++ai)
#pragma unroll
            for (int m = 0; m < 4; ++m) { const size_t off = (size_t)(row0 + ai * HALF + m * 16) * ldc + col0;
#pragma unroll
                for (int bj = 0; bj < 2; ++bj)
#pragma unroll
                    for (int n = 0; n < 2; ++n) { const f32x4 xv = *(const f32x4*)(X + off + bj * HALF + n * 16); *(f32x4*)(H + off + bj * HALF + n * 16) = xv + acc[ai][bj][m][n]; }
                asm volatile("" ::: "memory"); }
    }
};
__device__ __forceinline__ float swiglu1(float g, float l) {
    g = fminf(g, SW_LIMIT); l = fminf(fmaxf(l, -SW_LIMIT), SW_LIMIT);
    return g * (l + 1.0f) / (1.0f + __expf(-SW_ALPHA * g));
}
struct EpiSwiGLU {
    static constexpr bool PERM = true;
    bf16* ACT; const float* bgu;
    __device__ __forceinline__ void operator()(const f32x4 (&acc)[2][2][4][2], const MoeUnit& u, int wr, int wc, int fr, int fq) const {
        const int row0 = u.rt * BM + wr * 64 + fr; const int j0 = u.pn * HALF + wc * 32 + 8 * fq;
        const float* bg = bgu + (size_t)u.e * 2048 + j0;
        const f32x4 g0 = *(const f32x4*)(bg), g1 = *(const f32x4*)(bg + 4), l0 = *(const f32x4*)(bg + 1024), l1 = *(const f32x4*)(bg + 1028);
#pragma unroll
        for (int ai = 0; ai < 2; ++ai)
#pragma unroll
            for (int m = 0; m < 4; ++m) { bf16* rowp = ACT + (size_t)(row0 + ai * HALF + m * 16) * 1024 + j0;
                const f32x4 a0 = acc[ai][0][m][0] + g0, a1 = acc[ai][0][m][1] + g1, b0 = acc[ai][1][m][0] + l0, b1 = acc[ai][1][m][1] + l1;
                u32x4 w; w.x = cvt_pk_bf16(swiglu1(a0[0], b0[0]), swiglu1(a0[1], b0[1])); w.y = cvt_pk_bf16(swiglu1(a0[2], b0[2]), swiglu1(a0[3], b0[3]));
                w.z = cvt_pk_bf16(swiglu1(a1[0], b1[0]), swiglu1(a1[1], b1[1])); w.w = cvt_pk_bf16(swiglu1(a1[2], b1[2]), swiglu1(a1[3], b1[3]));
                *(u32x4*)rowp = w; }
    }
};
struct EpiDown {
    static constexpr bool PERM = true;
    bf16* YE; const float* bdn; const int* list; const float* gate;
    __device__ __forceinline__ void operator()(const f32x4 (&acc)[2][2][4][2], const MoeUnit& u, int wr, int wc, int fr, int fq) const {
        const int col0 = u.pn * BM + wc * 32 + 8 * fq;
        const float* bb = bdn + (size_t)u.e * 1024 + col0;
        f32x4 bv[2][2];
#pragma unroll
        for (int bj = 0; bj < 2; ++bj)
#pragma unroll
            for (int n = 0; n < 2; ++n) bv[bj][n] = *(const f32x4*)(bb + bj * HALF + 4 * n);
#pragma unroll
        for (int ai = 0; ai < 2; ++ai)
#pragma unroll
            for (int m = 0; m < 4; ++m) { const int r = ai * HALF + wr * 64 + m * 16 + fr;
                if (r < u.nv) { const int a = list[(size_t)u.e * TR + u.l0 + r]; const float g = gate[a]; bf16* rowp = YE + (size_t)a * 1024 + col0;
#pragma unroll
                    for (int bj = 0; bj < 2; ++bj) { const f32x4 v0 = (acc[ai][bj][m][0] + bv[bj][0]) * g, v1 = (acc[ai][bj][m][1] + bv[bj][1]) * g;
                        u32x4 w; w.x = cvt_pk_bf16(v0[0], v0[1]); w.y = cvt_pk_bf16(v0[2], v0[3]); w.z = cvt_pk_bf16(v1[0], v1[1]); w.w = cvt_pk_bf16(v1[2], v1[3]);
                        *(u32x4*)(rowp + bj * HALF) = w; } } }
    }
};
}

constexpr int NWAVES = 8;
constexpr int RING_OFF = 0, RING_BYTES = 131072;
constexpr int LDSCTL_OFF = RING_BYTES;
constexpr int MISC_OFF = LDSCTL_OFF + 320;
constexpr int MOE_OFF = LDSCTL_OFF + 512;
constexpr int RT_OFF = LDSCTL_OFF + 1024;
constexpr int LDS_BYTES = 147456;

#define XB_TMO      128
#define XB_XCNT(j)  (256  + 64 * (j))
#define XB_XSUB(j)  (1280 + 64 * (j))
#define XB_XGEN(j)  (2304 + 64 * (j))
#define XB_TOP      3328
#define XB_TOPGEN   3392
#define XCD_BAR_WORDS 3456
#define XB_SPIN_CAP (1u << 18)
__device__ __forceinline__ unsigned xb_ld(unsigned* p)              { return __hip_atomic_load(p, __ATOMIC_RELAXED, __HIP_MEMORY_SCOPE_AGENT); }
__device__ __forceinline__ unsigned xb_add(unsigned* p, unsigned v) { return __hip_atomic_fetch_add(p, v, __ATOMIC_RELAXED, __HIP_MEMORY_SCOPE_AGENT); }
__device__ __forceinline__ unsigned xb_xcc_id() { return (unsigned)__builtin_amdgcn_s_getreg((3 << 11) | 20) & 0xFu; }
#define XB_SPIN(cond, bar) do { unsigned _sp = 0; while (cond) { __builtin_amdgcn_s_sleep(1); \
    if ((++_sp & 255u) == 0u) { if (xb_ld(&(bar)[XB_TMO])) break; if (_sp > XB_SPIN_CAP) { atomicAdd(&(bar)[XB_TMO], 1u); break; } } } } while (0)
struct XcdBarrier { unsigned* bar; unsigned x; volatile LAS unsigned* st; };
__device__ __forceinline__ XcdBarrier xcd_barrier_post(unsigned* bar, volatile LAS unsigned* st) {
    XcdBarrier b; b.bar = bar; b.x = xb_xcc_id(); b.st = st;
    if (threadIdx.x == 0) (void)xb_add(&bar[XB_XCNT(b.x)], 1u);
    return b;
}
__device__ __forceinline__ void xcd_barrier_complete(unsigned* bar, unsigned x, unsigned& nloc, unsigned& nx) {
    const unsigned G = gridDim.x * gridDim.y * gridDim.z;
    unsigned sum, cnt, mine, sp = 0u;
    for (;;) {
        sum = 0u; cnt = 0u; mine = 0u;
#pragma unroll
        for (unsigned j = 0; j < 16; ++j) { const unsigned c = xb_ld(&bar[XB_XCNT(j)]); sum += c; cnt += (c > 0u) ? 1u : 0u; mine = (j == x) ? c : mine; }
        if (sum == G) break;
        __builtin_amdgcn_s_sleep(1);
        if ((++sp & 255u) == 0u) { if (xb_ld(&bar[XB_TMO])) break; if (sp > XB_SPIN_CAP) { atomicAdd(&bar[XB_TMO], 1u); break; } }
    }
    nloc = mine > 0u ? mine : 1u; nx = cnt > 0u ? cnt : 1u;
}
__device__ __forceinline__ void xcd_barrier(const XcdBarrier& b) {
    asm volatile("s_waitcnt vmcnt(0)" ::: "memory");
    __syncthreads();
    if (threadIdx.x == 0) {
        unsigned* bar = b.bar;
        __builtin_amdgcn_s_waitcnt(0);
        unsigned nloc = b.st[0], nx = b.st[1];
        if (nloc == 0u) { xcd_barrier_complete(bar, b.x, nloc, nx); b.st[0] = nloc; b.st[1] = nx; }
        const unsigned old = xb_add(&bar[XB_XSUB(b.x)], 1u);
        const unsigned gen = old / nloc;
        if (old + 1u == (gen + 1u) * nloc) {
            __builtin_amdgcn_fence(__ATOMIC_RELEASE, "agent");
            asm volatile("s_waitcnt vmcnt(0)" ::: "memory");
            const unsigned og = xb_add(&bar[XB_TOP], 1u);
            const unsigned tg = og / nx;
            if (og + 1u == (tg + 1u) * nx) xb_add(&bar[XB_TOPGEN], 1u);
            else XB_SPIN(xb_ld(&bar[XB_TOPGEN]) == tg, bar);
            __builtin_amdgcn_fence(__ATOMIC_ACQUIRE, "agent");
            xb_add(&bar[XB_XGEN(b.x)], 1u);
            asm volatile("s_waitcnt vmcnt(0)" ::: "memory");
        } else {
            XB_SPIN(xb_ld(&bar[XB_XGEN(b.x)]) == gen, bar);
            __builtin_amdgcn_fence(__ATOMIC_ACQUIRE, "agent");
            asm volatile("s_waitcnt vmcnt(0)" ::: "memory");
        }
    }
    __syncthreads();
}

struct Args { const float* in[21]; float* out; unsigned char* ws; int ph_lo, ph_hi; };
enum { I_X = 0, I_META, I_NMIX, I_WIN, I_CSW, I_CNW, I_SCW, I_SCB, I_DTB, I_ALOG, I_SD, I_SNW, I_WOUT, I_NFFN, I_RW, I_RB, I_WGU, I_BGU, I_WDN, I_BDN, I_NFIN };

__device__ __forceinline__ void p0_transpose_item(const float* W, int ldw, int K, const float* kscale, bf16* WT, int row_off, int k0, int n0, LAS float* scr, int lane) {
    float v[32];
#pragma unroll
    for (int i = 0; i < 32; ++i) v[i] = W[(size_t)(k0 + 2 * i + (lane >> 5)) * ldw + n0 + (lane & 31)];
    if (kscale) {
#pragma unroll
        for (int i = 0; i < 32; ++i) v[i] *= kscale[k0 + 2 * i + (lane >> 5)];
    }
#pragma unroll
    for (int i = 0; i < 32; ++i) scr[(2 * i + (lane >> 5)) * 33 + (lane & 31)] = v[i];
    LDS_WAIT(); asm volatile("" ::: "memory");
    const int c = lane & 7;
#pragma unroll
    for (int j = 0; j < 4; ++j) { const int n = (lane >> 3) + 8 * j; const LAS float* s = scr + (8 * c) * 33 + n;
        u32x4 o; o.x = pk2(s[0 * 33], s[1 * 33]); o.y = pk2(s[2 * 33], s[3 * 33]); o.z = pk2(s[4 * 33], s[5 * 33]); o.w = pk2(s[6 * 33], s[7 * 33]);
        *(u32x4*)(WT + (size_t)(row_off + n) * K + k0 + 8 * c) = o; }
    LDS_WAIT(); asm volatile("" ::: "memory");
}

__device__ __forceinline__ void p0_prologue(const Args& A, LAS unsigned char* lds, int vcu, int G, int tid, int lane, int wave) {
    unsigned char* ws = A.ws;
    LAS float* scr = (LAS float*)(lds + RING_OFF + wave * 16384);
    const int gw = vcu * NWAVES + wave, NGW = G * NWAVES;
    constexpr int I_IN = 16 * 192, I_OUT = 32 * 32, I_GU = 32 * 16 * 64, I_DN = 32 * 16 * 32;
    constexpr int NITEMS = I_IN + I_OUT + I_GU + I_DN;
    for (int it = gw; it < NITEMS; it += NGW) {
        int r = it;
        if (r < I_IN) { const int kb = r / 192, nb = r % 192; p0_transpose_item(A.in[I_WIN], WIN_LD, 1024, A.in[I_NMIX], (bf16*)(ws + WS_WIN), 32 * nb, 64 * kb, 32 * nb, scr, lane); continue; } r -= I_IN;
        if (r < I_OUT) { const int kb = r / 32, nb = r % 32; const float* ks = (kb < 16) ? A.in[I_CNW] : (A.in[I_SNW] - 1024);
            p0_transpose_item(A.in[I_WOUT], 1024, 2048, ks, (bf16*)(ws + WS_WOUT), 32 * nb, 64 * kb, 32 * nb, scr, lane); continue; } r -= I_OUT;
        if (r < I_GU) { const int e = r >> 10, q = r & 1023, kb = q >> 6, nb = q & 63; const int n0 = 32 * nb;
            const int bj = n0 >> 10, j = n0 & 1023, pn = j >> 7, jj = j & 127; const int rho = 256 * pn + 128 * bj + jj;
            p0_transpose_item(A.in[I_WGU] + (size_t)e * 1024 * 2048, 2048, 1024, A.in[I_NFFN], (bf16*)(ws + WS_WGU) + (size_t)e * 2048 * 1024, rho, 64 * kb, n0, scr, lane); continue; } r -= I_GU;
        { const int e = r >> 9, q = r & 511, kb = q >> 5, nb = q & 31;
            p0_transpose_item(A.in[I_WDN] + (size_t)e * 1024 * 1024, 1024, 1024, nullptr, (bf16*)(ws + WS_WDN) + (size_t)e * 1024 * 1024, 32 * nb, 64 * kb, 32 * nb, scr, lane); }
    }
    __syncthreads();
    LAS float* wdt = (LAS float*)(lds + RING_OFF);
    for (int idx = tid; idx < 16 * 1024; idx += NWAVES * 64) { const int d = idx >> 4, j = idx & 15; wdt[j * 1024 + d] = A.in[I_WIN][(size_t)d * WIN_LD + NPROJ + j] * A.in[I_NMIX][d]; }
    LDS_WAIT(); __syncthreads();
    bf16* XN = (bf16*)(ws + WS_XN); float* DT = (float*)(ws + WS_DT);
    f32x4 nv[4];
#define P0_ROWLOAD(mm) do { const int _m = (mm); const float* src = (_m < TR) ? A.in[I_X] + (size_t)_m * D : ((_m < MROW + NMETA) ? A.in[I_META] + (size_t)(_m - MROW) * D : nullptr); \
        _Pragma("unroll") for (int j = 0; j < 4; ++j) nv[j] = src ? *((const f32x4*)src + 64 * j + lane) : (f32x4){0.f, 0.f, 0.f, 0.f}; } while (0)
    if (gw < TA) P0_ROWLOAD(gw);
    for (int m = gw; m < TA; m += NGW) {
        f32x4 v[4]; float s = 0.f;
#pragma unroll
        for (int j = 0; j < 4; ++j) { v[j] = nv[j]; s += (v[j].x * v[j].x + v[j].y * v[j].y) + (v[j].z * v[j].z + v[j].w * v[j].w); }
        if (m + NGW < TA) P0_ROWLOAD(m + NGW);
        const float rstd = 1.0f / sqrtf(wave_sum(s) * (1.0f / D) + EPS);
        u32x2* o8 = (u32x2*)(XN + (size_t)m * D) + lane;
#pragma unroll
        for (int j = 0; j < 4; ++j) { u32x2 w; w.x = pk2(v[j].x * rstd, v[j].y * rstd); w.y = pk2(v[j].z * rstd, v[j].w * rstd); o8[64 * j] = w; }
        float mine = 0.f;
#pragma unroll 2
        for (int jj = 0; jj < 16; ++jj) { float a = 0.f;
#pragma unroll
            for (int j = 0; j < 4; ++j) { const f32x4 w = *(const LAS f32x4*)(wdt + jj * 1024 + 256 * j + 4 * lane); a += (v[j].x * w.x + v[j].y * w.y) + (v[j].z * w.z + v[j].w * w.w); }
            a = wave_sum(a); mine = (lane == jj) ? a : mine; }
        if (lane < 16) DT[(size_t)m * 16 + lane] = mine * rstd;
    }
}

__device__ __forceinline__ void p4_router(const Args& A, LAS unsigned char* lds, int vcu, int G, int tid, int lane, int wave) {
    unsigned char* ws = A.ws;
    const float* H1 = (const float*)(ws + WS_H1); bf16* XN2 = (bf16*)(ws + WS_XN);
    int* LIST = (int*)(ws + WS_LIST); float* GATE = (float*)(ws + WS_GATE); unsigned* CNT = (unsigned*)(ws + WS_CTL) + CW_CNT;
    LAS float* rwt = (LAS float*)(lds + RING_OFF);
    LAS int* sel_e = (LAS int*)(lds + RT_OFF); LAS float* sel_g = (LAS float*)(lds + RT_OFF + 2048); LAS int* rnk = (LAS int*)(lds + RT_OFF + 4096);
    LAS int* cnt_loc = (LAS int*)(lds + RT_OFF + 6144); LAS int* base_loc = (LAS int*)(lds + RT_OFF + 6144 + 128);
    for (int idx = tid; idx < 32 * 1024; idx += NWAVES * 64) { const int d = idx >> 5, e = idx & 31; rwt[e * 1024 + d] = A.in[I_RW][(size_t)d * 32 + e] * A.in[I_NFFN][d]; }
    LDS_WAIT(); __syncthreads();
    float rb[32];
#pragma unroll
    for (int e = 0; e < 32; ++e) rb[e] = A.in[I_RB][e];
    for (int ch = vcu; ch < TR / 128; ch += G) {
        if (tid < 32) cnt_loc[tid] = 0;
        LDS_WAIT(); __syncthreads();
        for (int q = 0; q < 16; ++q) {
            const int tl = wave * 16 + q, t = ch * 128 + tl;
            f32x4 v[4]; float s = 0.f;
#pragma unroll
            for (int j = 0; j < 4; ++j) { v[j] = *((const f32x4*)(H1 + (size_t)t * D) + 64 * j + lane); s += (v[j].x * v[j].x + v[j].y * v[j].y) + (v[j].z * v[j].z + v[j].w * v[j].w); }
            const float rstd = 1.0f / sqrtf(wave_sum(s) * (1.0f / D) + EPS);
            u32x2* o8 = (u32x2*)(XN2 + (size_t)t * D) + lane;
#pragma unroll
            for (int j = 0; j < 4; ++j) { u32x2 w; w.x = pk2(v[j].x * rstd, v[j].y * rstd); w.y = pk2(v[j].z * rstd, v[j].w * rstd); o8[64 * j] = w; }
            float lg[32];
#pragma unroll
            for (int e = 0; e < 32; ++e) { float a = 0.f;
#pragma unroll
                for (int j = 0; j < 4; ++j) { const f32x4 w = *(const LAS f32x4*)(rwt + e * 1024 + 256 * j + 4 * lane); a += (v[j].x * w.x + v[j].y * w.y) + (v[j].z * w.z + v[j].w * w.w); }
                lg[e] = wave_sum(a) * rstd + rb[e]; }
            float tv[4]; int ti[4];
#pragma unroll
            for (int k = 0; k < 4; ++k) { float best = lg[0]; int bi = 0;
#pragma unroll
                for (int e = 1; e < 32; ++e) { const bool gt = lg[e] > best; best = gt ? lg[e] : best; bi = gt ? e : bi; }
                tv[k] = best; ti[k] = bi;
#pragma unroll
                for (int e = 0; e < 32; ++e) lg[e] = (e == bi) ? -3.0e38f : lg[e]; }
            const float e1 = __expf(tv[1] - tv[0]), e2 = __expf(tv[2] - tv[0]), e3 = __expf(tv[3] - tv[0]); const float inv = 1.0f / (1.0f + e1 + e2 + e3);
            if (lane < 4) { const int e = lane == 0 ? ti[0] : (lane == 1 ? ti[1] : (lane == 2 ? ti[2] : ti[3]));
                const float g = (lane == 0 ? 1.0f : (lane == 1 ? e1 : (lane == 2 ? e2 : e3))) * inv;
                const int r = __hip_atomic_fetch_add(cnt_loc + e, 1, __ATOMIC_RELAXED, __HIP_MEMORY_SCOPE_WORKGROUP);
                sel_e[tl * 4 + lane] = e; sel_g[tl * 4 + lane] = g; rnk[tl * 4 + lane] = r; }
        }
        LDS_WAIT(); __syncthreads();
        if (tid < 32) base_loc[tid] = (int)__hip_atomic_fetch_add(CNT + tid, (unsigned)cnt_loc[tid], __ATOMIC_RELAXED, __HIP_MEMORY_SCOPE_AGENT);
        LDS_WAIT(); __syncthreads();
        { const int e = sel_e[tid]; const int pos = base_loc[e] + rnk[tid]; const int a = (ch * 128) * 4 + tid; LIST[(size_t)e * TR + pos] = a; GATE[a] = sel_g[tid]; }
        __syncthreads();
    }
}

__device__ __forceinline__ void p7_final(const Args& A, int vcu, int G, int lane, int wave) {
    unsigned char* ws = A.ws;
    const float* H1 = (const float*)(ws + WS_H1); const bf16* YE = (const bf16*)(ws + WS_YE);
    const int gw = vcu * NWAVES + wave, NGW = G * NWAVES;
    f32x4 wf[4];
#pragma unroll
    for (int j = 0; j < 4; ++j) wf[j] = *((const f32x4*)A.in[I_NFIN] + 64 * j + lane);
    for (int t = gw; t < TR; t += NGW) {
        f32x4 v[4]; float s = 0.f;
#pragma unroll
        for (int j = 0; j < 4; ++j) v[j] = *((const f32x4*)(H1 + (size_t)t * D) + 64 * j + lane);
#pragma unroll
        for (int k = 0; k < 4; ++k) { const u32x2* yr = (const u32x2*)(YE + ((size_t)t * 4 + k) * D) + lane;
#pragma unroll
            for (int j = 0; j < 4; ++j) { const u32x2 w = yr[64 * j]; v[j].x += bflo(w.x); v[j].y += bfhi(w.x); v[j].z += bflo(w.y); v[j].w += bfhi(w.y); } }
#pragma unroll
        for (int j = 0; j < 4; ++j) s += (v[j].x * v[j].x + v[j].y * v[j].y) + (v[j].z * v[j].z + v[j].w * v[j].w);
        const float rstd = 1.0f / sqrtf(wave_sum(s) * (1.0f / D) + EPS);
        f32x4* o = (f32x4*)(A.out + (size_t)t * D) + lane;
#pragma unroll
        for (int j = 0; j < 4; ++j) o[64 * j] = v[j] * rstd * wf[j];
    }
}

__device__ __forceinline__ void moe_tables(const Args& A, LAS unsigned char* lds, int tid) {
    LAS int* tst = (LAS int*)(lds + MOE_OFF); LAS int* cnt = tst + 40;
    const unsigned* CNT = (const unsigned*)(A.ws + WS_CTL) + CW_CNT;
    if (tid < 32) cnt[tid] = (int)__hip_atomic_load(CNT + tid, __ATOMIC_RELAXED, __HIP_MEMORY_SCOPE_AGENT);
    LDS_WAIT(); __syncthreads();
    if (tid == 0) { int s = 0; for (int e = 0; e < NE; ++e) { tst[e] = s; s += (cnt[e] + 255) >> 8; } tst[NE] = s; }
    LDS_WAIT(); __syncthreads();
}

__device__ __forceinline__ void d_conv_branch(const bf16* __restrict__ PROJ, const float* __restrict__ cw, bf16* __restrict__ Y, int m, int lane) {
    const int b = m / SEQ, s = m % SEQ, l = s + NMETA;
    const int r0 = row_of(b, l), r1 = row_of(b, l - 1), r2 = row_of(b, l - 2);
#pragma unroll
    for (int j = 0; j < 4; ++j) {
        const int c = 256 * j + 4 * lane;
        const u32x2 cb = *(const u32x2*)(PROJ + (size_t)r0 * NPROJ + C_CB + c);
        const u32x2 c0 = *(const u32x2*)(PROJ + (size_t)r0 * NPROJ + C_CC + c), x0 = *(const u32x2*)(PROJ + (size_t)r0 * NPROJ + C_CX + c);
        const u32x2 c1 = *(const u32x2*)(PROJ + (size_t)r1 * NPROJ + C_CC + c), x1 = *(const u32x2*)(PROJ + (size_t)r1 * NPROJ + C_CX + c);
        const u32x2 c2 = *(const u32x2*)(PROJ + (size_t)r2 * NPROJ + C_CC + c), x2 = *(const u32x2*)(PROJ + (size_t)r2 * NPROJ + C_CX + c);
        const f32x4 w0 = *(const f32x4*)(cw + c), w1 = *(const f32x4*)(cw + 1024 + c), w2 = *(const f32x4*)(cw + 2048 + c);
        float y[4];
        y[0] = bflo(cb.x) * (w0.x * bflo(c2.x) * bflo(x2.x) + w1.x * bflo(c1.x) * bflo(x1.x) + w2.x * bflo(c0.x) * bflo(x0.x));
        y[1] = bfhi(cb.x) * (w0.y * bfhi(c2.x) * bfhi(x2.x) + w1.y * bfhi(c1.x) * bfhi(x1.x) + w2.y * bfhi(c0.x) * bfhi(x0.x));
        y[2] = bflo(cb.y) * (w0.z * bflo(c2.y) * bflo(x2.y) + w1.z * bflo(c1.y) * bflo(x1.y) + w2.z * bflo(c0.y) * bflo(x0.y));
        y[3] = bfhi(cb.y) * (w0.w * bfhi(c2.y) * bfhi(x2.y) + w1.w * bfhi(c1.y) * bfhi(x1.y) + w2.w * bfhi(c0.y) * bfhi(x0.y));
        float ss = (y[0] * y[0] + y[1] * y[1]) + (y[2] * y[2] + y[3] * y[3]);
#pragma unroll
        for (int o = 1; o < 32; o <<= 1) ss += __shfl_xor(ss, o);
        const float rstd = 1.0f / sqrtf(ss * (1.0f / 128.0f) + EPS);
        u32x2 w; w.x = pk2(y[0] * rstd, y[1] * rstd); w.y = pk2(y[2] * rstd, y[3] * rstd);
        *(u32x2*)(Y + (size_t)m * DMIX + c) = w;
    }
}
__device__ __forceinline__ void d_xbc_act(const bf16* __restrict__ PROJ, const float* __restrict__ cw, const float* __restrict__ cb, bf16* __restrict__ XBCA, int m, int lane) {
    if (m >= MROW + NMETA) return;
    int b, l; if (m < TR) { b = m / SEQ; l = (m % SEQ) + NMETA; } else { b = 0; l = m - MROW; }
    int rk[4];
#pragma unroll
    for (int k = 0; k < 4; ++k) { const int lk = l - 3 + k; rk[k] = lk >= 0 ? row_of(b, lk) : -1; }
#pragma unroll
    for (int j = 0; j < 8; ++j) {
        const int c = 256 * j + 4 * lane;
        f32x4 a = *(const f32x4*)(cb + c);
#pragma unroll
        for (int k = 0; k < 4; ++k) if (rk[k] >= 0) { const u32x2 u = *(const u32x2*)(PROJ + (size_t)rk[k] * NPROJ + C_XS + c); const f32x4 w = *(const f32x4*)(cw + k * 2048 + c);
            a.x += w.x * bflo(u.x); a.y += w.y * bfhi(u.x); a.z += w.z * bflo(u.y); a.w += w.w * bfhi(u.y); }
        u32x2 o; o.x = pk2(silu_f(a.x), silu_f(a.y)); o.y = pk2(silu_f(a.z), silu_f(a.w));
        *(u32x2*)(XBCA + (size_t)m * 2048 + c) = o;
    }
}
__device__ __forceinline__ void d_ssd_naive(const bf16* __restrict__ XBCA, const bf16* __restrict__ PROJ, const float* __restrict__ DT, const float* __restrict__ dt_bias,
                                                   const float* __restrict__ a_log, const float* __restrict__ dpar, bf16* __restrict__ YPRE, int item, int p) {
    const int b = item >> 4, h = item & 15, g = h >> 2;
    const float Aneg = -__expf(a_log[h]), dtb = dt_bias[h], Dh = dpar[h];
    float S[128];
#pragma unroll
    for (int n = 0; n < 128; ++n) S[n] = 0.f;
    int row = row_of(b, 0);
    float n_draw = DT[(size_t)row * 16 + h]; unsigned short n_x = XBCA[(size_t)row * 2048 + h * 64 + p];
    unsigned n_bw = *(const unsigned*)(XBCA + (size_t)row * 2048 + 1024 + g * 128 + 2 * p), n_cw = *(const unsigned*)(XBCA + (size_t)row * 2048 + 1536 + g * 128 + 2 * p);
    unsigned short n_z = PROJ[(size_t)row * NPROJ + C_Z + h * 64 + p];
    for (int l = 0; l < LSEQ; ++l) {
        const int crow = row; const float draw = n_draw + dtb; const float xv = bf2f(n_x); const unsigned bw = n_bw, cw = n_cw; const float z = bf2f(n_z);
        if (l + 1 < LSEQ) { row = row_of(b, l + 1);
            n_draw = DT[(size_t)row * 16 + h]; n_x = XBCA[(size_t)row * 2048 + h * 64 + p];
            n_bw = *(const unsigned*)(XBCA + (size_t)row * 2048 + 1024 + g * 128 + 2 * p); n_cw = *(const unsigned*)(XBCA + (size_t)row * 2048 + 1536 + g * 128 + 2 * p);
            n_z = PROJ[(size_t)row * NPROJ + C_Z + h * 64 + p]; }
        const float dtv = draw > 20.f ? draw : log1pf(__expf(draw));
        const float dec = __expf(dtv * Aneg), xdt = xv * dtv;
        float y = 0.f;
#pragma unroll
        for (int n = 0; n < 128; n += 2) {
            const unsigned bb = (unsigned)__builtin_amdgcn_readlane((int)bw, n >> 1), cc = (unsigned)__builtin_amdgcn_readlane((int)cw, n >> 1);
            S[n] = S[n] * dec + xdt * bflo(bb); y += S[n] * bflo(cc);
            S[n + 1] = S[n + 1] * dec + xdt * bfhi(bb); y += S[n + 1] * bfhi(cc);
        }
        if (l >= NMETA) { const float yg = (y + Dh * xv) * silu_f(z); YPRE[(size_t)crow * 1024 + h * 64 + p] = (bf16)f2bf(yg); }
    }
}
__device__ __forceinline__ void d_ssd_norm(const bf16* __restrict__ YPRE, bf16* __restrict__ Y, int m, int lane) {
#pragma unroll
    for (int j = 0; j < 4; ++j) {
        const int c = 256 * j + 4 * lane;
        const u32x2 u = *(const u32x2*)(YPRE + (size_t)m * 1024 + c);
        const float y0 = bflo(u.x), y1 = bfhi(u.x), y2 = bflo(u.y), y3 = bfhi(u.y);
        const float ss = wave_sum((y0 * y0 + y1 * y1) + (y2 * y2 + y3 * y3));
        const float rstd = 1.0f / sqrtf(ss * (1.0f / 256.0f) + EPS);
        u32x2 w; w.x = pk2(y0 * rstd, y1 * rstd); w.y = pk2(y2 * rstd, y3 * rstd);
        *(u32x2*)(Y + (size_t)m * DMIX + 1024 + c) = w;
    }
}

__device__ __forceinline__ void unpack8(const u32x4 r, float (&f)[8]) { f[0] = bflo(r.x); f[1] = bfhi(r.x); f[2] = bflo(r.y); f[3] = bfhi(r.y); f[4] = bflo(r.z); f[5] = bfhi(r.z); f[6] = bflo(r.w); f[7] = bfhi(r.w); }
__device__ __forceinline__ void mixa_xbc(const bf16* __restrict__ PROJ, const float* __restrict__ cw, const float* __restrict__ cbias, bf16* __restrict__ XBCA, int b, int l0, int nrows, int strip, int lane) {
    const int c0 = strip * 512 + lane * 8;
    float w[4][8], bs[8];
#pragma unroll
    for (int k = 0; k < 4; ++k) { const f32x4 a = *(const f32x4*)(cw + k * 2048 + c0), bb = *(const f32x4*)(cw + k * 2048 + c0 + 4); w[k][0] = a.x; w[k][1] = a.y; w[k][2] = a.z; w[k][3] = a.w; w[k][4] = bb.x; w[k][5] = bb.y; w[k][6] = bb.z; w[k][7] = bb.w; }
    { const f32x4 a = *(const f32x4*)(cbias + c0), bb = *(const f32x4*)(cbias + c0 + 4); bs[0] = a.x; bs[1] = a.y; bs[2] = a.z; bs[3] = a.w; bs[4] = bb.x; bs[5] = bb.y; bs[6] = bb.z; bs[7] = bb.w; }
    float p1[8], p2[8], p3[8];
    { u32x4 h1 = (u32x4){0u, 0u, 0u, 0u}, h2 = h1, h3 = h1;
      if (l0 - 1 >= 0) h1 = *(const u32x4*)(PROJ + (size_t)row_of(b, l0 - 1) * NPROJ + C_XS + c0);
      if (l0 - 2 >= 0) h2 = *(const u32x4*)(PROJ + (size_t)row_of(b, l0 - 2) * NPROJ + C_XS + c0);
      if (l0 - 3 >= 0) h3 = *(const u32x4*)(PROJ + (size_t)row_of(b, l0 - 3) * NPROJ + C_XS + c0);
      unpack8(h1, p1); unpack8(h2, p2); unpack8(h3, p3); }
    for (int r0 = 0; r0 < nrows; r0 += 8) {
        u32x4 raw[8];
#pragma unroll
        for (int i = 0; i < 8; ++i) raw[i] = *(const u32x4*)(PROJ + (size_t)row_of(b, l0 + r0 + i) * NPROJ + C_XS + c0);
#pragma unroll
        for (int i = 0; i < 8; ++i) { float cur[8], o[8]; unpack8(raw[i], cur);
#pragma unroll
            for (int j = 0; j < 8; ++j) { const float a = bs[j] + w[3][j] * cur[j] + w[2][j] * p1[j] + w[1][j] * p2[j] + w[0][j] * p3[j]; o[j] = silu_f(a); p3[j] = p2[j]; p2[j] = p1[j]; p1[j] = cur[j]; }
            u32x4 ov; ov.x = pk2(o[0], o[1]); ov.y = pk2(o[2], o[3]); ov.z = pk2(o[4], o[5]); ov.w = pk2(o[6], o[7]);
            *(u32x4*)(XBCA + (size_t)row_of(b, l0 + r0 + i) * 2048 + c0) = ov; }
    }
}
__device__ __forceinline__ void mixa_conv(const bf16* __restrict__ PROJ, const float* __restrict__ cw, bf16* __restrict__ Y, int b, int s0, int strip, int lane) {
    const int c0 = strip * 512 + lane * 8;
    float w[3][8];
#pragma unroll
    for (int k = 0; k < 3; ++k) { const f32x4 a = *(const f32x4*)(cw + k * 1024 + c0), bb = *(const f32x4*)(cw + k * 1024 + c0 + 4); w[k][0] = a.x; w[k][1] = a.y; w[k][2] = a.z; w[k][3] = a.w; w[k][4] = bb.x; w[k][5] = bb.y; w[k][6] = bb.z; w[k][7] = bb.w; }
    float u1[8], u2[8];
    { const size_t r1 = (size_t)row_of(b, s0 + NMETA - 1) * NPROJ, r2 = (size_t)row_of(b, s0 + NMETA - 2) * NPROJ; float a[8], c[8];
      unpack8(*(const u32x4*)(PROJ + r1 + C_CC + c0), a); unpack8(*(const u32x4*)(PROJ + r1 + C_CX + c0), c);
#pragma unroll
      for (int j = 0; j < 8; ++j) u1[j] = a[j] * c[j];
      unpack8(*(const u32x4*)(PROJ + r2 + C_CC + c0), a); unpack8(*(const u32x4*)(PROJ + r2 + C_CX + c0), c);
#pragma unroll
      for (int j = 0; j < 8; ++j) u2[j] = a[j] * c[j]; }
    for (int r0 = 0; r0 < 32; r0 += 4) {
        u32x4 rb[4], rc[4], rx[4];
#pragma unroll
        for (int i = 0; i < 4; ++i) { const size_t ro = (size_t)(b * SEQ + s0 + r0 + i) * NPROJ + c0; rb[i] = *(const u32x4*)(PROJ + ro + C_CB); rc[i] = *(const u32x4*)(PROJ + ro + C_CC); rx[i] = *(const u32x4*)(PROJ + ro + C_CX); }
#pragma unroll
        for (int i = 0; i < 4; ++i) { float cb[8], cc[8], cx[8], y[8]; unpack8(rb[i], cb); unpack8(rc[i], cc); unpack8(rx[i], cx); float ss = 0.f;
#pragma unroll
            for (int j = 0; j < 8; ++j) { const float u = cc[j] * cx[j]; y[j] = cb[j] * (w[2][j] * u + w[1][j] * u1[j] + w[0][j] * u2[j]); ss += y[j] * y[j]; u2[j] = u1[j]; u1[j] = u; }
            ss += __shfl_xor(ss, 1); ss += __shfl_xor(ss, 2); ss += __shfl_xor(ss, 4); ss += __shfl_xor(ss, 8);
            const float rstd = 1.0f / sqrtf(ss * (1.0f / 128.0f) + EPS);
            u32x4 ov; ov.x = pk2(y[0] * rstd, y[1] * rstd); ov.y = pk2(y[2] * rstd, y[3] * rstd); ov.z = pk2(y[4] * rstd, y[5] * rstd); ov.w = pk2(y[6] * rstd, y[7] * rstd);
            *(u32x4*)(Y + (size_t)(b * SEQ + s0 + r0 + i) * DMIX + c0) = ov; }
    }
}

namespace ssd {
constexpr int XP = 144, BP = 272;
constexpr int O_XDT = 0, O_XW = 18432, O_B = 36864, O_C = 71680, O_S = 106496, O_TAB = 123904;
constexpr int NCH = 17;
template <int STEP, int PITCH> __device__ __forceinline__ void tr4(unsigned a, bf16x8 (&f)[4]) {
    u32x2 r0, r1, r2, r3, r4, r5, r6, r7;
    asm volatile("ds_read_b64_tr_b16 %0, %8 offset:%9\n\tds_read_b64_tr_b16 %1, %8 offset:%10\n\tds_read_b64_tr_b16 %2, %8 offset:%11\n\tds_read_b64_tr_b16 %3, %8 offset:%12\n\t"
                 "ds_read_b64_tr_b16 %4, %8 offset:%13\n\tds_read_b64_tr_b16 %5, %8 offset:%14\n\tds_read_b64_tr_b16 %6, %8 offset:%15\n\tds_read_b64_tr_b16 %7, %8 offset:%16\n\ts_waitcnt lgkmcnt(0)"
                 : "=&v"(r0), "=&v"(r1), "=&v"(r2), "=&v"(r3), "=&v"(r4), "=&v"(r5), "=&v"(r6), "=&v"(r7)
                 : "v"(a), "i"(0 * STEP), "i"(0 * STEP + 4 * PITCH), "i"(1 * STEP), "i"(1 * STEP + 4 * PITCH), "i"(2 * STEP), "i"(2 * STEP + 4 * PITCH), "i"(3 * STEP), "i"(3 * STEP + 4 * PITCH) : "memory");
    u32x4 w;
    w.x = r0.x; w.y = r0.y; w.z = r1.x; w.w = r1.y; f[0] = __builtin_bit_cast(bf16x8, w);
    w.x = r2.x; w.y = r2.y; w.z = r3.x; w.w = r3.y; f[1] = __builtin_bit_cast(bf16x8, w);
    w.x = r4.x; w.y = r4.y; w.z = r5.x; w.w = r5.y; f[2] = __builtin_bit_cast(bf16x8, w);
    w.x = r6.x; w.y = r6.y; w.z = r7.x; w.w = r7.y; f[3] = __builtin_bit_cast(bf16x8, w);
}
#define SSD_MFMA(a, b, c) __builtin_amdgcn_mfma_f32_16x16x32_bf16((a), (b), (c), 0, 0, 0)
__device__ __forceinline__ int grow_of(int b, int c, int r) { return c > 0 ? b * SEQ + 128 * (c - 1) + r : (r >= 112 ? MROW + r - 112 : MROW); }

__device__ __forceinline__ void chain(const Args& A, LAS unsigned char* lds, int item, int tid, int lane, int wave) {
    const int b = item >> 4, h = item & 15, g = h >> 2, fr = lane & 15, fq = lane >> 4;
    const bf16* XB = (const bf16*)(A.ws + WS_XBCA); const bf16* PROJ = (const bf16*)(A.ws + WS_PROJ); const float* DT = (const float*)(A.ws + WS_DT); bf16* YPRE = (bf16*)(A.ws + WS_XN);
    const float Aneg = -__expf(A.in[I_ALOG][h]), dtb = A.in[I_DTB][h], Dh = A.in[I_SD][h];
    const unsigned lbase = (unsigned)(size_t)lds;
    for (int i = tid; i < 64 * BP / 16; i += NWAVES * 64) *(LAS u32x4*)(lds + O_S + i * 16) = (u32x4){0u, 0u, 0u, 0u};
    f32x4 st[4];
#pragma unroll
    for (int t = 0; t < 4; ++t) st[t] = (f32x4){0.f, 0.f, 0.f, 0.f};
    u32x4 pfx[2], pfb[4], pfc[4]; float pdt[2];
#define SSD_LOAD(c) do { \
        _Pragma("unroll") for (int i = 0; i < 2; ++i) { const int q = tid + 512 * i, row = q >> 3, c16 = q & 7; const bool ok = (c) > 0 || row >= 112; \
            const u32x4 v = *(const u32x4*)(XB + (size_t)grow_of(b, (c), row) * 2048 + h * 64 + c16 * 8); pfx[i] = ok ? v : (u32x4){0u, 0u, 0u, 0u}; } \
        _Pragma("unroll") for (int i = 0; i < 4; ++i) { const int q = tid + 512 * i, row = q >> 4, c16 = q & 15; const bool ok = (c) > 0 || row >= 112; \
            const bf16* src = XB + (size_t)grow_of(b, (c), row) * 2048 + 1024 + g * 128 + c16 * 8; \
            const u32x4 vb = *(const u32x4*)src, vc = *(const u32x4*)(src + 512); pfb[i] = ok ? vb : (u32x4){0u, 0u, 0u, 0u}; pfc[i] = ok ? vc : (u32x4){0u, 0u, 0u, 0u}; } \
        _Pragma("unroll") for (int i = 0; i < 2; ++i) { const int row = 2 * lane + i; const bool ok = (c) > 0 || row >= 112; const float v = DT[(size_t)grow_of(b, (c), row) * 16 + h]; pdt[i] = ok ? v : -1.0e30f; } \
    } while (0)
#define SSD_TABLES(buf) do { \
        float d0 = pdt[0] + dtb, d1 = pdt[1] + dtb; d0 = d0 > 20.f ? d0 : log1pf(__expf(d0)); d1 = d1 > 20.f ? d1 : log1pf(__expf(d1)); \
        if (pdt[0] < -1.0e29f) d0 = 0.f; if (pdt[1] < -1.0e29f) d1 = 0.f; \
        const float a0 = d0 * Aneg, a1 = d1 * Aneg; float incl = a0 + a1; \
        _Pragma("unroll") for (int o = 1; o < 64; o <<= 1) { const float t = __shfl_up(incl, o); incl += (lane >= o) ? t : 0.f; } \
        const float c1 = incl, c0 = incl - a1; const float aend = __shfl(incl, 63); \
        if (wave == 0) { LAS float* tb = (LAS float*)(lds + O_TAB + (buf) * 2048); \
            *(LAS f32x2*)(tb + 2 * lane) = (f32x2){c0, c1}; *(LAS f32x2*)(tb + 128 + 2 * lane) = (f32x2){d0, d1}; \
            *(LAS f32x2*)(tb + 256 + 2 * lane) = (f32x2){__expf(aend - c0), __expf(aend - c1)}; *(LAS f32x2*)(tb + 384 + 2 * lane) = (f32x2){__expf(c0), __expf(c1)}; } \
    } while (0)
    SSD_LOAD(0);
    SSD_TABLES(0);
    LDS_WAIT(); __syncthreads();
    for (int c = 0; c < NCH; ++c) {
        const LAS float* tb = (const LAS float*)(lds + O_TAB + (c & 1) * 2048);
#pragma unroll
        for (int i = 0; i < 2; ++i) { const int q = tid + 512 * i, row = q >> 3, c16 = q & 7; const float dv = tb[128 + row], wv = dv * tb[256 + row];
            const u32x4 v = pfx[i]; u32x4 a, w;
            a.x = pk2(bflo(v.x) * dv, bfhi(v.x) * dv); a.y = pk2(bflo(v.y) * dv, bfhi(v.y) * dv); a.z = pk2(bflo(v.z) * dv, bfhi(v.z) * dv); a.w = pk2(bflo(v.w) * dv, bfhi(v.w) * dv);
            w.x = pk2(bflo(v.x) * wv, bfhi(v.x) * wv); w.y = pk2(bflo(v.y) * wv, bfhi(v.y) * wv); w.z = pk2(bflo(v.z) * wv, bfhi(v.z) * wv); w.w = pk2(bflo(v.w) * wv, bfhi(v.w) * wv);
            *(LAS u32x4*)(lds + O_XDT + row * XP + c16 * 16) = a; *(LAS u32x4*)(lds + O_XW + row * XP + c16 * 16) = w; }
#pragma unroll
        for (int i = 0; i < 4; ++i) { const int q = tid + 512 * i, row = q >> 4, c16 = q & 15;
            *(LAS u32x4*)(lds + O_B + row * BP + c16 * 16) = pfb[i]; *(LAS u32x4*)(lds + O_C + row * BP + c16 * 16) = pfc[i]; }
        if (c + 1 < NCH) SSD_LOAD(c + 1);
        LDS_WAIT(); __syncthreads();
        const int lrow = 16 * wave + fr;
        bf16x8 Cf[4];
#pragma unroll
        for (int ks = 0; ks < 4; ++ks) Cf[ks] = *(const LAS bf16x8*)(lds + O_C + lrow * BP + ks * 64 + fq * 16);
        f32x4 cb[8];
#pragma unroll
        for (int nt = 0; nt < 8; ++nt) { cb[nt] = (f32x4){0.f, 0.f, 0.f, 0.f};
#pragma unroll
            for (int ks = 0; ks < 4; ++ks) { const bf16x8 Bf = *(const LAS bf16x8*)(lds + O_B + (16 * nt + fr) * BP + ks * 64 + fq * 16); cb[nt] = SSD_MFMA(Bf, Cf[ks], cb[nt]); }
            __builtin_amdgcn_sched_barrier(0); }
        f32x4 y[4];
#pragma unroll
        for (int pt = 0; pt < 4; ++pt) { y[pt] = (f32x4){0.f, 0.f, 0.f, 0.f};
#pragma unroll
            for (int ks = 0; ks < 4; ++ks) { const bf16x8 Sf = *(const LAS bf16x8*)(lds + O_S + (16 * pt + fr) * BP + ks * 64 + fq * 16); y[pt] = SSD_MFMA(Sf, Cf[ks], y[pt]); }
            if (pt & 1) __builtin_amdgcn_sched_barrier(0); }
        u32x2 ex[4], ez[4];
        { const int gr = grow_of(b, c, 16 * wave + fr);
#pragma unroll
          for (int pt = 0; pt < 4; ++pt) { ex[pt] = *(const u32x2*)(XB + (size_t)gr * 2048 + h * 64 + 16 * pt + 4 * fq); ez[pt] = *(const u32x2*)(PROJ + (size_t)gr * NPROJ + C_Z + h * 64 + 16 * pt + 4 * fq); } }
        { const float al = tb[lrow];
#pragma unroll
          for (int nt = 0; nt < 8; ++nt) { const int s0 = 16 * nt + 4 * fq; const f32x4 as4 = *(const LAS f32x4*)(tb + s0); float m[4];
#pragma unroll
              for (int j = 0; j < 4; ++j) m[j] = (s0 + j <= lrow) ? cb[nt][j] * __expf(al - as4[j]) : 0.f;
              u32x2 w; w.x = pk2(m[0], m[1]); w.y = pk2(m[2], m[3]); *(LAS u32x2*)(lds + O_C + lrow * BP + s0 * 2) = w; } }
        { const float el = tb[384 + lrow];
#pragma unroll
          for (int pt = 0; pt < 4; ++pt) y[pt] = y[pt] * el; }
        bf16x8 Mf[4];
#pragma unroll
        for (int ks = 0; ks < 4; ++ks) Mf[ks] = *(const LAS bf16x8*)(lds + O_C + lrow * BP + ks * 64 + fq * 16);
        const unsigned tra = (unsigned)((8 * fq + ((lane & 15) >> 2)) * XP + 8 * (lane & 3));
        const unsigned trb = (unsigned)((8 * fq + ((lane & 15) >> 2)) * BP + 8 * (lane & 3));
#pragma unroll
        for (int pt = 0; pt < 4; ++pt) { bf16x8 Xf[4]; tr4<32 * XP, XP>(lbase + O_XDT + tra + 32 * pt, Xf);
#pragma unroll
            for (int ks = 0; ks < 4; ++ks) y[pt] = SSD_MFMA(Xf[ks], Mf[ks], y[pt]); }
        if (c > 0) { const size_t orow = (size_t)(b * SEQ + 128 * (c - 1) + lrow) * 1024 + h * 64 + 4 * fq;
#pragma unroll
            for (int pt = 0; pt < 4; ++pt) { const f32x4 v = y[pt]; const u32x2 xv = ex[pt], zv = ez[pt];
                const float o0 = (v[0] + Dh * bflo(xv.x)) * silu_f(bflo(zv.x)), o1 = (v[1] + Dh * bfhi(xv.x)) * silu_f(bfhi(zv.x));
                const float o2 = (v[2] + Dh * bflo(xv.y)) * silu_f(bflo(zv.y)), o3 = (v[3] + Dh * bfhi(xv.y)) * silu_f(bfhi(zv.y));
                u32x2 w; w.x = pk2(o0, o1); w.y = pk2(o2, o3); *(u32x2*)(YPRE + orow + 16 * pt) = w; } }
        __syncthreads();
        { const int pt4 = wave & 3, nt0 = 4 * (wave >> 2); const float dec = __expf(tb[127]);
          bf16x8 Xw[4]; tr4<32 * XP, XP>(lbase + O_XW + tra + 32 * pt4, Xw);
#pragma unroll
          for (int t = 0; t < 4; ++t) { bf16x8 Bf[4]; tr4<32 * BP, BP>(lbase + O_B + trb + 32 * (nt0 + t), Bf); st[t] = st[t] * dec;
#pragma unroll
              for (int ks = 0; ks < 4; ++ks) st[t] = SSD_MFMA(Bf[ks], Xw[ks], st[t]);
              u32x2 w; w.x = pk2(st[t][0], st[t][1]); w.y = pk2(st[t][2], st[t][3]);
              *(LAS u32x2*)(lds + O_S + (16 * pt4 + fr) * BP + (16 * (nt0 + t) + 4 * fq) * 2) = w; } }
        if (c + 1 < NCH) SSD_TABLES((c + 1) & 1);
        LDS_WAIT(); __syncthreads();
    }
#undef SSD_LOAD
#undef SSD_TABLES
}
}

enum { PH_PREP = 0, PH_INPROJ, PH_MIXA, PH_MIXB, PH_MIXC, PH_OUTPROJ, PH_ROUTER, PH_GU, PH_DOWN, PH_FINAL, PH_N };
__global__ void __launch_bounds__(NWAVES * 64, 2) mk_fwd(Args args) {
    extern __shared__ __attribute__((aligned(16))) unsigned char lds_raw[];
    LAS unsigned char* lds = (LAS unsigned char*)lds_raw;
    const int tid = threadIdx.x, lane = tid & 63, wave = __builtin_amdgcn_readfirstlane(tid >> 6);
    const int G = gridDim.x; const int bx = blockIdx.x; const int vcu = (G % 8 == 0) ? (bx % 8) * (G / 8) + bx / 8 : bx;
    unsigned char* ws = args.ws;
    for (int u = tid; u < (LDS_BYTES - LDSCTL_OFF) / 4; u += NWAVES * 64) ((LAS unsigned*)(lds + LDSCTL_OFF))[u] = 0u;
    __syncthreads();
    const int lo = args.ph_lo, hi = args.ph_hi;
    const bool multi = (hi - lo) > 1;
    XcdBarrier bar; bar.bar = (unsigned*)(ws + WS_CTL) + CW_BAR; bar.x = 0; bar.st = nullptr;
    if (multi) bar = xcd_barrier_post((unsigned*)(ws + WS_CTL) + CW_BAR, (volatile LAS unsigned*)(lds + MISC_OFF) + 8);
#ifndef PHASE_MASK
#define PHASE_MASK 0xffff
#endif
#ifndef REPEAT_MASK
#define REPEAT_MASK 0
#endif
#define IN(k) (((PHASE_MASK >> (k)) & 1) && lo <= (k) && (k) < hi)
#define REP(k) for (int _rep = 0; _rep < (((REPEAT_MASK >> (k)) & 1) ? 2 : 1); ++_rep)
#define SEAM(k) do { if (IN(k) && IN((k) + 1)) xcd_barrier(bar); } while (0)

    if (IN(PH_PREP)) REP(PH_PREP) { p0_prologue(args, lds, vcu, G, tid, lane, wave); __syncthreads(); SEAM(PH_PREP); }

    if (IN(PH_INPROJ)) REP(PH_INPROJ) {
        pg8::DenseSched S; S.init(TA, NPROJ, 1024, ws + WS_WIN, G, bx);
        pg8::EpiProj E{(bf16*)(ws + WS_PROJ), NPROJ};
        pg8::gemm_phase<pg8::EpiProj, pg8::DenseSched, true, true>(lds + RING_OFF, (const char*)(ws + WS_XN), 1024, S, E);
        SEAM(PH_INPROJ);
    }
    if (IN(PH_MIXA)) REP(PH_MIXA) {
        const int gw = vcu * NWAVES + wave, NGW = G * NWAVES;
        for (int it = gw; it < 2048 + 4; it += NGW) {
            if (it < 2048) mixa_xbc((const bf16*)(ws + WS_PROJ), args.in[I_SCW], args.in[I_SCB], (bf16*)(ws + WS_XBCA), it >> 7, NMETA + ((it >> 2) & 31) * 64, 64, it & 3, lane);
            else mixa_xbc((const bf16*)(ws + WS_PROJ), args.in[I_SCW], args.in[I_SCB], (bf16*)(ws + WS_XBCA), 0, 0, 16, it & 3, lane);
        }
        for (int it = gw; it < 2048; it += NGW) mixa_conv((const bf16*)(ws + WS_PROJ), args.in[I_CSW], (bf16*)(ws + WS_Y), it >> 7, ((it >> 1) & 63) * 32, it & 1, lane);
        SEAM(PH_MIXA);
    }
    if (IN(PH_MIXB)) REP(PH_MIXB) {
#ifdef SSD_NAIVE
        for (int item = bx; item < BATCH * NH; item += G) if (wave == 0) d_ssd_naive((const bf16*)(ws + WS_XBCA), (const bf16*)(ws + WS_PROJ), (const float*)(ws + WS_DT), args.in[I_DTB], args.in[I_ALOG], args.in[I_SD], (bf16*)(ws + WS_XN), item, lane);
#else
        for (int item = vcu; item < BATCH * NH; item += G) ssd::chain(args, lds, item, tid, lane, wave);
#endif
        SEAM(PH_MIXB);
    }
    if (IN(PH_MIXC)) REP(PH_MIXC) {
        const int gw = vcu * NWAVES + wave, NGW = G * NWAVES;
        for (int m = gw; m < TR; m += NGW) d_ssd_norm((const bf16*)(ws + WS_XN), (bf16*)(ws + WS_Y), m, lane);
        SEAM(PH_MIXC);
    }
    if (IN(PH_OUTPROJ)) REP(PH_OUTPROJ) {
        pg8::DenseSched S; S.init(TR, 1024, 2048, ws + WS_WOUT, G, bx);
        pg8::EpiH1 E{args.in[I_X], (float*)(ws + WS_H1), 1024};
        pg8::gemm_phase<pg8::EpiH1, pg8::DenseSched, true, true>(lds + RING_OFF, (const char*)(ws + WS_Y), 2048, S, E);
        SEAM(PH_OUTPROJ);
    }
    if (IN(PH_ROUTER)) { p4_router(args, lds, vcu, G, tid, lane, wave); SEAM(PH_ROUTER); }
    if (IN(PH_GU)) REP(PH_GU) {
        moe_tables(args, lds, tid);
        pg8::MoeSched<true> S; S.tst = (const LAS int*)(lds + MOE_OFF); S.cnt = S.tst + 40; S.G = G; S.c = bx; S.NP = 8; S.K = 1024; S.list = (const int*)(ws + WS_LIST);
        S.Bt = (const char*)(ws + WS_WGU); S.estride = (size_t)2048 * 1024 * 2;
        pg8::EpiSwiGLU E{(bf16*)(ws + WS_ACT), args.in[I_BGU]};
        pg8::gemm_phase<pg8::EpiSwiGLU, pg8::MoeSched<true>, true, true>(lds + RING_OFF, (const char*)(ws + WS_XN), 1024, S, E);
        SEAM(PH_GU);
    }
    if (IN(PH_DOWN)) REP(PH_DOWN) {
        moe_tables(args, lds, tid);
        pg8::MoeSched<false> S; S.tst = (const LAS int*)(lds + MOE_OFF); S.cnt = S.tst + 40; S.G = G; S.c = bx; S.NP = 4; S.K = 1024; S.list = (const int*)(ws + WS_LIST);
        S.Bt = (const char*)(ws + WS_WDN); S.estride = (size_t)1024 * 1024 * 2;
        pg8::EpiDown E{(bf16*)(ws + WS_YE), args.in[I_BDN], (const int*)(ws + WS_LIST), (const float*)(ws + WS_GATE)};
        pg8::gemm_phase<pg8::EpiDown, pg8::MoeSched<false>, true, true>(lds + RING_OFF, (const char*)(ws + WS_ACT), 1024, S, E);
        SEAM(PH_DOWN);
    }
    if (IN(PH_FINAL)) REP(PH_FINAL) { p7_final(args, vcu, G, lane, wave); }
#undef IN
#undef SEAM
}

extern "C" void kernel_launch(void* const* d_in, const int* in_sizes, int n_in, void* d_out, int out_size, void* d_ws, size_t ws_size, hipStream_t stream) {
    static int grid = 0;
    if (grid == 0) {
        if (n_in != 21 || in_sizes[0] != TR * D || out_size != TR * D || ws_size < WS_END) { fprintf(stderr, "kernel_launch: unexpected problem shape (n_in %d, in0 %d, out %d, ws %zu)\n", n_in, n_in > 0 ? in_sizes[0] : -1, out_size, ws_size); grid = -1; return; }
        int dev = 0, cus = 0, per_cu = 0;
        if (hipGetDevice(&dev) != hipSuccess || hipDeviceGetAttribute(&cus, hipDeviceAttributeMultiprocessorCount, dev) != hipSuccess) { grid = -1; return; }
        if (hipFuncSetAttribute((const void*)mk_fwd, hipFuncAttributeMaxDynamicSharedMemorySize, LDS_BYTES) != hipSuccess) { fprintf(stderr, "kernel_launch: hipFuncSetAttribute failed\n"); grid = -1; return; }
        if (hipOccupancyMaxActiveBlocksPerMultiprocessor(&per_cu, (const void*)mk_fwd, NWAVES * 64, LDS_BYTES) != hipSuccess || per_cu < 1) { fprintf(stderr, "kernel_launch: occupancy query says %d\n", per_cu); per_cu = 1; }
        (void)hipGetLastError();
        grid = cus;
    }
    if (grid < 0) return;
    (void)hipMemsetAsync((char*)d_ws + WS_CTL, 0, CTL_ZERO_BYTES, stream);
    Args a{};
    for (int i = 0; i < 21; ++i) a.in[i] = (const float*)d_in[i];
    a.out = (float*)d_out; a.ws = (unsigned char*)d_ws;
    unsigned char* ws = (unsigned char*)d_ws;
    auto launch = [&](int lo, int hi) { a.ph_lo = lo; a.ph_hi = hi; hipLaunchKernelGGL(mk_fwd, dim3(grid), dim3(NWAVES * 64), LDS_BYTES, stream, a); };
    launch(0, PH_N);
}
```

```cpp
#include <hip/hip_runtime.h>
#include <cstdio>
#include <cstdint>

#define LAS __attribute__((address_space(3)))
#define GAS __attribute__((address_space(1)))
typedef unsigned short bf16;
typedef short bf16x8 __attribute__((ext_vector_type(8)));
typedef float f32x4 __attribute__((ext_vector_type(4)));
typedef float f32x2 __attribute__((ext_vector_type(2)));
typedef unsigned u32x4 __attribute__((ext_vector_type(4)));
typedef unsigned u32x2 __attribute__((ext_vector_type(2)));
typedef GAS unsigned gu32;

constexpr int BATCH = 16, SEQ = 2048, D = 1024, NMETA = 16, LSEQ = SEQ + NMETA;
constexpr int TR = BATCH * SEQ;
constexpr int TA = 33024;
constexpr int MROW = TR;
constexpr int WIN_LD = 6160, NPROJ = 6144;
constexpr int C_CB = 0, C_CC = 1024, C_CX = 2048, C_Z = 3072, C_XS = 4096, C_BS = 5120, C_CS = 5632;
constexpr int NH = 16, HD = 64, NE = 32, DMIX = 2048;
constexpr float EPS = 1e-5f;
constexpr float SW_ALPHA = 1.702f, SW_LIMIT = 7.0f;

constexpr size_t MiB = 1u << 20;
constexpr size_t WS_CTL = 0, CTL_ZERO_BYTES = 1 * MiB;
constexpr size_t WS_LIST = 1 * MiB;
constexpr size_t WS_GATE = 5 * MiB;
constexpr size_t WS_DT = 6 * MiB;
constexpr size_t WS_WIN = 12 * MiB;
constexpr size_t WS_WOUT = 24 * MiB;
constexpr size_t WS_WGU = 28 * MiB;
constexpr size_t WS_WDN = 156 * MiB;
constexpr size_t WS_XN = 220 * MiB;
constexpr size_t WS_PROJ = 285 * MiB;
constexpr size_t WS_ACT = 285 * MiB;
constexpr size_t WS_YE = 557 * MiB;
constexpr size_t WS_Y = 672 * MiB;
constexpr size_t WS_H1 = 816 * MiB;
constexpr size_t WS_XBCA = 880 * MiB;
constexpr size_t WS_END = 1024 * MiB;
constexpr int CW_CNT = 64;
constexpr int CW_BAR = 4096;

__device__ __forceinline__ unsigned f2bf(float f) { unsigned u = __float_as_uint(f); return (u + 0x7fffu + ((u >> 16) & 1u)) >> 16; }
__device__ __forceinline__ unsigned pk2(float lo, float hi) { return f2bf(lo) | (f2bf(hi) << 16); }
__device__ __forceinline__ float bf2f(unsigned short b) { return __uint_as_float(((unsigned)b) << 16); }
__device__ __forceinline__ float bflo(unsigned w) { return __uint_as_float(w << 16); }
__device__ __forceinline__ float bfhi(unsigned w) { return __uint_as_float(w & 0xffff0000u); }
__device__ __forceinline__ unsigned cvt_pk_bf16(float lo, float hi) { unsigned r; asm volatile("v_cvt_pk_bf16_f32 %0, %1, %2" : "=v"(r) : "v"(lo), "v"(hi)); return r; }
__device__ __forceinline__ float wave_sum(float v) {
#pragma unroll
    for (int o = 1; o < 64; o <<= 1) v += __shfl_xor(v, o);
    return v;
}
__device__ __forceinline__ int row_of(int b, int l) { return l >= NMETA ? b * SEQ + (l - NMETA) : MROW + l; }
__device__ __forceinline__ float silu_f(float z) { return z / (1.0f + __expf(-z)); }
#define LDS_WAIT() asm volatile("s_waitcnt lgkmcnt(0)" ::: "memory")
#define VM_WAIT() asm volatile("s_waitcnt vmcnt(0)" ::: "memory")

namespace pg8 {
constexpr int BM = 256, BK = 64, HALF = 128, HTB = HALF * BK * 2, STAGE_BYTES = 8 * HTB, NXCD = 8, WGM = 8;
constexpr int NOFF_REL = STAGE_BYTES + 8192;
__host__ __device__ __forceinline__ int lds_byte(int r, int c) { const int st = (r >> 4) * 2 + (c >> 5), rr = r & 15, cc = c & 31, ob = rr * 64 + cc * 2; return st * 1024 + (ob ^ (((ob >> 9) & 1) << 5)); }
__host__ __device__ __forceinline__ void stage_rc(int b, int& R, int& C) { const int st = b / 1024, sb = b % 1024, swz = sb ^ (((sb >> 9) & 1) << 5); R = (st >> 1) * 16 + swz / 64; C = (st & 1) * 32 + (swz % 64) / 2; }
typedef int i32x8 __attribute__((ext_vector_type(8)));
typedef int i32x4 __attribute__((ext_vector_type(4)));
__device__ __forceinline__ i32x8 cat8(bf16x8 lo, bf16x8 hi) { const i32x4 a = __builtin_bit_cast(i32x4, lo), b = __builtin_bit_cast(i32x4, hi); return __builtin_shufflevector(a, b, 0, 1, 2, 3, 4, 5, 6, 7); }
__host__ __device__ __forceinline__ int perm32(int rho) { const int n = rho >> 4, i = rho & 15; return 8 * (i >> 2) + 4 * n + (i & 3); }

template <class Epi, class Sched, bool ALIGN_EPI, bool SP2, bool F8 = false>
__device__ __forceinline__ void gemm_phase(LAS unsigned char* lds, const char* Abase, const int K, const Sched& S, const Epi& E) {
    const int tid = threadIdx.x, wid = __builtin_amdgcn_readfirstlane(tid >> 6), lane = tid & 63, wr = wid >> 2, wc = wid & 3, fr = lane & 15, fq = lane >> 4;
    const int nt = K / BK;
    int Rr[2]; unsigned cbA[2], voffB[2];
#pragma unroll
    for (int i = 0; i < 2; ++i) { int R, C; stage_rc(tid * 16 + i * 8192, R, C); const int Rb = Epi::PERM ? ((R & ~31) + perm32(R & 31)) : R;
        Rr[i] = R; cbA[i] = (unsigned)C * 2u; voffB[i] = (unsigned)(Rb * K + C) * 2u; }
    const size_t kstep = (size_t)(BK * 2);
    const size_t hstep = (size_t)HALF * K * 2;
    const unsigned ldsw = (unsigned)wid * 1024u;
    const int aoff = lds_byte(wr * 64 + fr, fq * 8), boff = lds_byte(wc * 32 + fr, fq * 8);
#define PG8_SA(b, h) (((b) * 2 + (h)) * HTB)
#define PG8_SB(b, h) ((4 + (b) * 2 + (h)) * HTB)
#define PG8_STAGEB(bufoff, gbase) do { _Pragma("unroll") for (int _i = 0; _i < 2; ++_i) \
        __builtin_amdgcn_global_load_lds((const unsigned*)((const char*)(gbase) + voffB[_i]), (LAS unsigned*)(lds + (bufoff) + ldsw + _i * 8192), 16, 0, 0); } while (0)
#define PG8_STAGEA(bufoff, offs, kt) do { const char* _gb = Abase + (size_t)(kt) * kstep; _Pragma("unroll") for (int _i = 0; _i < 2; ++_i) \
        __builtin_amdgcn_global_load_lds((const unsigned*)(_gb + (offs)[_i]), (LAS unsigned*)(lds + (bufoff) + ldsw + _i * 8192), 16, 0, 0); } while (0)
#define PG8_LDA(dst, b, h) do { if constexpr (F8) { _Pragma("unroll") for (int m = 0; m < 4; ++m) dst##8[m] = cat8(*(const LAS bf16x8*)(lds + PG8_SA(b, h) + aoff + m * 2048), *(const LAS bf16x8*)(lds + PG8_SA(b, h) + aoff + m * 2048 + 1024)); } \
        else { _Pragma("unroll") for (int m = 0; m < 4; ++m) _Pragma("unroll") for (int k = 0; k < 2; ++k) dst[m][k] = *(const LAS bf16x8*)(lds + PG8_SA(b, h) + aoff + m * 2048 + k * 1024); } } while (0)
#define PG8_LDB(dst, b, h) do { if constexpr (F8) { _Pragma("unroll") for (int n = 0; n < 2; ++n) dst##8[n] = cat8(*(const LAS bf16x8*)(lds + PG8_SB(b, h) + boff + n * 2048), *(const LAS bf16x8*)(lds + PG8_SB(b, h) + boff + n * 2048 + 1024)); } \
        else { _Pragma("unroll") for (int n = 0; n < 2; ++n) _Pragma("unroll") for (int k = 0; k < 2; ++k) dst[n][k] = *(const LAS bf16x8*)(lds + PG8_SB(b, h) + boff + n * 2048 + k * 1024); } } while (0)
#define PG8_MMA(ai, bj, At, Bt) do { __builtin_amdgcn_s_setprio(1); \
        if constexpr (F8) { _Pragma("unroll") for (int m = 0; m < 4; ++m) _Pragma("unroll") for (int n = 0; n < 2; ++n) \
            acc[ai][bj][m][n] = __builtin_amdgcn_mfma_scale_f32_16x16x128_f8f6f4(Bt##8[n], At##8[m], acc[ai][bj][m][n], 0, 0, 0, 0, 0, 0); } \
        else { _Pragma("unroll") for (int m = 0; m < 4; ++m) _Pragma("unroll") for (int n = 0; n < 2; ++n) _Pragma("unroll") for (int k = 0; k < 2; ++k) \
            acc[ai][bj][m][n] = __builtin_amdgcn_mfma_f32_16x16x32_bf16(Bt[n][k], At[m][k], acc[ai][bj][m][n], 0, 0, 0); } \
        __builtin_amdgcn_s_setprio(0); } while (0)
#define PG8_WAIT_V(n) asm volatile("s_waitcnt vmcnt(" #n ")" ::: "memory")
#define PG8_WAIT_L(n) asm volatile("s_waitcnt lgkmcnt(" #n ")" ::: "memory")
#define PG8_BAR __builtin_amdgcn_s_barrier()
#define PG8_SCHED __builtin_amdgcn_sched_barrier(0)
    typename Sched::Unit cur, nxt; int ui = 0;
    if (!S.next(0, cur)) return;
    f32x4 acc[2][2][4][2];
#pragma unroll
    for (int a = 0; a < 2; ++a)
#pragma unroll
        for (int b = 0; b < 2; ++b)
#pragma unroll
            for (int m = 0; m < 4; ++m)
#pragma unroll
                for (int n = 0; n < 2; ++n) acc[a][b][m][n] = (f32x4){0.f, 0.f, 0.f, 0.f};
    bf16x8 At[4][2], B0[2][2], B1[2][2];
    i32x8 At8[4], B08[2], B18[2];
    unsigned coff[2][2];
    LAS u32x4* stash = (LAS u32x4*)(lds + NOFF_REL) + tid;
#pragma unroll
    for (int h = 0; h < 2; ++h)
#pragma unroll
        for (int i = 0; i < 2; ++i) coff[h][i] = S.aoff(cur, h * HALF + Rr[i]) + cbA[i];
    const char* cB = S.bptr(cur);
    if constexpr (SP2) {
        PG8_STAGEB(PG8_SB(0, 0), cB); PG8_STAGEB(PG8_SB(0, 1), cB + hstep); PG8_STAGEA(PG8_SA(0, 0), coff[0], 0); PG8_STAGEA(PG8_SA(0, 1), coff[1], 0);
        if (wr == 1) PG8_BAR;
        PG8_WAIT_V(2); PG8_BAR;
        PG8_STAGEB(PG8_SB(1, 0), cB + kstep); PG8_STAGEA(PG8_SA(1, 0), coff[0], 1); PG8_STAGEB(PG8_SB(1, 1), cB + hstep + kstep);
        PG8_WAIT_V(6); PG8_BAR;
    } else {
        PG8_STAGEB(PG8_SB(0, 0), cB); PG8_STAGEA(PG8_SA(0, 0), coff[0], 0); PG8_STAGEB(PG8_SB(0, 1), cB + hstep); PG8_STAGEA(PG8_SA(0, 1), coff[1], 0);
        if (wr == 1) PG8_BAR;
        PG8_WAIT_V(4); PG8_BAR;
        PG8_STAGEB(PG8_SB(1, 0), cB + kstep); PG8_STAGEA(PG8_SA(1, 0), coff[0], 1); PG8_STAGEB(PG8_SB(1, 1), cB + hstep + kstep);
        PG8_WAIT_V(6); PG8_BAR;
    }
    for (;;) {
        const bool has_next = S.next(ui + 1, nxt);
        const char* nB = has_next ? S.bptr(nxt) : cB;
        if (has_next) { u32x4 w; w.x = S.aoff(nxt, Rr[0]) + cbA[0]; w.y = S.aoff(nxt, Rr[1]) + cbA[1]; w.z = S.aoff(nxt, HALF + Rr[0]) + cbA[0]; w.w = S.aoff(nxt, HALF + Rr[1]) + cbA[1]; *stash = w; }
#pragma unroll 1
        for (int t = 0; t < nt; t += 2) {
            const bool last = (t == nt - 2);
            const char* b2 = last ? nB : cB + (size_t)(t + 2) * kstep;
            const char* b3 = b2 + kstep;
            const int ka = last ? 0 : t + 2;
            if constexpr (SP2) {
            PG8_LDB(B0, 0, 0); PG8_LDB(B1, 0, 1); PG8_SCHED; PG8_LDA(At, 0, 0); PG8_STAGEA(PG8_SA(1, 1), coff[1], t + 1);
            PG8_WAIT_V(8); PG8_WAIT_L(0); PG8_BAR; PG8_MMA(0, 0, At, B0); PG8_MMA(0, 1, At, B1); PG8_BAR; PG8_SCHED;
            if (last && has_next) { const u32x4 w = *stash; coff[0][0] = w.x; coff[0][1] = w.y; coff[1][0] = w.z; coff[1][1] = w.w; }
            PG8_LDA(At, 0, 1); PG8_STAGEB(PG8_SB(0, 0), b2); PG8_STAGEB(PG8_SB(0, 1), b2 + hstep); PG8_STAGEA(PG8_SA(0, 0), coff[0], ka);
            PG8_WAIT_V(8); PG8_WAIT_L(0); PG8_BAR; PG8_MMA(1, 0, At, B0); PG8_MMA(1, 1, At, B1); PG8_BAR; PG8_SCHED;
            PG8_LDB(B0, 1, 0); PG8_LDB(B1, 1, 1); PG8_SCHED; PG8_LDA(At, 1, 0); PG8_STAGEA(PG8_SA(0, 1), coff[1], ka);
            PG8_WAIT_V(8); PG8_WAIT_L(0); PG8_BAR; PG8_MMA(0, 0, At, B0); PG8_MMA(0, 1, At, B1); PG8_BAR; PG8_SCHED;
            PG8_LDA(At, 1, 1); PG8_STAGEB(PG8_SB(1, 0), b3); PG8_STAGEB(PG8_SB(1, 1), b3 + hstep); PG8_STAGEA(PG8_SA(1, 0), coff[0], ka + 1);
            PG8_WAIT_V(8); PG8_WAIT_L(0); PG8_BAR; PG8_MMA(1, 0, At, B0); PG8_MMA(1, 1, At, B1); PG8_BAR; PG8_SCHED;
            } else {
            PG8_LDB(B0, 0, 0); PG8_SCHED; PG8_LDA(At, 0, 0); PG8_STAGEA(PG8_SA(1, 1), coff[1], t + 1);
            PG8_WAIT_L(8); PG8_BAR; PG8_WAIT_L(0); PG8_MMA(0, 0, At, B0); PG8_BAR; PG8_SCHED;
            if (last && has_next) { const u32x4 w = *stash; coff[0][0] = w.x; coff[0][1] = w.y; coff[1][0] = w.z; coff[1][1] = w.w; }
            PG8_LDB(B1, 0, 1); PG8_STAGEB(PG8_SB(0, 0), b2);
            PG8_BAR; PG8_WAIT_L(0); PG8_MMA(0, 1, At, B1); PG8_BAR;
            PG8_LDA(At, 0, 1); PG8_STAGEA(PG8_SA(0, 0), coff[0], ka);
            PG8_BAR; PG8_WAIT_L(0); PG8_MMA(1, 0, At, B0); PG8_BAR; PG8_SCHED;
            PG8_STAGEB(PG8_SB(0, 1), b2 + hstep);
            PG8_WAIT_V(6); PG8_BAR; PG8_MMA(1, 1, At, B1); PG8_BAR;
            PG8_LDB(B0, 1, 0); PG8_SCHED; PG8_LDA(At, 1, 0); PG8_STAGEA(PG8_SA(0, 1), coff[1], ka);
            PG8_WAIT_L(8); PG8_BAR; PG8_WAIT_L(0); PG8_MMA(0, 0, At, B0); PG8_BAR; PG8_SCHED;
            PG8_LDB(B1, 1, 1); PG8_STAGEB(PG8_SB(1, 0), b3);
            PG8_BAR; PG8_WAIT_L(0); PG8_MMA(0, 1, At, B1); PG8_BAR;
            PG8_LDA(At, 1, 1); PG8_STAGEA(PG8_SA(1, 0), coff[0], ka + 1);
            PG8_BAR; PG8_WAIT_L(0); PG8_MMA(1, 0, At, B0); PG8_BAR; PG8_SCHED;
            PG8_STAGEB(PG8_SB(1, 1), b3 + hstep);
            PG8_WAIT_V(6); PG8_BAR; PG8_MMA(1, 1, At, B1); PG8_BAR;
            }
        }
        if constexpr (ALIGN_EPI) { if (wr == 0) PG8_BAR; }
        asm volatile("" ::: "memory");
        E(acc, cur, wr, wc, fr, fq);
        if (!has_next) break;
#pragma unroll
        for (int a = 0; a < 2; ++a)
#pragma unroll
            for (int b = 0; b < 2; ++b)
#pragma unroll
                for (int m = 0; m < 4; ++m)
#pragma unroll
                    for (int n = 0; n < 2; ++n) acc[a][b][m][n] = (f32x4){0.f, 0.f, 0.f, 0.f};
        cur = nxt; cB = nB; ++ui;
        if constexpr (ALIGN_EPI) { if (wr == 1) PG8_BAR; }
    }
    PG8_WAIT_V(0);
    if constexpr (!ALIGN_EPI) { if (wr == 0) PG8_BAR; }
    PG8_BAR;
#undef PG8_SA
#undef PG8_SB
#undef PG8_STAGEA
#undef PG8_STAGEB
#undef PG8_LDA
#undef PG8_LDB
#undef PG8_MMA
#undef PG8_WAIT_V
#undef PG8_WAIT_L
#undef PG8_BAR
#undef PG8_SCHED
}

struct DenseUnit { int pm, pn; };
struct DenseSched {
    typedef DenseUnit Unit;
    int nM, nN, nwg, G, c, K; const char* Bt;
    __device__ void init(int M, int N, int K_, const void* Bt_, int G_, int c_) { nM = M / BM; nN = N / BM; nwg = nM * nN; G = G_; c = c_; K = K_; Bt = (const char*)Bt_; }
    __device__ __forceinline__ bool next(int i, Unit& u) const {
        const long L = (long)i * G + c; if (L >= nwg) return false;
        int wgid = (int)L; { const int q = nwg / NXCD, r = nwg % NXCD, xcd = wgid % NXCD, off = wgid / NXCD; wgid = (xcd < r ? xcd * (q + 1) : r * (q + 1) + (xcd - r) * q) + off; }
        const int nig = WGM * nN, gid = wgid / nig, fm = gid * WGM, gsz = (nM - fm) < WGM ? (nM - fm) : WGM;
        u.pm = fm + ((wgid % nig) % gsz); u.pn = (wgid % nig) / gsz; return true;
    }
    __device__ __forceinline__ unsigned aoff(const Unit& u, int r) const { return (unsigned)(u.pm * BM + r) * (unsigned)(K * 2); }
    __device__ __forceinline__ const char* bptr(const Unit& u) const { return Bt + (size_t)u.pn * BM * K * 2; }
};

struct MoeUnit { int e, rt, l0, nv, pn; };
template <bool GATHER>
struct MoeSched {
    typedef MoeUnit Unit;
    const LAS int* tst;
    const LAS int* cnt;
    int G, c, NP, K; const int* list; const char* Bt; size_t estride;
    __device__ __forceinline__ bool next(int i, Unit& u) const {
        const int L = i * G + c; const int R = __builtin_amdgcn_readfirstlane(tst[NE]); if (L >= R * NP) return false;
        const int rt = L / NP; u.pn = L % NP;
        int e = 0;
#pragma unroll 1
        for (int j = 1; j < NE; ++j) e = (rt >= __builtin_amdgcn_readfirstlane(tst[j])) ? j : e;
        u.e = e; u.rt = rt; u.l0 = (rt - __builtin_amdgcn_readfirstlane(tst[e])) * BM; const int rem = __builtin_amdgcn_readfirstlane(cnt[e]) - u.l0; u.nv = rem < BM ? rem : BM; return true;
    }
    __device__ __forceinline__ unsigned aoff(const Unit& u, int r) const {
        if (GATHER) { const int j = (r < u.nv) ? (u.l0 + r) : u.l0; const int a = list[(size_t)u.e * TR + j]; return (unsigned)(a >> 2) * (unsigned)(K * 2); }
        else return (unsigned)(u.rt * BM + r) * (unsigned)(K * 2);
    }
    __device__ __forceinline__ const char* bptr(const Unit& u) const { return Bt + (size_t)u.e * estride + (size_t)u.pn * BM * K * 2; }
};

struct EpiProj {
    static constexpr bool PERM = true;
    bf16* O; int ldc;
    __device__ __forceinline__ void operator()(const f32x4 (&acc)[2][2][4][2], const DenseUnit& u, int wr, int wc, int fr, int fq) const {
        const int row0 = u.pm * BM + wr * 64 + fr; const int col0 = u.pn * BM + wc * 32 + 8 * fq;
#pragma unroll
        for (int ai = 0; ai < 2; ++ai)
#pragma unroll
            for (int m = 0; m < 4; ++m) { bf16* rowp = O + (size_t)(row0 + ai * HALF + m * 16) * ldc + col0;
#pragma unroll
                for (int bj = 0; bj < 2; ++bj) { const f32x4 v0 = acc[ai][bj][m][0], v1 = acc[ai][bj][m][1];
                    u32x4 w; w.x = cvt_pk_bf16(v0[0], v0[1]); w.y = cvt_pk_bf16(v0[2], v0[3]); w.z = cvt_pk_bf16(v1[0], v1[1]); w.w = cvt_pk_bf16(v1[2], v1[3]);
                    *(u32x4*)(rowp + bj * HALF) = w; } }
    }
};
struct EpiH1 {
    static constexpr bool PERM = false;
    const float* X; float* H; int ldc;
    __device__ __forceinline__ void operator()(const f32x4 (&acc)[2][2][4][2], const DenseUnit& u, int wr, int wc, int fr, int fq) const {
        const int row0 = u.pm * BM + wr * 64 + fr, col0 = u.pn * BM + wc * 32 + 4 * fq;
#pragma unroll
        for (int ai = 0; ai < 2; ++ai)
#pragma unroll
            for (int m = 0; m < 4; ++m) { const size_t off = (size_t)(row0 + ai * HALF + m * 16) * ldc + col0;
#pragma unroll
                for (int bj = 0; bj < 2; ++bj)
#pragma unroll
                    for (int n = 0; n < 2; ++n) { const f32x4 xv = *(const f32x4*)(X + off + bj * HALF + n * 16); *(f32x4*)(H + off + bj * HALF + n * 16) = xv + acc[ai][bj][m][n]; }
                asm volatile("" ::: "memory"); }
    }
};
__device__ __forceinline__ float swiglu1(float g, float l) {
    g = fminf(g, SW_LIMIT); l = fminf(fmaxf(l, -SW_LIMIT), SW_LIMIT);
    return g * (l + 1.0f) / (1.0f + __expf(-SW_ALPHA * g));
}
__device__ __forceinline__ unsigned pk4_fp8(float a, float b, float c, float d) { int w = 0; w = __builtin_amdgcn_cvt_pk_fp8_f32(a, b, w, false); w = __builtin_amdgcn_cvt_pk_fp8_f32(c, d, w, true); return (unsigned)w; }
constexpr float W8_SCALE = 32.0f, W8_INV = 1.0f / 32.0f;
struct EpiSwiGLU8 {
    static constexpr bool PERM = true;
    unsigned char* ACT; const float* bgu;
    __device__ __forceinline__ void operator()(const f32x4 (&acc)[2][2][4][2], const MoeUnit& u, int wr, int wc, int fr, int fq) const {
        const int row0 = u.rt * BM + wr * 64 + fr; const int j0 = u.pn * HALF + wc * 32 + 8 * fq;
        const float* bg = bgu + (size_t)u.e * 2048 + j0;
        const f32x4 g0 = *(const f32x4*)(bg), g1 = *(const f32x4*)(bg + 4), l0 = *(const f32x4*)(bg + 1024), l1 = *(const f32x4*)(bg + 1028);
#pragma unroll
        for (int ai = 0; ai < 2; ++ai)
#pragma unroll
            for (int m = 0; m < 4; ++m) { unsigned char* rowp = ACT + (size_t)(row0 + ai * HALF + m * 16) * 1024 + j0;
                const f32x4 a0 = acc[ai][0][m][0] * W8_INV + g0, a1 = acc[ai][0][m][1] * W8_INV + g1, b0 = acc[ai][1][m][0] * W8_INV + l0, b1 = acc[ai][1][m][1] * W8_INV + l1;
                u32x2 w; w.x = pk4_fp8(swiglu1(a0[0], b0[0]), swiglu1(a0[1], b0[1]), swiglu1(a0[2], b0[2]), swiglu1(a0[3], b0[3]));
                w.y = pk4_fp8(swiglu1(a1[0], b1[0]), swiglu1(a1[1], b1[1]), swiglu1(a1[2], b1[2]), swiglu1(a1[3], b1[3]));
                *(u32x2*)rowp = w; }
    }
};
struct EpiSwiGLU {
    static constexpr bool PERM = true;
    bf16* ACT; const float* bgu;
    __device__ __forceinline__ void operator()(const f32x4 (&acc)[2][2][4][2], const MoeUnit& u, int wr, int wc, int fr, int fq) const {
        const int row0 = u.rt * BM + wr * 64 + fr; const int j0 = u.pn * HALF + wc * 32 + 8 * fq;
        const float* bg = bgu + (size_t)u.e * 2048 + j0;
        const f32x4 g0 = *(const f32x4*)(bg), g1 = *(const f32x4*)(bg + 4), l0 = *(const f32x4*)(bg + 1024), l1 = *(const f32x4*)(bg + 1028);
#pragma unroll
        for (int ai = 0; ai < 2; ++ai)
#pragma unroll
            for (int m = 0; m < 4; ++m) { bf16* rowp = ACT + (size_t)(row0 + ai * HALF + m * 16) * 1024 + j0;
                const f32x4 a0 = acc[ai][0][m][0] + g0, a1 = acc[ai][0][m][1] + g1, b0 = acc[ai][1][m][0] + l0, b1 = acc[ai][1][m][1] + l1;
                u32x4 w; w.x = cvt_pk_bf16(swiglu1(a0[0], b0[0]), swiglu1(a0[1], b0[1])); w.y = cvt_pk_bf16(swiglu1(a0[2], b0[2]), swiglu1(a0[3], b0[3]));
                w.z = cvt_pk_bf16(swiglu1(a1[0], b1[0]), swiglu1(a1[1], b1[1])); w.w = cvt_pk_bf16(swiglu1(a1[2], b1[2]), swiglu1(a1[3], b1[3]));
                *(u32x4*)rowp = w; }
    }
};
struct EpiDown {
    static constexpr bool PERM = true;
    bf16* YE; const float* bdn; const int* list; const float* gate; float ascale;
    __device__ __forceinline__ void operator()(const f32x4 (&acc)[2][2][4][2], const MoeUnit& u, int wr, int wc, int fr, int fq) const {
        const int col0 = u.pn * BM + wc * 32 + 8 * fq;
        const float* bb = bdn + (size_t)u.e * 1024 + col0;
        f32x4 bv[2][2];
#pragma unroll
        for (int bj = 0; bj < 2; ++bj)
#pragma unroll
            for (int n = 0; n < 2; ++n) bv[bj][n] = *(const f32x4*)(bb + bj * HALF + 4 * n);
#pragma unroll
        for (int ai = 0; ai < 2; ++ai)
#pragma unroll
            for (int m = 0; m < 4; ++m) { const int r = ai * HALF + wr * 64 + m * 16 + fr;
                if (r < u.nv) { const int a = list[(size_t)u.e * TR + u.l0 + r]; const float g = gate[a]; bf16* rowp = YE + (size_t)a * 1024 + col0;
#pragma unroll
                    for (int bj = 0; bj < 2; ++bj) { const f32x4 v0 = (acc[ai][bj][m][0] * ascale + bv[bj][0]) * g, v1 = (acc[ai][bj][m][1] * ascale + bv[bj][1]) * g;
                        u32x4 w; w.x = cvt_pk_bf16(v0[0], v0[1]); w.y = cvt_pk_bf16(v0[2], v0[3]); w.z = cvt_pk_bf16(v1[0], v1[1]); w.w = cvt_pk_bf16(v1[2], v1[3]);
                        *(u32x4*)(rowp + bj * HALF) = w; } } }
    }
};
}

constexpr int NWAVES = 8;
constexpr int RING_OFF = 0, RING_BYTES = 131072;
constexpr int LDSCTL_OFF = RING_BYTES;
constexpr int MISC_OFF = LDSCTL_OFF + 320;
constexpr int MOE_OFF = LDSCTL_OFF + 512;
constexpr int RT_OFF = LDSCTL_OFF + 1024;
constexpr int LDS_BYTES = 147456;

#define XB_TMO      128
#define XB_XCNT(j)  (256  + 64 * (j))
#define XB_XSUB(j)  (1280 + 64 * (j))
#define XB_XGEN(j)  (2304 + 64 * (j))
#define XB_TOP      3328
#define XB_TOPGEN   3392
#define XCD_BAR_WORDS 3456
#define XB_SPIN_CAP (1u << 18)
__device__ __forceinline__ unsigned xb_ld(unsigned* p)              { return __hip_atomic_load(p, __ATOMIC_RELAXED, __HIP_MEMORY_SCOPE_AGENT); }
__device__ __forceinline__ unsigned xb_add(unsigned* p, unsigned v) { return __hip_atomic_fetch_add(p, v, __ATOMIC_RELAXED, __HIP_MEMORY_SCOPE_AGENT); }
__device__ __forceinline__ unsigned xb_xcc_id() { return (unsigned)__builtin_amdgcn_s_getreg((3 << 11) | 20) & 0xFu; }
#define XB_SPIN(cond, bar) do { unsigned _sp = 0; while (cond) { __builtin_amdgcn_s_sleep(1); \
    if ((++_sp & 255u) == 0u) { if (xb_ld(&(bar)[XB_TMO])) break; if (_sp > XB_SPIN_CAP) { atomicAdd(&(bar)[XB_TMO], 1u); break; } } } } while (0)
struct XcdBarrier { unsigned* bar; unsigned x; volatile LAS unsigned* st; };
__device__ __forceinline__ XcdBarrier xcd_barrier_post(unsigned* bar, volatile LAS unsigned* st) {
    XcdBarrier b; b.bar = bar; b.x = xb_xcc_id(); b.st = st;
    if (threadIdx.x == 0) (void)xb_add(&bar[XB_XCNT(b.x)], 1u);
    return b;
}
__device__ __forceinline__ void xcd_barrier_complete(unsigned* bar, unsigned x, unsigned& nloc, unsigned& nx) {
    const unsigned G = gridDim.x * gridDim.y * gridDim.z;
    unsigned sum, cnt, mine, sp = 0u;
    for (;;) {
        sum = 0u; cnt = 0u; mine = 0u;
#pragma unroll
        for (unsigned j = 0; j < 16; ++j) { const unsigned c = xb_ld(&bar[XB_XCNT(j)]); sum += c; cnt += (c > 0u) ? 1u : 0u; mine = (j == x) ? c : mine; }
        if (sum == G) break;
        __builtin_amdgcn_s_sleep(1);
        if ((++sp & 255u) == 0u) { if (xb_ld(&bar[XB_TMO])) break; if (sp > XB_SPIN_CAP) { atomicAdd(&bar[XB_TMO], 1u); break; } }
    }
    nloc = mine > 0u ? mine : 1u; nx = cnt > 0u ? cnt : 1u;
}
__device__ __forceinline__ void xcd_barrier(const XcdBarrier& b) {
    asm volatile("s_waitcnt vmcnt(0)" ::: "memory");
    __syncthreads();
    if (threadIdx.x == 0) {
        unsigned* bar = b.bar;
        __builtin_amdgcn_s_waitcnt(0);
        unsigned nloc = b.st[0], nx = b.st[1];
        if (nloc == 0u) { xcd_barrier_complete(bar, b.x, nloc, nx); b.st[0] = nloc; b.st[1] = nx; }
        const unsigned old = xb_add(&bar[XB_XSUB(b.x)], 1u);
        const unsigned gen = old / nloc;
        if (old + 1u == (gen + 1u) * nloc) {
            __builtin_amdgcn_fence(__ATOMIC_RELEASE, "agent");
            asm volatile("s_waitcnt vmcnt(0)" ::: "memory");
            const unsigned og = xb_add(&bar[XB_TOP], 1u);
            const unsigned tg = og / nx;
            if (og + 1u == (tg + 1u) * nx) xb_add(&bar[XB_TOPGEN], 1u);
            else XB_SPIN(xb_ld(&bar[XB_TOPGEN]) == tg, bar);
            __builtin_amdgcn_fence(__ATOMIC_ACQUIRE, "agent");
            xb_add(&bar[XB_XGEN(b.x)], 1u);
            asm volatile("s_waitcnt vmcnt(0)" ::: "memory");
        } else {
            XB_SPIN(xb_ld(&bar[XB_XGEN(b.x)]) == gen, bar);
            __builtin_amdgcn_fence(__ATOMIC_ACQUIRE, "agent");
            asm volatile("s_waitcnt vmcnt(0)" ::: "memory");
        }
    }
    __syncthreads();
}

struct Args { const float* in[21]; float* out; unsigned char* ws; int ph_lo, ph_hi; };
enum { I_X = 0, I_META, I_NMIX, I_WIN, I_CSW, I_CNW, I_SCW, I_SCB, I_DTB, I_ALOG, I_SD, I_SNW, I_WOUT, I_NFFN, I_RW, I_RB, I_WGU, I_BGU, I_WDN, I_BDN, I_NFIN };

__device__ __forceinline__ void p0_transpose_item(const float* W, int ldw, int K, const float* kscale, bf16* WT, int row_off, int k0, int n0, LAS float* scr, int lane) {
    float v[32];
#pragma unroll
    for (int i = 0; i < 32; ++i) v[i] = W[(size_t)(k0 + 2 * i + (lane >> 5)) * ldw + n0 + (lane & 31)];
    if (kscale) {
#pragma unroll
        for (int i = 0; i < 32; ++i) v[i] *= kscale[k0 + 2 * i + (lane >> 5)];
    }
#pragma unroll
    for (int i = 0; i < 32; ++i) scr[(2 * i + (lane >> 5)) * 33 + (lane & 31)] = v[i];
    LDS_WAIT(); asm volatile("" ::: "memory");
    const int c = lane & 7;
#pragma unroll
    for (int j = 0; j < 4; ++j) { const int n = (lane >> 3) + 8 * j; const LAS float* s = scr + (8 * c) * 33 + n;
        u32x4 o; o.x = pk2(s[0 * 33], s[1 * 33]); o.y = pk2(s[2 * 33], s[3 * 33]); o.z = pk2(s[4 * 33], s[5 * 33]); o.w = pk2(s[6 * 33], s[7 * 33]);
        *(u32x4*)(WT + (size_t)(row_off + n) * K + k0 + 8 * c) = o; }
    LDS_WAIT(); asm volatile("" ::: "memory");
}

__device__ __forceinline__ void p0_transpose_item_f8(const float* W, int ldw, int K, const float* kscale, unsigned char* WT, int row_off, int k0, int n0, LAS float* scr, int lane) {
    float v[32];
#pragma unroll
    for (int i = 0; i < 32; ++i) v[i] = W[(size_t)(k0 + 2 * i + (lane >> 5)) * ldw + n0 + (lane & 31)];
#pragma unroll
    for (int i = 0; i < 32; ++i) v[i] *= kscale ? kscale[k0 + 2 * i + (lane >> 5)] * pg8::W8_SCALE : pg8::W8_SCALE;
#pragma unroll
    for (int i = 0; i < 32; ++i) scr[(2 * i + (lane >> 5)) * 33 + (lane & 31)] = v[i];
    LDS_WAIT(); asm volatile("" ::: "memory");
    const int c = lane & 7;
#pragma unroll
    for (int j = 0; j < 4; ++j) { const int n = (lane >> 3) + 8 * j; const LAS float* s = scr + (8 * c) * 33 + n;
        u32x2 o; o.x = pg8::pk4_fp8(s[0 * 33], s[1 * 33], s[2 * 33], s[3 * 33]); o.y = pg8::pk4_fp8(s[4 * 33], s[5 * 33], s[6 * 33], s[7 * 33]);
        *(u32x2*)(WT + (size_t)(row_off + n) * K + k0 + 8 * c) = o; }
    LDS_WAIT(); asm volatile("" ::: "memory");
}
__device__ __forceinline__ void p0_prologue(const Args& A, LAS unsigned char* lds, int vcu, int G, int tid, int lane, int wave) {
    unsigned char* ws = A.ws;
    LAS float* scr = (LAS float*)(lds + RING_OFF + wave * 16384);
    const int gw = vcu * NWAVES + wave, NGW = G * NWAVES;
    constexpr int I_IN = 16 * 192, I_OUT = 32 * 32, I_GU = 32 * 16 * 64, I_DN = 32 * 16 * 32;
    constexpr int NITEMS = I_IN + I_OUT + I_GU + I_DN;
    for (int it = gw; it < NITEMS; it += NGW) {
        int r = it;
        if (r < I_IN) { const int kb = r / 192, nb = r % 192; p0_transpose_item(A.in[I_WIN], WIN_LD, 1024, A.in[I_NMIX], (bf16*)(ws + WS_WIN), 32 * nb, 64 * kb, 32 * nb, scr, lane); continue; } r -= I_IN;
        if (r < I_OUT) { const int kb = r / 32, nb = r % 32; const float* ks = (kb < 16) ? A.in[I_CNW] : (A.in[I_SNW] - 1024);
            p0_transpose_item(A.in[I_WOUT], 1024, 2048, ks, (bf16*)(ws + WS_WOUT), 32 * nb, 64 * kb, 32 * nb, scr, lane); continue; } r -= I_OUT;
        if (r < I_GU) { const int e = r >> 10, q = r & 1023, kb = q >> 6, nb = q & 63; const int n0 = 32 * nb;
            const int bj = n0 >> 10, j = n0 & 1023, pn = j >> 7, jj = j & 127; const int rho = 256 * pn + 128 * bj + jj;
            p0_transpose_item_f8(A.in[I_WGU] + (size_t)e * 1024 * 2048, 2048, 1024, A.in[I_NFFN], (unsigned char*)(ws + WS_WGU) + (size_t)e * 2048 * 1024, rho, 64 * kb, n0, scr, lane); continue; } r -= I_GU;
        { const int e = r >> 9, q = r & 511, kb = q >> 5, nb = q & 31;
            p0_transpose_item_f8(A.in[I_WDN] + (size_t)e * 1024 * 1024, 1024, 1024, nullptr, (unsigned char*)(ws + WS_WDN) + (size_t)e * 1024 * 1024, 32 * nb, 64 * kb, 32 * nb, scr, lane); }
    }
    __syncthreads();
    LAS float* wdt = (LAS float*)(lds + RING_OFF);
    for (int idx = tid; idx < 16 * 1024; idx += NWAVES * 64) { const int d = idx >> 4, j = idx & 15; wdt[j * 1024 + d] = A.in[I_WIN][(size_t)d * WIN_LD + NPROJ + j] * A.in[I_NMIX][d]; }
    LDS_WAIT(); __syncthreads();
    bf16* XN = (bf16*)(ws + WS_XN); float* DT = (float*)(ws + WS_DT);
    f32x4 nv[4];
#define P0_ROWLOAD(mm) do { const int _m = (mm); const float* src = (_m < TR) ? A.in[I_X] + (size_t)_m * D : ((_m < MROW + NMETA) ? A.in[I_META] + (size_t)(_m - MROW) * D : nullptr); \
        _Pragma("unroll") for (int j = 0; j < 4; ++j) nv[j] = src ? *((const f32x4*)src + 64 * j + lane) : (f32x4){0.f, 0.f, 0.f, 0.f}; } while (0)
    if (gw < TA) P0_ROWLOAD(gw);
    for (int m = gw; m < TA; m += NGW) {
        f32x4 v[4]; float s = 0.f;
#pragma unroll
        for (int j = 0; j < 4; ++j) { v[j] = nv[j]; s += (v[j].x * v[j].x + v[j].y * v[j].y) + (v[j].z * v[j].z + v[j].w * v[j].w); }
        if (m + NGW < TA) P0_ROWLOAD(m + NGW);
        const float rstd = 1.0f / sqrtf(wave_sum(s) * (1.0f / D) + EPS);
        u32x2* o8 = (u32x2*)(XN + (size_t)m * D) + lane;
#pragma unroll
        for (int j = 0; j < 4; ++j) { u32x2 w; w.x = pk2(v[j].x * rstd, v[j].y * rstd); w.y = pk2(v[j].z * rstd, v[j].w * rstd); o8[64 * j] = w; }
        float mine = 0.f;
#pragma unroll 2
        for (int jj = 0; jj < 16; ++jj) { float a = 0.f;
#pragma unroll
            for (int j = 0; j < 4; ++j) { const f32x4 w = *(const LAS f32x4*)(wdt + jj * 1024 + 256 * j + 4 * lane); a += (v[j].x * w.x + v[j].y * w.y) + (v[j].z * w.z + v[j].w * w.w); }
            a = wave_sum(a); mine = (lane == jj) ? a : mine; }
        if (lane < 16) DT[(size_t)m * 16 + lane] = mine * rstd;
    }
}

__device__ __forceinline__ void p4_router(const Args& A, LAS unsigned char* lds, int vcu, int G, int tid, int lane, int wave) {
    unsigned char* ws = A.ws;
    const float* H1 = (const float*)(ws + WS_H1); unsigned char* XN2 = (unsigned char*)(ws + WS_XN);
    int* LIST = (int*)(ws + WS_LIST); float* GATE = (float*)(ws + WS_GATE); unsigned* CNT = (unsigned*)(ws + WS_CTL) + CW_CNT;
    LAS float* rwt = (LAS float*)(lds + RING_OFF);
    LAS int* sel_e = (LAS int*)(lds + RT_OFF); LAS float* sel_g = (LAS float*)(lds + RT_OFF + 2048); LAS int* rnk = (LAS int*)(lds + RT_OFF + 4096);
    LAS int* cnt_loc = (LAS int*)(lds + RT_OFF + 6144); LAS int* base_loc = (LAS int*)(lds + RT_OFF + 6144 + 128);
    for (int idx = tid; idx < 32 * 1024; idx += NWAVES * 64) { const int d = idx >> 5, e = idx & 31; rwt[e * 1024 + d] = A.in[I_RW][(size_t)d * 32 + e] * A.in[I_NFFN][d]; }
    LDS_WAIT(); __syncthreads();
    float rb[32];
#pragma unroll
    for (int e = 0; e < 32; ++e) rb[e] = A.in[I_RB][e];
    for (int ch = vcu; ch < TR / 128; ch += G) {
        if (tid < 32) cnt_loc[tid] = 0;
        LDS_WAIT(); __syncthreads();
        for (int q = 0; q < 16; ++q) {
            const int tl = wave * 16 + q, t = ch * 128 + tl;
            f32x4 v[4]; float s = 0.f;
#pragma unroll
            for (int j = 0; j < 4; ++j) { v[j] = *((const f32x4*)(H1 + (size_t)t * D) + 64 * j + lane); s += (v[j].x * v[j].x + v[j].y * v[j].y) + (v[j].z * v[j].z + v[j].w * v[j].w); }
            const float rstd = 1.0f / sqrtf(wave_sum(s) * (1.0f / D) + EPS);
            unsigned* o4 = (unsigned*)(XN2 + (size_t)t * D) + lane;
#pragma unroll
            for (int j = 0; j < 4; ++j) o4[64 * j] = pg8::pk4_fp8(v[j].x * rstd, v[j].y * rstd, v[j].z * rstd, v[j].w * rstd);
            float lg[32];
#pragma unroll
            for (int e = 0; e < 32; ++e) { float a = 0.f;
#pragma unroll
                for (int j = 0; j < 4; ++j) { const f32x4 w = *(const LAS f32x4*)(rwt + e * 1024 + 256 * j + 4 * lane); a += (v[j].x * w.x + v[j].y * w.y) + (v[j].z * w.z + v[j].w * w.w); }
                lg[e] = wave_sum(a) * rstd + rb[e]; }
            float tv[4]; int ti[4];
#pragma unroll
            for (int k = 0; k < 4; ++k) { float best = lg[0]; int bi = 0;
#pragma unroll
                for (int e = 1; e < 32; ++e) { const bool gt = lg[e] > best; best = gt ? lg[e] : best; bi = gt ? e : bi; }
                tv[k] = best; ti[k] = bi;
#pragma unroll
                for (int e = 0; e < 32; ++e) lg[e] = (e == bi) ? -3.0e38f : lg[e]; }
            const float e1 = __expf(tv[1] - tv[0]), e2 = __expf(tv[2] - tv[0]), e3 = __expf(tv[3] - tv[0]); const float inv = 1.0f / (1.0f + e1 + e2 + e3);
            if (lane < 4) { const int e = lane == 0 ? ti[0] : (lane == 1 ? ti[1] : (lane == 2 ? ti[2] : ti[3]));
                const float g = (lane == 0 ? 1.0f : (lane == 1 ? e1 : (lane == 2 ? e2 : e3))) * inv;
                const int r = __hip_atomic_fetch_add(cnt_loc + e, 1, __ATOMIC_RELAXED, __HIP_MEMORY_SCOPE_WORKGROUP);
                sel_e[tl * 4 + lane] = e; sel_g[tl * 4 + lane] = g; rnk[tl * 4 + lane] = r; }
        }
        LDS_WAIT(); __syncthreads();
        if (tid < 32) base_loc[tid] = (int)__hip_atomic_fetch_add(CNT + tid, (unsigned)cnt_loc[tid], __ATOMIC_RELAXED, __HIP_MEMORY_SCOPE_AGENT);
        LDS_WAIT(); __syncthreads();
        { const int e = sel_e[tid]; const int pos = base_loc[e] + rnk[tid]; const int a = (ch * 128) * 4 + tid; LIST[(size_t)e * TR + pos] = a; GATE[a] = sel_g[tid]; }
        __syncthreads();
    }
}

__device__ __forceinline__ void p7_final(const Args& A, int vcu, int G, int lane, int wave) {
    unsigned char* ws = A.ws;
    const float* H1 = (const float*)(ws + WS_H1); const bf16* YE = (const bf16*)(ws + WS_YE);
    const int gw = vcu * NWAVES + wave, NGW = G * NWAVES;
    f32x4 wf[4];
#pragma unroll
    for (int j = 0; j < 4; ++j) wf[j] = *((const f32x4*)A.in[I_NFIN] + 64 * j + lane);
    for (int t = gw; t < TR; t += NGW) {
        f32x4 v[4]; float s = 0.f;
#pragma unroll
        for (int j = 0; j < 4; ++j) v[j] = *((const f32x4*)(H1 + (size_t)t * D) + 64 * j + lane);
#pragma unroll
        for (int k = 0; k < 4; ++k) { const u32x2* yr = (const u32x2*)(YE + ((size_t)t * 4 + k) * D) + lane;
#pragma unroll
            for (int j = 0; j < 4; ++j) { const u32x2 w = yr[64 * j]; v[j].x += bflo(w.x); v[j].y += bfhi(w.x); v[j].z += bflo(w.y); v[j].w += bfhi(w.y); } }
#pragma unroll
        for (int j = 0; j < 4; ++j) s += (v[j].x * v[j].x + v[j].y * v[j].y) + (v[j].z * v[j].z + v[j].w * v[j].w);
        const float rstd = 1.0f / sqrtf(wave_sum(s) * (1.0f / D) + EPS);
        f32x4* o = (f32x4*)(A.out + (size_t)t * D) + lane;
#pragma unroll
        for (int j = 0; j < 4; ++j) o[64 * j] = v[j] * rstd * wf[j];
    }
}

__device__ __forceinline__ void moe_tables(const Args& A, LAS unsigned char* lds, int tid) {
    LAS int* tst = (LAS int*)(lds + MOE_OFF); LAS int* cnt = tst + 40;
    const unsigned* CNT = (const unsigned*)(A.ws + WS_CTL) + CW_CNT;
    if (tid < 32) cnt[tid] = (int)__hip_atomic_load(CNT + tid, __ATOMIC_RELAXED, __HIP_MEMORY_SCOPE_AGENT);
    LDS_WAIT(); __syncthreads();
    if (tid == 0) { int s = 0; for (int e = 0; e < NE; ++e) { tst[e] = s; s += (cnt[e] + 255) >> 8; } tst[NE] = s; }
    LDS_WAIT(); __syncthreads();
}

__device__ __forceinline__ void d_conv_branch(const bf16* __restrict__ PROJ, const float* __restrict__ cw, bf16* __restrict__ Y, int m, int lane) {
    const int b = m / SEQ, s = m % SEQ, l = s + NMETA;
    const int r0 = row_of(b, l), r1 = row_of(b, l - 1), r2 = row_of(b, l - 2);
#pragma unroll
    for (int j = 0; j < 4; ++j) {
        const int c = 256 * j + 4 * lane;
        const u32x2 cb = *(const u32x2*)(PROJ + (size_t)r0 * NPROJ + C_CB + c);
        const u32x2 c0 = *(const u32x2*)(PROJ + (size_t)r0 * NPROJ + C_CC + c), x0 = *(const u32x2*)(PROJ + (size_t)r0 * NPROJ + C_CX + c);
        const u32x2 c1 = *(const u32x2*)(PROJ + (size_t)r1 * NPROJ + C_CC + c), x1 = *(const u32x2*)(PROJ + (size_t)r1 * NPROJ + C_CX + c);
        const u32x2 c2 = *(const u32x2*)(PROJ + (size_t)r2 * NPROJ + C_CC + c), x2 = *(const u32x2*)(PROJ + (size_t)r2 * NPROJ + C_CX + c);
        const f32x4 w0 = *(const f32x4*)(cw + c), w1 = *(const f32x4*)(cw + 1024 + c), w2 = *(const f32x4*)(cw + 2048 + c);
        float y[4];
        y[0] = bflo(cb.x) * (w0.x * bflo(c2.x) * bflo(x2.x) + w1.x * bflo(c1.x) * bflo(x1.x) + w2.x * bflo(c0.x) * bflo(x0.x));
        y[1] = bfhi(cb.x) * (w0.y * bfhi(c2.x) * bfhi(x2.x) + w1.y * bfhi(c1.x) * bfhi(x1.x) + w2.y * bfhi(c0.x) * bfhi(x0.x));
        y[2] = bflo(cb.y) * (w0.z * bflo(c2.y) * bflo(x2.y) + w1.z * bflo(c1.y) * bflo(x1.y) + w2.z * bflo(c0.y) * bflo(x0.y));
        y[3] = bfhi(cb.y) * (w0.w * bfhi(c2.y) * bfhi(x2.y) + w1.w * bfhi(c1.y) * bfhi(x1.y) + w2.w * bfhi(c0.y) * bfhi(x0.y));
        float ss = (y[0] * y[0] + y[1] * y[1]) + (y[2] * y[2] + y[3] * y[3]);
#pragma unroll
        for (int o = 1; o < 32; o <<= 1) ss += __shfl_xor(ss, o);
        const float rstd = 1.0f / sqrtf(ss * (1.0f / 128.0f) + EPS);
        u32x2 w; w.x = pk2(y[0] * rstd, y[1] * rstd); w.y = pk2(y[2] * rstd, y[3] * rstd);
        *(u32x2*)(Y + (size_t)m * DMIX + c) = w;
    }
}
__device__ __forceinline__ void d_xbc_act(const bf16* __restrict__ PROJ, const float* __restrict__ cw, const float* __restrict__ cb, bf16* __restrict__ XBCA, int m, int lane) {
    if (m >= MROW + NMETA) return;
    int b, l; if (m < TR) { b = m / SEQ; l = (m % SEQ) + NMETA; } else { b = 0; l = m - MROW; }
    int rk[4];
#pragma unroll
    for (int k = 0; k < 4; ++k) { const int lk = l - 3 + k; rk[k] = lk >= 0 ? row_of(b, lk) : -1; }
#pragma unroll
    for (int j = 0; j < 8; ++j) {
        const int c = 256 * j + 4 * lane;
        f32x4 a = *(const f32x4*)(cb + c);
#pragma unroll
        for (int k = 0; k < 4; ++k) if (rk[k] >= 0) { const u32x2 u = *(const u32x2*)(PROJ + (size_t)rk[k] * NPROJ + C_XS + c); const f32x4 w = *(const f32x4*)(cw + k * 2048 + c);
            a.x += w.x * bflo(u.x); a.y += w.y * bfhi(u.x); a.z += w.z * bflo(u.y); a.w += w.w * bfhi(u.y); }
        u32x2 o; o.x = pk2(silu_f(a.x), silu_f(a.y)); o.y = pk2(silu_f(a.z), silu_f(a.w));
        *(u32x2*)(XBCA + (size_t)m * 2048 + c) = o;
    }
}
__device__ __forceinline__ void d_ssd_naive(const bf16* __restrict__ XBCA, const bf16* __restrict__ PROJ, const float* __restrict__ DT, const float* __restrict__ dt_bias,
                                                   const float* __restrict__ a_log, const float* __restrict__ dpar, bf16* __restrict__ YPRE, int item, int p) {
    const int b = item >> 4, h = item & 15, g = h >> 2;
    const float Aneg = -__expf(a_log[h]), dtb = dt_bias[h], Dh = dpar[h];
    float S[128];
#pragma unroll
    for (int n = 0; n < 128; ++n) S[n] = 0.f;
    int row = row_of(b, 0);
    float n_draw = DT[(size_t)row * 16 + h]; unsigned short n_x = XBCA[(size_t)row * 2048 + h * 64 + p];
    unsigned n_bw = *(const unsigned*)(XBCA + (size_t)row * 2048 + 1024 + g * 128 + 2 * p), n_cw = *(const unsigned*)(XBCA + (size_t)row * 2048 + 1536 + g * 128 + 2 * p);
    unsigned short n_z = PROJ[(size_t)row * NPROJ + C_Z + h * 64 + p];
    for (int l = 0; l < LSEQ; ++l) {
        const int crow = row; const float draw = n_draw + dtb; const float xv = bf2f(n_x); const unsigned bw = n_bw, cw = n_cw; const float z = bf2f(n_z);
        if (l + 1 < LSEQ) { row = row_of(b, l + 1);
            n_draw = DT[(size_t)row * 16 + h]; n_x = XBCA[(size_t)row * 2048 + h * 64 + p];
            n_bw = *(const unsigned*)(XBCA + (size_t)row * 2048 + 1024 + g * 128 + 2 * p); n_cw = *(const unsigned*)(XBCA + (size_t)row * 2048 + 1536 + g * 128 + 2 * p);
            n_z = PROJ[(size_t)row * NPROJ + C_Z + h * 64 + p]; }
        const float dtv = draw > 20.f ? draw : log1pf(__expf(draw));
        const float dec = __expf(dtv * Aneg), xdt = xv * dtv;
        float y = 0.f;
#pragma unroll
        for (int n = 0; n < 128; n += 2) {
            const unsigned bb = (unsigned)__builtin_amdgcn_readlane((int)bw, n >> 1), cc = (unsigned)__builtin_amdgcn_readlane((int)cw, n >> 1);
            S[n] = S[n] * dec + xdt * bflo(bb); y += S[n] * bflo(cc);
            S[n + 1] = S[n + 1] * dec + xdt * bfhi(bb); y += S[n + 1] * bfhi(cc);
        }
        if (l >= NMETA) { const float yg = (y + Dh * xv) * silu_f(z); YPRE[(size_t)crow * 1024 + h * 64 + p] = (bf16)f2bf(yg); }
    }
}
__device__ __forceinline__ void d_ssd_norm(const bf16* __restrict__ YPRE, bf16* __restrict__ Y, int m, int lane) {
#pragma unroll
    for (int j = 0; j < 4; ++j) {
        const int c = 256 * j + 4 * lane;
        const u32x2 u = *(const u32x2*)(YPRE + (size_t)m * 1024 + c);
        const float y0 = bflo(u.x), y1 = bfhi(u.x), y2 = bflo(u.y), y3 = bfhi(u.y);
        const float ss = wave_sum((y0 * y0 + y1 * y1) + (y2 * y2 + y3 * y3));
        const float rstd = 1.0f / sqrtf(ss * (1.0f / 256.0f) + EPS);
        u32x2 w; w.x = pk2(y0 * rstd, y1 * rstd); w.y = pk2(y2 * rstd, y3 * rstd);
        *(u32x2*)(Y + (size_t)m * DMIX + 1024 + c) = w;
    }
}

__device__ __forceinline__ void unpack8(const u32x4 r, float (&f)[8]) { f[0] = bflo(r.x); f[1] = bfhi(r.x); f[2] = bflo(r.y); f[3] = bfhi(r.y); f[4] = bflo(r.z); f[5] = bfhi(r.z); f[6] = bflo(r.w); f[7] = bfhi(r.w); }
__device__ __forceinline__ void mixa_xbc(const bf16* __restrict__ PROJ, const float* __restrict__ cw, const float* __restrict__ cbias, bf16* __restrict__ XBCA, int b, int l0, int nrows, int strip, int lane) {
    const int c0 = strip * 512 + lane * 8;
    float w[4][8], bs[8];
#pragma unroll
    for (int k = 0; k < 4; ++k) { const f32x4 a = *(const f32x4*)(cw + k * 2048 + c0), bb = *(const f32x4*)(cw + k * 2048 + c0 + 4); w[k][0] = a.x; w[k][1] = a.y; w[k][2] = a.z; w[k][3] = a.w; w[k][4] = bb.x; w[k][5] = bb.y; w[k][6] = bb.z; w[k][7] = bb.w; }
    { const f32x4 a = *(const f32x4*)(cbias + c0), bb = *(const f32x4*)(cbias + c0 + 4); bs[0] = a.x; bs[1] = a.y; bs[2] = a.z; bs[3] = a.w; bs[4] = bb.x; bs[5] = bb.y; bs[6] = bb.z; bs[7] = bb.w; }
    float p1[8], p2[8], p3[8];
    { u32x4 h1 = (u32x4){0u, 0u, 0u, 0u}, h2 = h1, h3 = h1;
      if (l0 - 1 >= 0) h1 = *(const u32x4*)(PROJ + (size_t)row_of(b, l0 - 1) * NPROJ + C_XS + c0);
      if (l0 - 2 >= 0) h2 = *(const u32x4*)(PROJ + (size_t)row_of(b, l0 - 2) * NPROJ + C_XS + c0);
      if (l0 - 3 >= 0) h3 = *(const u32x4*)(PROJ + (size_t)row_of(b, l0 - 3) * NPROJ + C_XS + c0);
      unpack8(h1, p1); unpack8(h2, p2); unpack8(h3, p3); }
    for (int r0 = 0; r0 < nrows; r0 += 8) {
        u32x4 raw[8];
#pragma unroll
        for (int i = 0; i < 8; ++i) raw[i] = *(const u32x4*)(PROJ + (size_t)row_of(b, l0 + r0 + i) * NPROJ + C_XS + c0);
#pragma unroll
        for (int i = 0; i < 8; ++i) { float cur[8], o[8]; unpack8(raw[i], cur);
#pragma unroll
            for (int j = 0; j < 8; ++j) { const float a = bs[j] + w[3][j] * cur[j] + w[2][j] * p1[j] + w[1][j] * p2[j] + w[0][j] * p3[j]; o[j] = silu_f(a); p3[j] = p2[j]; p2[j] = p1[j]; p1[j] = cur[j]; }
            u32x4 ov; ov.x = pk2(o[0], o[1]); ov.y = pk2(o[2], o[3]); ov.z = pk2(o[4], o[5]); ov.w = pk2(o[6], o[7]);
            *(u32x4*)(XBCA + (size_t)row_of(b, l0 + r0 + i) * 2048 + c0) = ov; }
    }
}
__device__ __forceinline__ void mixa_conv(const bf16* __restrict__ PROJ, const float* __restrict__ cw, bf16* __restrict__ Y, int b, int s0, int strip, int lane) {
    const int c0 = strip * 512 + lane * 8;
    float w[3][8];
#pragma unroll
    for (int k = 0; k < 3; ++k) { const f32x4 a = *(const f32x4*)(cw + k * 1024 + c0), bb = *(const f32x4*)(cw + k * 1024 + c0 + 4); w[k][0] = a.x; w[k][1] = a.y; w[k][2] = a.z; w[k][3] = a.w; w[k][4] = bb.x; w[k][5] = bb.y; w[k][6] = bb.z; w[k][7] = bb.w; }
    float u1[8], u2[8];
    { const size_t r1 = (size_t)row_of(b, s0 + NMETA - 1) * NPROJ, r2 = (size_t)row_of(b, s0 + NMETA - 2) * NPROJ; float a[8], c[8];
      unpack8(*(const u32x4*)(PROJ + r1 + C_CC + c0), a); unpack8(*(const u32x4*)(PROJ + r1 + C_CX + c0), c);
#pragma unroll
      for (int j = 0; j < 8; ++j) u1[j] = a[j] * c[j];
      unpack8(*(const u32x4*)(PROJ + r2 + C_CC + c0), a); unpack8(*(const u32x4*)(PROJ + r2 + C_CX + c0), c);
#pragma unroll
      for (int j = 0; j < 8; ++j) u2[j] = a[j] * c[j]; }
    for (int r0 = 0; r0 < 32; r0 += 4) {
        u32x4 rb[4], rc[4], rx[4];
#pragma unroll
        for (int i = 0; i < 4; ++i) { const size_t ro = (size_t)(b * SEQ + s0 + r0 + i) * NPROJ + c0; rb[i] = *(const u32x4*)(PROJ + ro + C_CB); rc[i] = *(const u32x4*)(PROJ + ro + C_CC); rx[i] = *(const u32x4*)(PROJ + ro + C_CX); }
#pragma unroll
        for (int i = 0; i < 4; ++i) { float cb[8], cc[8], cx[8], y[8]; unpack8(rb[i], cb); unpack8(rc[i], cc); unpack8(rx[i], cx); float ss = 0.f;
#pragma unroll
            for (int j = 0; j < 8; ++j) { const float u = cc[j] * cx[j]; y[j] = cb[j] * (w[2][j] * u + w[1][j] * u1[j] + w[0][j] * u2[j]); ss += y[j] * y[j]; u2[j] = u1[j]; u1[j] = u; }
            ss += __shfl_xor(ss, 1); ss += __shfl_xor(ss, 2); ss += __shfl_xor(ss, 4); ss += __shfl_xor(ss, 8);
            const float rstd = 1.0f / sqrtf(ss * (1.0f / 128.0f) + EPS);
            u32x4 ov; ov.x = pk2(y[0] * rstd, y[1] * rstd); ov.y = pk2(y[2] * rstd, y[3] * rstd); ov.z = pk2(y[4] * rstd, y[5] * rstd); ov.w = pk2(y[6] * rstd, y[7] * rstd);
            *(u32x4*)(Y + (size_t)(b * SEQ + s0 + r0 + i) * DMIX + c0) = ov; }
    }
}

namespace ssd {
constexpr int XP = 144, BP = 272;
constexpr int O_XDT = 0, O_XW = 18432, O_B = 36864, O_C = 71680, O_S = 106496, O_TAB = 123904;
constexpr int NCH = 17;
template <int STEP, int PITCH> __device__ __forceinline__ void tr4(unsigned a, bf16x8 (&f)[4]) {
    u32x2 r0, r1, r2, r3, r4, r5, r6, r7;
    asm volatile("ds_read_b64_tr_b16 %0, %8 offset:%9\n\tds_read_b64_tr_b16 %1, %8 offset:%10\n\tds_read_b64_tr_b16 %2, %8 offset:%11\n\tds_read_b64_tr_b16 %3, %8 offset:%12\n\t"
                 "ds_read_b64_tr_b16 %4, %8 offset:%13\n\tds_read_b64_tr_b16 %5, %8 offset:%14\n\tds_read_b64_tr_b16 %6, %8 offset:%15\n\tds_read_b64_tr_b16 %7, %8 offset:%16\n\ts_waitcnt lgkmcnt(0)"
                 : "=&v"(r0), "=&v"(r1), "=&v"(r2), "=&v"(r3), "=&v"(r4), "=&v"(r5), "=&v"(r6), "=&v"(r7)
                 : "v"(a), "i"(0 * STEP), "i"(0 * STEP + 4 * PITCH), "i"(1 * STEP), "i"(1 * STEP + 4 * PITCH), "i"(2 * STEP), "i"(2 * STEP + 4 * PITCH), "i"(3 * STEP), "i"(3 * STEP + 4 * PITCH) : "memory");
    u32x4 w;
    w.x = r0.x; w.y = r0.y; w.z = r1.x; w.w = r1.y; f[0] = __builtin_bit_cast(bf16x8, w);
    w.x = r2.x; w.y = r2.y; w.z = r3.x; w.w = r3.y; f[1] = __builtin_bit_cast(bf16x8, w);
    w.x = r4.x; w.y = r4.y; w.z = r5.x; w.w = r5.y; f[2] = __builtin_bit_cast(bf16x8, w);
    w.x = r6.x; w.y = r6.y; w.z = r7.x; w.w = r7.y; f[3] = __builtin_bit_cast(bf16x8, w);
}
#define SSD_MFMA(a, b, c) __builtin_amdgcn_mfma_f32_16x16x32_bf16((a), (b), (c), 0, 0, 0)
__device__ __forceinline__ int grow_of(int b, int c, int r) { return c > 0 ? b * SEQ + 128 * (c - 1) + r : (r >= 112 ? MROW + r - 112 : MROW); }

__device__ __forceinline__ void chain(const Args& A, LAS unsigned char* lds, int item, int tid, int lane, int wave) {
    const int b = item >> 4, h = item & 15, g = h >> 2, fr = lane & 15, fq = lane >> 4;
    const bf16* XB = (const bf16*)(A.ws + WS_XBCA); const bf16* PROJ = (const bf16*)(A.ws + WS_PROJ); const float* DT = (const float*)(A.ws + WS_DT); bf16* YPRE = (bf16*)(A.ws + WS_XN);
    const float Aneg = -__expf(A.in[I_ALOG][h]), dtb = A.in[I_DTB][h], Dh = A.in[I_SD][h];
    const unsigned lbase = (unsigned)(size_t)lds;
    for (int i = tid; i < 64 * BP / 16; i += NWAVES * 64) *(LAS u32x4*)(lds + O_S + i * 16) = (u32x4){0u, 0u, 0u, 0u};
    f32x4 st[4];
#pragma unroll
    for (int t = 0; t < 4; ++t) st[t] = (f32x4){0.f, 0.f, 0.f, 0.f};
    u32x4 pfx[2], pfb[4], pfc[4]; float pdt[2];
#define SSD_LOAD(c) do { \
        _Pragma("unroll") for (int i = 0; i < 2; ++i) { const int q = tid + 512 * i, row = q >> 3, c16 = q & 7; const bool ok = (c) > 0 || row >= 112; \
            const u32x4 v = *(const u32x4*)(XB + (size_t)grow_of(b, (c), row) * 2048 + h * 64 + c16 * 8); pfx[i] = ok ? v : (u32x4){0u, 0u, 0u, 0u}; } \
        _Pragma("unroll") for (int i = 0; i < 4; ++i) { const int q = tid + 512 * i, row = q >> 4, c16 = q & 15; const bool ok = (c) > 0 || row >= 112; \
            const bf16* src = XB + (size_t)grow_of(b, (c), row) * 2048 + 1024 + g * 128 + c16 * 8; \
            const u32x4 vb = *(const u32x4*)src, vc = *(const u32x4*)(src + 512); pfb[i] = ok ? vb : (u32x4){0u, 0u, 0u, 0u}; pfc[i] = ok ? vc : (u32x4){0u, 0u, 0u, 0u}; } \
        _Pragma("unroll") for (int i = 0; i < 2; ++i) { const int row = 2 * lane + i; const bool ok = (c) > 0 || row >= 112; const float v = DT[(size_t)grow_of(b, (c), row) * 16 + h]; pdt[i] = ok ? v : -1.0e30f; } \
    } while (0)
#define SSD_TABLES(buf) do { \
        float d0 = pdt[0] + dtb, d1 = pdt[1] + dtb; d0 = d0 > 20.f ? d0 : log1pf(__expf(d0)); d1 = d1 > 20.f ? d1 : log1pf(__expf(d1)); \
        if (pdt[0] < -1.0e29f) d0 = 0.f; if (pdt[1] < -1.0e29f) d1 = 0.f; \
        const float a0 = d0 * Aneg, a1 = d1 * Aneg; float incl = a0 + a1; \
        _Pragma("unroll") for (int o = 1; o < 64; o <<= 1) { const float t = __shfl_up(incl, o); incl += (lane >= o) ? t : 0.f; } \
        const float c1 = incl, c0 = incl - a1; const float aend = __shfl(incl, 63); \
        if (wave == 0) { LAS float* tb = (LAS float*)(lds + O_TAB + (buf) * 2048); \
            *(LAS f32x2*)(tb + 2 * lane) = (f32x2){c0, c1}; *(LAS f32x2*)(tb + 128 + 2 * lane) = (f32x2){d0, d1}; \
            *(LAS f32x2*)(tb + 256 + 2 * lane) = (f32x2){__expf(aend - c0), __expf(aend - c1)}; *(LAS f32x2*)(tb + 384 + 2 * lane) = (f32x2){__expf(c0), __expf(c1)}; } \
    } while (0)
    SSD_LOAD(0);
    SSD_TABLES(0);
    LDS_WAIT(); __syncthreads();
    for (int c = 0; c < NCH; ++c) {
        const LAS float* tb = (const LAS float*)(lds + O_TAB + (c & 1) * 2048);
#pragma unroll
        for (int i = 0; i < 2; ++i) { const int q = tid + 512 * i, row = q >> 3, c16 = q & 7; const float dv = tb[128 + row], wv = dv * tb[256 + row];
            const u32x4 v = pfx[i]; u32x4 a, w;
            a.x = pk2(bflo(v.x) * dv, bfhi(v.x) * dv); a.y = pk2(bflo(v.y) * dv, bfhi(v.y) * dv); a.z = pk2(bflo(v.z) * dv, bfhi(v.z) * dv); a.w = pk2(bflo(v.w) * dv, bfhi(v.w) * dv);
            w.x = pk2(bflo(v.x) * wv, bfhi(v.x) * wv); w.y = pk2(bflo(v.y) * wv, bfhi(v.y) * wv); w.z = pk2(bflo(v.z) * wv, bfhi(v.z) * wv); w.w = pk2(bflo(v.w) * wv, bfhi(v.w) * wv);
            *(LAS u32x4*)(lds + O_XDT + row * XP + c16 * 16) = a; *(LAS u32x4*)(lds + O_XW + row * XP + c16 * 16) = w; }
#pragma unroll
        for (int i = 0; i < 4; ++i) { const int q = tid + 512 * i, row = q >> 4, c16 = q & 15;
            *(LAS u32x4*)(lds + O_B + row * BP + c16 * 16) = pfb[i]; *(LAS u32x4*)(lds + O_C + row * BP + c16 * 16) = pfc[i]; }
        if (c + 1 < NCH) SSD_LOAD(c + 1);
        LDS_WAIT(); __syncthreads();
        const int lrow = 16 * wave + fr;
        bf16x8 Cf[4];
#pragma unroll
        for (int ks = 0; ks < 4; ++ks) Cf[ks] = *(const LAS bf16x8*)(lds + O_C + lrow * BP + ks * 64 + fq * 16);
        f32x4 cb[8];
#pragma unroll
        for (int nt = 0; nt < 8; ++nt) { cb[nt] = (f32x4){0.f, 0.f, 0.f, 0.f};
#pragma unroll
            for (int ks = 0; ks < 4; ++ks) { const bf16x8 Bf = *(const LAS bf16x8*)(lds + O_B + (16 * nt + fr) * BP + ks * 64 + fq * 16); cb[nt] = SSD_MFMA(Bf, Cf[ks], cb[nt]); }
            __builtin_amdgcn_sched_barrier(0); }
        f32x4 y[4];
#pragma unroll
        for (int pt = 0; pt < 4; ++pt) { y[pt] = (f32x4){0.f, 0.f, 0.f, 0.f};
#pragma unroll
            for (int ks = 0; ks < 4; ++ks) { const bf16x8 Sf = *(const LAS bf16x8*)(lds + O_S + (16 * pt + fr) * BP + ks * 64 + fq * 16); y[pt] = SSD_MFMA(Sf, Cf[ks], y[pt]); }
            if (pt & 1) __builtin_amdgcn_sched_barrier(0); }
        u32x2 ex[4], ez[4];
        { const int gr = grow_of(b, c, 16 * wave + fr);
#pragma unroll
          for (int pt = 0; pt < 4; ++pt) { ex[pt] = *(const u32x2*)(XB + (size_t)gr * 2048 + h * 64 + 16 * pt + 4 * fq); ez[pt] = *(const u32x2*)(PROJ + (size_t)gr * NPROJ + C_Z + h * 64 + 16 * pt + 4 * fq); } }
        { const float al = tb[lrow];
#pragma unroll
          for (int nt = 0; nt < 8; ++nt) { const int s0 = 16 * nt + 4 * fq; const f32x4 as4 = *(const LAS f32x4*)(tb + s0); float m[4];
#pragma unroll
              for (int j = 0; j < 4; ++j) m[j] = (s0 + j <= lrow) ? cb[nt][j] * __expf(al - as4[j]) : 0.f;
              u32x2 w; w.x = pk2(m[0], m[1]); w.y = pk2(m[2], m[3]); *(LAS u32x2*)(lds + O_C + lrow * BP + s0 * 2) = w; } }
        { const float el = tb[384 + lrow];
#pragma unroll
          for (int pt = 0; pt < 4; ++pt) y[pt] = y[pt] * el; }
        bf16x8 Mf[4];
#pragma unroll
        for (int ks = 0; ks < 4; ++ks) Mf[ks] = *(const LAS bf16x8*)(lds + O_C + lrow * BP + ks * 64 + fq * 16);
        const unsigned tra = (unsigned)((8 * fq + ((lane & 15) >> 2)) * XP + 8 * (lane & 3));
        const unsigned trb = (unsigned)((8 * fq + ((lane & 15) >> 2)) * BP + 8 * (lane & 3));
#pragma unroll
        for (int pt = 0; pt < 4; ++pt) { bf16x8 Xf[4]; tr4<32 * XP, XP>(lbase + O_XDT + tra + 32 * pt, Xf);
#pragma unroll
            for (int ks = 0; ks < 4; ++ks) y[pt] = SSD_MFMA(Xf[ks], Mf[ks], y[pt]); }
        if (c > 0) { const size_t orow = (size_t)(b * SEQ + 128 * (c - 1) + lrow) * 1024 + h * 64 + 4 * fq;
#pragma unroll
            for (int pt = 0; pt < 4; ++pt) { const f32x4 v = y[pt]; const u32x2 xv = ex[pt], zv = ez[pt];
                const float o0 = (v[0] + Dh * bflo(xv.x)) * silu_f(bflo(zv.x)), o1 = (v[1] + Dh * bfhi(xv.x)) * silu_f(bfhi(zv.x));
                const float o2 = (v[2] + Dh * bflo(xv.y)) * silu_f(bflo(zv.y)), o3 = (v[3] + Dh * bfhi(xv.y)) * silu_f(bfhi(zv.y));
                u32x2 w; w.x = pk2(o0, o1); w.y = pk2(o2, o3); *(u32x2*)(YPRE + orow + 16 * pt) = w; } }
        __syncthreads();
        { const int pt4 = wave & 3, nt0 = 4 * (wave >> 2); const float dec = __expf(tb[127]);
          bf16x8 Xw[4]; tr4<32 * XP, XP>(lbase + O_XW + tra + 32 * pt4, Xw);
#pragma unroll
          for (int t = 0; t < 4; ++t) { bf16x8 Bf[4]; tr4<32 * BP, BP>(lbase + O_B + trb + 32 * (nt0 + t), Bf); st[t] = st[t] * dec;
#pragma unroll
              for (int ks = 0; ks < 4; ++ks) st[t] = SSD_MFMA(Bf[ks], Xw[ks], st[t]);
              u32x2 w; w.x = pk2(st[t][0], st[t][1]); w.y = pk2(st[t][2], st[t][3]);
              *(LAS u32x2*)(lds + O_S + (16 * pt4 + fr) * BP + (16 * (nt0 + t) + 4 * fq) * 2) = w; } }
        if (c + 1 < NCH) SSD_TABLES((c + 1) & 1);
        LDS_WAIT(); __syncthreads();
    }
#undef SSD_LOAD
#undef SSD_TABLES
}
}

enum { PH_PREP = 0, PH_INPROJ, PH_MIXA, PH_MIXB, PH_MIXC, PH_OUTPROJ, PH_ROUTER, PH_GU, PH_DOWN, PH_FINAL, PH_N };
__global__ void __launch_bounds__(NWAVES * 64, 2) mk_fwd(Args args) {
    extern __shared__ __attribute__((aligned(16))) unsigned char lds_raw[];
    LAS unsigned char* lds = (LAS unsigned char*)lds_raw;
    const int tid = threadIdx.x, lane = tid & 63, wave = __builtin_amdgcn_readfirstlane(tid >> 6);
    const int G = gridDim.x; const int bx = blockIdx.x; const int vcu = (G % 8 == 0) ? (bx % 8) * (G / 8) + bx / 8 : bx;
    unsigned char* ws = args.ws;
    for (int u = tid; u < (LDS_BYTES - LDSCTL_OFF) / 4; u += NWAVES * 64) ((LAS unsigned*)(lds + LDSCTL_OFF))[u] = 0u;
    __syncthreads();
    const int lo = args.ph_lo, hi = args.ph_hi;
    const bool multi = (hi - lo) > 1;
    XcdBarrier bar; bar.bar = (unsigned*)(ws + WS_CTL) + CW_BAR; bar.x = 0; bar.st = nullptr;
    if (multi) bar = xcd_barrier_post((unsigned*)(ws + WS_CTL) + CW_BAR, (volatile LAS unsigned*)(lds + MISC_OFF) + 8);
#ifndef PHASE_MASK
#define PHASE_MASK 0xffff
#endif
#ifndef REPEAT_MASK
#define REPEAT_MASK 0
#endif
#define IN(k) (((PHASE_MASK >> (k)) & 1) && lo <= (k) && (k) < hi)
#define REP(k) for (int _rep = 0; _rep < (((REPEAT_MASK >> (k)) & 1) ? 2 : 1); ++_rep)
#define SEAM(k) do { if (IN(k) && IN((k) + 1)) xcd_barrier(bar); } while (0)

    if (IN(PH_PREP)) REP(PH_PREP) { p0_prologue(args, lds, vcu, G, tid, lane, wave); __syncthreads(); SEAM(PH_PREP); }

    if (IN(PH_INPROJ)) REP(PH_INPROJ) {
        pg8::DenseSched S; S.init(TA, NPROJ, 1024, ws + WS_WIN, G, bx);
        pg8::EpiProj E{(bf16*)(ws + WS_PROJ), NPROJ};
        pg8::gemm_phase<pg8::EpiProj, pg8::DenseSched, true, true>(lds + RING_OFF, (const char*)(ws + WS_XN), 1024, S, E);
        SEAM(PH_INPROJ);
    }
    if (IN(PH_MIXA)) REP(PH_MIXA) {
        const int gw = vcu * NWAVES + wave, NGW = G * NWAVES;
        for (int it = gw; it < 2048 + 4; it += NGW) {
            if (it < 2048) mixa_xbc((const bf16*)(ws + WS_PROJ), args.in[I_SCW], args.in[I_SCB], (bf16*)(ws + WS_XBCA), it >> 7, NMETA + ((it >> 2) & 31) * 64, 64, it & 3, lane);
            else mixa_xbc((const bf16*)(ws + WS_PROJ), args.in[I_SCW], args.in[I_SCB], (bf16*)(ws + WS_XBCA), 0, 0, 16, it & 3, lane);
        }
        for (int it = gw; it < 2048; it += NGW) mixa_conv((const bf16*)(ws + WS_PROJ), args.in[I_CSW], (bf16*)(ws + WS_Y), it >> 7, ((it >> 1) & 63) * 32, it & 1, lane);
        SEAM(PH_MIXA);
    }
    if (IN(PH_MIXB)) REP(PH_MIXB) {
#ifdef SSD_NAIVE
        for (int item = bx; item < BATCH * NH; item += G) if (wave == 0) d_ssd_naive((const bf16*)(ws + WS_XBCA), (const bf16*)(ws + WS_PROJ), (const float*)(ws + WS_DT), args.in[I_DTB], args.in[I_ALOG], args.in[I_SD], (bf16*)(ws + WS_XN), item, lane);
#else
        for (int item = vcu; item < BATCH * NH; item += G) ssd::chain(args, lds, item, tid, lane, wave);
#endif
        SEAM(PH_MIXB);
    }
    if (IN(PH_MIXC)) REP(PH_MIXC) {
        const int gw = vcu * NWAVES + wave, NGW = G * NWAVES;
        for (int m = gw; m < TR; m += NGW) d_ssd_norm((const bf16*)(ws + WS_XN), (bf16*)(ws + WS_Y), m, lane);
        SEAM(PH_MIXC);
    }
    if (IN(PH_OUTPROJ)) REP(PH_OUTPROJ) {
        pg8::DenseSched S; S.init(TR, 1024, 2048, ws + WS_WOUT, G, bx);
        pg8::EpiH1 E{args.in[I_X], (float*)(ws + WS_H1), 1024};
        pg8::gemm_phase<pg8::EpiH1, pg8::DenseSched, true, true>(lds + RING_OFF, (const char*)(ws + WS_Y), 2048, S, E);
        SEAM(PH_OUTPROJ);
    }
    if (IN(PH_ROUTER)) { p4_router(args, lds, vcu, G, tid, lane, wave); SEAM(PH_ROUTER); }
    if (IN(PH_GU)) REP(PH_GU) {
        moe_tables(args, lds, tid);
        pg8::MoeSched<true> S; S.tst = (const LAS int*)(lds + MOE_OFF); S.cnt = S.tst + 40; S.G = G; S.c = bx; S.NP = 8; S.K = 512; S.list = (const int*)(ws + WS_LIST);
        S.Bt = (const char*)(ws + WS_WGU); S.estride = (size_t)2048 * 1024;
        pg8::EpiSwiGLU8 E{(unsigned char*)(ws + WS_ACT), args.in[I_BGU]};
        pg8::gemm_phase<pg8::EpiSwiGLU8, pg8::MoeSched<true>, true, true, true>(lds + RING_OFF, (const char*)(ws + WS_XN), 512, S, E);
        SEAM(PH_GU);
    }
    if (IN(PH_DOWN)) REP(PH_DOWN) {
        moe_tables(args, lds, tid);
        pg8::MoeSched<false> S; S.tst = (const LAS int*)(lds + MOE_OFF); S.cnt = S.tst + 40; S.G = G; S.c = bx; S.NP = 4; S.K = 512; S.list = (const int*)(ws + WS_LIST);
        S.Bt = (const char*)(ws + WS_WDN); S.estride = (size_t)1024 * 1024;
        pg8::EpiDown E{(bf16*)(ws + WS_YE), args.in[I_BDN], (const int*)(ws + WS_LIST), (const float*)(ws + WS_GATE), pg8::W8_INV};
        pg8::gemm_phase<pg8::EpiDown, pg8::MoeSched<false>, true, true, true>(lds + RING_OFF, (const char*)(ws + WS_ACT), 512, S, E);
        SEAM(PH_DOWN);
    }
    if (IN(PH_FINAL)) REP(PH_FINAL) { p7_final(args, vcu, G, lane, wave); }
#undef IN
#undef SEAM
}

extern "C" void kernel_launch(void* const* d_in, const int* in_sizes, int n_in, void* d_out, int out_size, void* d_ws, size_t ws_size, hipStream_t stream) {
    static int grid = 0;
    if (grid == 0) {
        if (n_in != 21 || in_sizes[0] != TR * D || out_size != TR * D || ws_size < WS_END) { fprintf(stderr, "kernel_launch: unexpected problem shape (n_in %d, in0 %d, out %d, ws %zu)\n", n_in, n_in > 0 ? in_sizes[0] : -1, out_size, ws_size); grid = -1; return; }
        int dev = 0, cus = 0, per_cu = 0;
        if (hipGetDevice(&dev) != hipSuccess || hipDeviceGetAttribute(&cus, hipDeviceAttributeMultiprocessorCount, dev) != hipSuccess) { grid = -1; return; }
        if (hipFuncSetAttribute((const void*)mk_fwd, hipFuncAttributeMaxDynamicSharedMemorySize, LDS_BYTES) != hipSuccess) { fprintf(stderr, "kernel_launch: hipFuncSetAttribute failed\n"); grid = -1; return; }
        if (hipOccupancyMaxActiveBlocksPerMultiprocessor(&per_cu, (const void*)mk_fwd, NWAVES * 64, LDS_BYTES) != hipSuccess || per_cu < 1) { fprintf(stderr, "kernel_launch: occupancy query says %d\n", per_cu); per_cu = 1; }
        (void)hipGetLastError();
        grid = cus;
    }
    if (grid < 0) return;
    (void)hipMemsetAsync((char*)d_ws + WS_CTL, 0, CTL_ZERO_BYTES, stream);
    Args a{};
    for (int i = 0; i < 21; ++i) a.in[i] = (const float*)d_in[i];
    a.out = (float*)d_out; a.ws = (unsigned char*)d_ws;
    unsigned char* ws = (unsigned char*)d_ws;
    auto launch = [&](int lo, int hi) { a.ph_lo = lo; a.ph_hi = hi; hipLaunchKernelGGL(mk_fwd, dim3(grid), dim3(NWAVES * 64), LDS_BYTES, stream, a); };
    launch(0, PH_N);
}
```
